# Optimizing an MI355X kernel written in HIP

```python
import math
import jax
import jax.numpy as jnp
from jax import lax
import numpy as np

D_MODEL = 2048
BATCH = 4
SEQ = 4096
DEPTH = 4

GRID_W = 64
CTX_LEN = 256
N_EVEN = (DEPTH + 1) // 2
N_ODD = DEPTH // 2
D_FF = 4 * D_MODEL
N_MOD = 6
NORM_EPS = 1e-6

A_WIDTH = D_MODEL // 2
A_HEAD_DIM = 64
A_HEADS = A_WIDTH // (2 * A_HEAD_DIM)
ROPE_FREQS = A_HEAD_DIM // 4
ROPE_BASE = 10000.0
Q_BLOCK = 128

B_WIDTH = D_MODEL - A_WIDTH
B_BLOCKS = 8
B_BLOCK_DIM = B_WIDTH // B_BLOCKS
CONV_W = 4
CONV_LEFT = 2
LRU_C = 8.0

C_HEADS = 4
C_KEY_DIM = D_MODEL // 2 // C_HEADS
C_VAL_DIM = D_MODEL // C_HEADS
C_KEY_W = C_HEADS * C_KEY_DIM
C_GATE_RANK = 16
C_GATE_TAU = 16.0
C_CHUNK = 64

EVEN_IN = 3 * A_WIDTH + 2 * B_WIDTH
ODD_IN = 2 * C_KEY_W + 2 * D_MODEL + 2 * C_GATE_RANK

kernel_name = 'hybrid_diffattn_rglru_gla_dit'


def rmsnorm(x, g):
    xf = x.astype(jnp.float32)
    y = xf * lax.rsqrt(jnp.mean(xf * xf, axis=-1, keepdims=True) + NORM_EPS)
    return (y * g.astype(jnp.float32)).astype(x.dtype)


def modulate(h, shift, scale):
    return h * (1.0 + scale) + shift


def sq_relu_mlp(u, w1, w2):
    return jnp.square(jax.nn.relu(u @ w1)) @ w2


def grid_angles(rows):
    inv = ROPE_BASE ** (-jnp.arange(ROPE_FREQS, dtype=jnp.float32) / ROPE_FREQS)
    r = jnp.repeat(jnp.arange(rows, dtype=jnp.float32), GRID_W)
    col = jnp.tile(jnp.arange(GRID_W, dtype=jnp.float32), rows)
    return r[:, None] * inv, col[:, None] * inv


def rope_axis(x, ang):
    f = ang.shape[-1]
    x1, x2 = x[..., :f], x[..., f:]
    cs, sn = jnp.cos(ang)[:, None, :], jnp.sin(ang)[:, None, :]
    return jnp.concatenate([x1 * cs - x2 * sn, x2 * cs + x1 * sn], axis=-1)


def rope_2d(x, ang_r, ang_c):
    half = x.shape[-1] // 2
    return jnp.concatenate([rope_axis(x[..., :half], ang_r), rope_axis(x[..., half:], ang_c)], axis=-1)


def qk_pair(t):
    t = t.astype(jnp.float32).reshape(t.shape[0], t.shape[1], A_HEADS, 2, A_HEAD_DIM)
    return t[..., 0, :], t[..., 1, :]


def v_heads(t):
    return t.astype(jnp.float32).reshape(t.shape[0], t.shape[1], A_HEADS, 2 * A_HEAD_DIM)


def diff_softmax_core(q1, q2, k1, k2, v, lam):
    p1 = jax.nn.softmax(jnp.einsum('bqhd,bkhd->bhqk', q1, k1), axis=-1)
    p2 = jax.nn.softmax(jnp.einsum('bqhd,bkhd->bhqk', q2, k2), axis=-1)
    return jnp.einsum('bhqk,bkhe->bqhe', p1 - lam * p2, v)


def centred_dwconv(x, w, b):
    L = x.shape[1]
    xp = jnp.pad(x, ((0, 0), (CONV_LEFT, CONV_W - 1 - CONV_LEFT), (0, 0)))
    w = w.astype(jnp.float32)
    return sum(xp[:, j:j + L] * w[j] for j in range(CONV_W)) + b.astype(jnp.float32)


def block_diag(x, w, b):
    xb = x.reshape(x.shape[0], x.shape[1], B_BLOCKS, B_BLOCK_DIM)
    y = jnp.einsum('blni,nij->blnj', xb, w.astype(jnp.float32))
    return y.reshape(x.shape) + b.astype(jnp.float32)


def lru_coeffs(xc, wa, ba, wx, bx, lam):
    r = jax.nn.sigmoid(block_diag(xc, wa, ba))
    gi = jax.nn.sigmoid(block_diag(xc, wx, bx))
    log_a = -LRU_C * r * jax.nn.softplus(-lam.astype(jnp.float32))
    return jnp.exp(log_a), jnp.sqrt(-jnp.expm1(2.0 * log_a)) * gi * xc


def linear_scan(a, b, h0, reverse):
    idx = -1 if reverse else 0
    b = b.at[:, idx].add(a[:, idx] * h0)

    def combine(e1, e2):
        a1, b1 = e1
        a2, b2 = e2
        return a1 * a2, a2 * b1 + b2

    _, h = lax.associative_scan(combine, (a, b), axis=1, reverse=reverse)
    return h


def gla_chunked(q, k, v, log_a, s0):
    B, L, H, _ = q.shape
    dv = v.shape[-1]
    n = L // C_CHUNK

    def to_chunks(t):
        return t.reshape(B, n, C_CHUNK, H, t.shape[-1]).transpose(1, 0, 3, 2, 4)

    mask = jnp.tril(jnp.ones((C_CHUNK, C_CHUNK), dtype=bool))

    def step(S, inp):
        qc, kc, vc, gc = inp
        bcum = jnp.cumsum(gc, axis=2)
        qe = qc * jnp.exp(bcum)
        ke = kc * jnp.exp(-bcum)
        att = jnp.where(mask, jnp.einsum('bhtk,bhsk->bhts', qe, ke), 0.0)
        o = jnp.einsum('bhtk,bhkv->bhtv', qe, S) + jnp.einsum('bhts,bhsv->bhtv', att, vc)
        b_end = bcum[:, :, -1:]
        S = jnp.exp(b_end[:, :, 0])[..., None] * S + jnp.einsum('bhsk,bhsv->bhkv', kc * jnp.exp(b_end - bcum), vc)
        return S, o

    S, o = lax.scan(step, s0, (to_chunks(q), to_chunks(k), to_chunks(v), to_chunks(log_a)))
    return o.transpose(1, 0, 3, 2, 4).reshape(B, L, H, dv), S


def even_mixer(u, uc, ang_r, ang_c, w_in, w_out, lq1, lk1, lq2, lk2, subln_g, lam_init,
               conv_w, conv_b, wa, ba, wx, bx, lru_lam, need_ctx):
    f32 = jnp.float32
    B, L, _ = u.shape
    cuts = [A_WIDTH, 2 * A_WIDTH, 3 * A_WIDTH, 3 * A_WIDTH + B_WIDTH]
    q, k, v, gt, rec = jnp.split(u @ w_in, cuts, axis=-1)
    qc, kc, vc, gtc, recc = jnp.split(uc @ w_in, cuts, axis=-1)
    lam = (jnp.exp(jnp.sum(lq1.astype(f32) * lk1.astype(f32)))
           - jnp.exp(jnp.sum(lq2.astype(f32) * lk2.astype(f32))) + lam_init)
    scale = A_HEAD_DIM ** -0.5
    q1, q2 = (rope_2d(t, ang_r, ang_c) * scale for t in qk_pair(q))
    k1, k2 = (rope_2d(t, ang_r, ang_c) for t in qk_pair(k))
    k1c, k2c = qk_pair(kc)
    v_ctx = v_heads(vc)
    keys1 = jnp.concatenate([k1c, k1], axis=1)
    keys2 = jnp.concatenate([k2c, k2], axis=1)
    vals = jnp.concatenate([v_ctx, v_heads(v)], axis=1)
    nb = L // Q_BLOCK

    def to_blocks(t):
        return t.reshape(B, nb, Q_BLOCK, A_HEADS, A_HEAD_DIM).swapaxes(0, 1)

    o = lax.map(lambda qb: diff_softmax_core(qb[0], qb[1], keys1, keys2, vals, lam),
                (to_blocks(q1), to_blocks(q2)))
    o = o.swapaxes(0, 1).reshape(B, L, A_HEADS, 2 * A_HEAD_DIM)

    def a_post(t):
        return (rmsnorm(t, subln_g) * (1.0 - lam_init)).reshape(t.shape[0], t.shape[1], A_WIDTH)

    x_lat = centred_dwconv(rec.astype(f32), conv_w, conv_b)
    x_ctx = centred_dwconv(recc.astype(f32), conv_w, conv_b)
    h_lat, h_ctx = [], []
    for d in range(2):
        rev = d == 1
        a_c, b_c = lru_coeffs(x_ctx, wa[d], ba[d], wx[d], bx[d], lru_lam[d])
        hc_d = linear_scan(a_c, b_c, jnp.zeros((B, B_WIDTH), f32), rev)
        a_l, b_l = lru_coeffs(x_lat, wa[d], ba[d], wx[d], bx[d], lru_lam[d])
        h_lat.append(linear_scan(a_l, b_l, hc_d[:, 0] if rev else hc_d[:, -1], rev))
        h_ctx.append(hc_d)

    def merge(ya, gate, h):
        yb = jax.nn.gelu(gate.astype(f32)) * (h[0] + h[1])
        return jnp.concatenate([ya, yb], axis=-1).astype(u.dtype) @ w_out

    y = merge(a_post(o), gt, h_lat)
    if not need_ctx:
        return y, None
    q1c, q2c = (t * scale for t in qk_pair(qc))
    oc = diff_softmax_core(q1c, q2c, k1c, k2c, v_ctx, lam)
    return y, merge(a_post(oc), gtc, h_ctx)


def odd_mixer(u, uc, w_in, w_out, gate_w2, gate_b, norm_g, need_ctx):
    f32 = jnp.float32
    cuts = [C_KEY_W, 2 * C_KEY_W, 2 * C_KEY_W + D_MODEL, 2 * C_KEY_W + 2 * D_MODEL]

    def prep(p):
        B, L, _ = p.shape
        q, k, v, r, z = jnp.split(p.astype(f32), cuts, axis=-1)
        q = q.reshape(B, L, C_HEADS, C_KEY_DIM) * C_KEY_DIM ** -0.5
        k = k.reshape(B, L, C_HEADS, C_KEY_DIM)
        v = v.reshape(B, L, C_HEADS, C_VAL_DIM)
        z = z.reshape(B, L, 2, C_GATE_RANK)
        log_a = [(jax.nn.log_sigmoid(z[:, :, d] @ gate_w2[d].astype(f32) + gate_b[d].astype(f32))
                  / C_GATE_TAU).reshape(B, L, C_HEADS, C_KEY_DIM) for d in range(2)]
        return q, k, v, r, log_a

    q, k, v, r, la = prep(u @ w_in)
    qc, kc, vc, rc, lac = prep(uc @ w_in)
    B = u.shape[0]
    o_lat, o_ctx = [], []
    for d in range(2):
        f = (lambda t: t[:, ::-1]) if d == 1 else (lambda t: t)
        s0 = jnp.zeros((B, C_HEADS, C_KEY_DIM, C_VAL_DIM), f32)
        oc_d, s_ctx = gla_chunked(f(qc), f(kc), f(vc), f(lac[d]), s0)
        ol_d, _ = gla_chunked(f(q), f(k), f(v), f(la[d]), s_ctx)
        o_lat.append(f(ol_d))
        o_ctx.append(f(oc_d))

    def out(o, gate):
        y = rmsnorm(o, norm_g).reshape(o.shape[0], o.shape[1], D_MODEL) * jax.nn.silu(gate)
        return y.astype(u.dtype) @ w_out

    y = out(o_lat[0] + o_lat[1], r)
    if not need_ctx:
        return y, None
    return y, out(o_ctx[0] + o_ctx[1], rc)


def setup_inputs(seed: int = 0) -> dict:
    key = jax.random.key(seed)
    keys = iter(list(jax.random.split(key, 32)))
    f32 = jnp.float32

    def nrm(shape, scale=1.0):
        return scale * jax.random.normal(next(keys), shape, f32)

    def gain(shape):
        return 1.0 + nrm(shape, 0.05)

    x = nrm((BATCH, SEQ, D_MODEL))
    c = nrm((BATCH, D_MODEL))
    ctx = nrm((BATCH, CTX_LEN, D_MODEL))
    c_ctx = nrm((D_MODEL,))
    ada_w = nrm((DEPTH, D_MODEL, N_MOD * D_MODEL), 0.5 * D_MODEL ** -0.5)
    ada_b = nrm((DEPTH, N_MOD * D_MODEL), 0.02)
    norm1_g = gain((DEPTH, D_MODEL))
    norm2_g = gain((DEPTH, D_MODEL))
    mlp_w1 = nrm((DEPTH, D_MODEL, D_FF), D_MODEL ** -0.5)
    mlp_w2 = nrm((DEPTH, D_FF, D_MODEL), D_FF ** -0.5)
    ev_w_in = nrm((N_EVEN, D_MODEL, EVEN_IN), D_MODEL ** -0.5)
    ev_w_out = nrm((N_EVEN, D_MODEL, D_MODEL), D_MODEL ** -0.5)
    ev_lambda_q1 = nrm((N_EVEN, A_HEAD_DIM), 0.1)
    ev_lambda_k1 = nrm((N_EVEN, A_HEAD_DIM), 0.1)
    ev_lambda_q2 = nrm((N_EVEN, A_HEAD_DIM), 0.1)
    ev_lambda_k2 = nrm((N_EVEN, A_HEAD_DIM), 0.1)
    ev_subln_g = gain((N_EVEN, 2 * A_HEAD_DIM))
    ev_conv_w = nrm((N_EVEN, CONV_W, B_WIDTH), CONV_W ** -0.5)
    ev_conv_b = nrm((N_EVEN, B_WIDTH), 0.02)
    ev_lru_wa = nrm((N_EVEN, 2, B_BLOCKS, B_BLOCK_DIM, B_BLOCK_DIM), B_BLOCK_DIM ** -0.5)
    ev_lru_ba = nrm((N_EVEN, 2, B_WIDTH), 0.1)
    ev_lru_wx = nrm((N_EVEN, 2, B_BLOCKS, B_BLOCK_DIM, B_BLOCK_DIM), B_BLOCK_DIM ** -0.5)
    ev_lru_bx = nrm((N_EVEN, 2, B_WIDTH), 0.1)
    a_pow = jax.random.uniform(next(keys), (N_EVEN, 2, B_WIDTH), f32, 0.9, 0.999)
    a_base = a_pow ** (1.0 / LRU_C)
    ev_lru_lam = jnp.log(a_base) - jnp.log1p(-a_base)
    od_w_in = nrm((N_ODD, D_MODEL, ODD_IN), D_MODEL ** -0.5)
    od_w_out = nrm((N_ODD, D_MODEL, D_MODEL), D_MODEL ** -0.5)
    od_gate_w2 = nrm((N_ODD, 2, C_GATE_RANK, C_KEY_W), C_GATE_RANK ** -0.5)
    od_gate_b = nrm((N_ODD, 2, C_KEY_W), 0.1)
    od_norm_g = gain((N_ODD, C_VAL_DIM))
    final_g = gain((D_MODEL,))
    return {'x': x, 'c': c, 'ctx': ctx, 'c_ctx': c_ctx, 'ada_w': ada_w, 'ada_b': ada_b,
            'norm1_g': norm1_g, 'norm2_g': norm2_g, 'mlp_w1': mlp_w1, 'mlp_w2': mlp_w2,
            'ev_w_in': ev_w_in, 'ev_w_out': ev_w_out, 'ev_lambda_q1': ev_lambda_q1,
            'ev_lambda_k1': ev_lambda_k1, 'ev_lambda_q2': ev_lambda_q2, 'ev_lambda_k2': ev_lambda_k2,
            'ev_subln_g': ev_subln_g, 'ev_conv_w': ev_conv_w, 'ev_conv_b': ev_conv_b,
            'ev_lru_wa': ev_lru_wa, 'ev_lru_ba': ev_lru_ba, 'ev_lru_wx': ev_lru_wx,
            'ev_lru_bx': ev_lru_bx, 'ev_lru_lam': ev_lru_lam, 'od_w_in': od_w_in,
            'od_w_out': od_w_out, 'od_gate_w2': od_gate_w2, 'od_gate_b': od_gate_b,
            'od_norm_g': od_norm_g, 'final_g': final_g}


def reference(x, c, ctx, c_ctx, ada_w, ada_b, norm1_g, norm2_g, mlp_w1, mlp_w2,
              ev_w_in, ev_w_out, ev_lambda_q1, ev_lambda_k1, ev_lambda_q2, ev_lambda_k2,
              ev_subln_g, ev_conv_w, ev_conv_b, ev_lru_wa, ev_lru_ba, ev_lru_wx, ev_lru_bx,
              ev_lru_lam, od_w_in, od_w_out, od_gate_w2, od_gate_b, od_norm_g, final_g):
    ROWS = x.shape[1] // GRID_W
    ang_r, ang_c = grid_angles(ROWS)
    s_lat = jax.nn.silu(c)
    s_ctx = jax.nn.silu(c_ctx)
    h, hc = x, ctx
    for i in range(DEPTH):
        need_ctx = i < DEPTH - 1
        m = jnp.split((s_lat @ ada_w[i] + ada_b[i])[:, None, :], N_MOD, axis=-1)
        mc = jnp.split(s_ctx @ ada_w[i] + ada_b[i], N_MOD, axis=-1)
        u = modulate(rmsnorm(h, norm1_g[i]), m[0], m[1])
        uc = modulate(rmsnorm(hc, norm1_g[i]), mc[0], mc[1])
        j = i // 2
        if i % 2 == 0:
            lam_init = 0.8 - 0.6 * math.exp(-0.3 * i)
            y, yc = even_mixer(u, uc, ang_r, ang_c, ev_w_in[j], ev_w_out[j],
                               ev_lambda_q1[j], ev_lambda_k1[j], ev_lambda_q2[j], ev_lambda_k2[j],
                               ev_subln_g[j], lam_init, ev_conv_w[j], ev_conv_b[j],
                               ev_lru_wa[j], ev_lru_ba[j], ev_lru_wx[j], ev_lru_bx[j],
                               ev_lru_lam[j], need_ctx)
        else:
            y, yc = odd_mixer(u, uc, od_w_in[j], od_w_out[j], od_gate_w2[j], od_gate_b[j],
                              od_norm_g[j], need_ctx)
        h = h + m[2] * y
        h = h + m[5] * sq_relu_mlp(modulate(rmsnorm(h, norm2_g[i]), m[3], m[4]), mlp_w1[i], mlp_w2[i])
        if need_ctx:
            hc = hc + mc[2] * yc
            hc = hc + mc[5] * sq_relu_mlp(modulate(rmsnorm(hc, norm2_g[i]), mc[3], mc[4]),
                                          mlp_w1[i], mlp_w2[i])
    return rmsnorm(h, final_g)
```

```cpp
#include <hip/hip_runtime.h>
#include <cstdio>
#include <cstdint>
#include <cmath>
namespace pg8 {
#define PG8_LAS __attribute__((address_space(3)))
typedef unsigned short bf16_t;
typedef short bf16x8 __attribute__((ext_vector_type(8)));
typedef float f32x4 __attribute__((ext_vector_type(4)));
typedef unsigned u32x4 __attribute__((ext_vector_type(4)));
constexpr int BM = 256, BK = 64, HALF = 128, HTB = HALF * BK * 2  , STAGE_BYTES = 8 * HTB, NXCD = 8, WGM = 8;

__host__ __device__ __forceinline__ int lds_byte(int r, int c) { const int st = (r >> 4) * 2 + (c >> 5), rr = r & 15, cc = c & 31, ob = rr * 64 + cc * 2; return st * 1024 + (ob ^ (((ob >> 9) & 1) << 5)); }
__host__ __device__ __forceinline__ void stage_rc(int b, int& R, int& C) { const int st = b / 1024, sb = b % 1024, swz = sb ^ (((sb >> 9) & 1) << 5); R = (st >> 1) * 16 + swz / 64; C = (st & 1) * 32 + (swz % 64) / 2; }
__host__ __device__ __forceinline__ int perm32(int rho) { const int n = rho >> 4, i = rho & 15; return 8 * (i >> 2) + 4 * n + (i & 3); }

struct Unit { int pm, pn; };
struct Gemm { const bf16_t* A; const bf16_t* Bt; int M, N, K; };

struct StaticOrder {
    int nM, nN, nwg, G, c;
    __host__ __device__ void init(int M, int N, int G_, int c_) { nM = M / BM; nN = N / BM; nwg = nM * nN; G = G_; c = c_; }
    __host__ __device__ bool next(int i, Unit& u) const {
        const long L = (long)i * G + c; if (L >= nwg) return false;
        int wgid = (int)L; { const int q = nwg / NXCD, r = nwg % NXCD, xcd = wgid % NXCD, off = wgid / NXCD; wgid = (xcd < r ? xcd * (q + 1) : r * (q + 1) + (xcd - r) * q) + off; }
        const int nig = WGM * nN, gid = wgid / nig, fm = gid * WGM, gsz = (nM - fm) < WGM ? (nM - fm) : WGM;
        u.pm = fm + ((wgid % nig) % gsz); u.pn = (wgid % nig) / gsz; return true;
    }
    __device__ __forceinline__ void a_ready(const Unit&) const {}
    __device__ __forceinline__ void done(const Unit&) const {}
};

__device__ __forceinline__ unsigned cvt_pk_bf16(float lo, float hi) { unsigned r; asm volatile("v_cvt_pk_bf16_f32 %0, %1, %2" : "=v"(r) : "v"(lo), "v"(hi)); return r; }
typedef float f32x2 __attribute__((ext_vector_type(2)));
template <int ACT> struct EpiStore {
    static constexpr bool PERM = true, AFTER_DRAIN = false;
    bf16_t* O; int ldc;
    __device__ __forceinline__ void operator()(const f32x4 (&acc)[2][2][4][2], const Unit& u, int wr, int wc, int fr, int fq) const {
        const int row0 = u.pm * BM + wr * 64 + fr; const int col0 = u.pn * BM + wc * 32 + 8 * fq;
#pragma unroll
        for (int ai = 0; ai < 2; ++ai)
#pragma unroll
            for (int m = 0; m < 4; ++m) { bf16_t* rowp = O + (size_t)(row0 + ai * HALF + m * 16) * ldc + col0;
#pragma unroll
                for (int bj = 0; bj < 2; ++bj) { f32x4 v0 = acc[ai][bj][m][0], v1 = acc[ai][bj][m][1];
                    if (ACT == 1) {
#pragma unroll
                        for (int e = 0; e < 4; ++e) { float a = v0[e] > 0.f ? v0[e] : 0.f; v0[e] = a * a; float b = v1[e] > 0.f ? v1[e] : 0.f; v1[e] = b * b; } }
                    u32x4 w; w.x = cvt_pk_bf16(v0[0], v0[1]); w.y = cvt_pk_bf16(v0[2], v0[3]); w.z = cvt_pk_bf16(v1[0], v1[1]); w.w = cvt_pk_bf16(v1[2], v1[3]);
                    *(u32x4*)(rowp + bj * HALF) = w; } }
    }
};
struct EpiResid {
    static constexpr bool PERM = false, AFTER_DRAIN = false;
    float* H; const float* mods; int which; int row_base;
    __device__ __forceinline__ void operator()(const f32x4 (&acc)[2][2][4][2], const Unit& u, int wr, int wc, int fr, int fq) const {
        const int prow = row_base + u.pm * BM;
        const int mr = prow < 1024 ? 4 : (prow - 1024) / 4096;
        const float* gate = mods + (size_t)(mr * 6 + which) * 2048;
        const int col0 = u.pn * BM + wc * 32 + 4 * fq;
#pragma unroll
        for (int bj = 0; bj < 2; ++bj)
#pragma unroll
            for (int n = 0; n < 2; ++n) { const int col = col0 + bj * HALF + n * 16; const f32x4 g = *(const f32x4*)(gate + col);
#pragma unroll
                for (int ai = 0; ai < 2; ++ai)
#pragma unroll
                    for (int m = 0; m < 4; ++m) { float* p = H + (size_t)(prow + ai * HALF + wr * 64 + m * 16 + fr) * 2048 + col;
                        const f32x4 h = *(const f32x4*)p; *(f32x4*)p = h + g * acc[ai][bj][m][n]; } }
    }
};
template <class Epi, class Sched, bool ALIGN_EPI = false, bool SP2 = false>
__device__ __forceinline__ void gemm_phase(PG8_LAS unsigned char* lds, const Gemm g, const Sched& S, const Epi& E) {
    const int tid = threadIdx.x, wid = __builtin_amdgcn_readfirstlane(tid >> 6), lane = tid & 63, wr = wid >> 2, wc = wid & 3, fr = lane & 15, fq = lane >> 4;
    const int K = g.K, nt = K / BK;
    unsigned voffA[2], voffB[2];
#pragma unroll
    for (int i = 0; i < 2; ++i) { int R, C; stage_rc(tid * 16 + i * 8192, R, C); const int Rb = Epi::PERM ? ((R & ~31) + perm32(R & 31)) : R;
        voffA[i] = (unsigned)(R * K + C) * 2u; voffB[i] = (unsigned)(Rb * K + C) * 2u; }
    const size_t kstep = (size_t)(BK * 2);
    const size_t hstep = (size_t)HALF * K * 2;
    const size_t tstep = 2 * hstep;
    const unsigned ldsw = (unsigned)wid * 1024u;
    const int aoff = lds_byte(wr * 64 + fr, fq * 8), boff = lds_byte(wc * 32 + fr, fq * 8);
#define PG8_SA(b, h) (((b) * 2 + (h)) * HTB)
#define PG8_SB(b, h) ((4 + (b) * 2 + (h)) * HTB)
#define PG8_STAGE(bufoff, gbase, voff) do { _Pragma("unroll") for (int _i = 0; _i < 2; ++_i) \
        __builtin_amdgcn_global_load_lds((const unsigned*)((const char*)(gbase) + (voff)[_i]), (PG8_LAS unsigned*)(lds + (bufoff) + ldsw + _i * 8192), 16, 0, 0); } while (0)
#define PG8_LDA(dst, b, h) do { _Pragma("unroll") for (int m = 0; m < 4; ++m) _Pragma("unroll") for (int k = 0; k < 2; ++k) dst[m][k] = *(const PG8_LAS bf16x8*)(lds + PG8_SA(b, h) + aoff + m * 2048 + k * 1024); } while (0)
#define PG8_LDB(dst, b, h) do { _Pragma("unroll") for (int n = 0; n < 2; ++n) _Pragma("unroll") for (int k = 0; k < 2; ++k) dst[n][k] = *(const PG8_LAS bf16x8*)(lds + PG8_SB(b, h) + boff + n * 2048 + k * 1024); } while (0)
#define PG8_MMA(ai, bj, At, Bt) do { __builtin_amdgcn_s_setprio(1); _Pragma("unroll") for (int m = 0; m < 4; ++m) _Pragma("unroll") for (int n = 0; n < 2; ++n) _Pragma("unroll") for (int k = 0; k < 2; ++k) \
        acc[ai][bj][m][n] = __builtin_amdgcn_mfma_f32_16x16x32_bf16(Bt[n][k], At[m][k], acc[ai][bj][m][n], 0, 0, 0); __builtin_amdgcn_s_setprio(0); } while (0)
#define PG8_WAIT_V(n) asm volatile("s_waitcnt vmcnt(" #n ")" ::: "memory")
#define PG8_WAIT_L(n) asm volatile("s_waitcnt lgkmcnt(" #n ")" ::: "memory")
#define PG8_BAR __builtin_amdgcn_s_barrier()
#define PG8_SCHED __builtin_amdgcn_sched_barrier(0)
    Unit cur, nxt; int ui = 0;
    if (!S.next(0, cur)) return;
    f32x4 acc[2][2][4][2];
#pragma unroll
    for (int a = 0; a < 2; ++a)
#pragma unroll
        for (int b = 0; b < 2; ++b)
#pragma unroll
            for (int m = 0; m < 4; ++m)
#pragma unroll
                for (int n = 0; n < 2; ++n) acc[a][b][m][n] = (f32x4){0.f, 0.f, 0.f, 0.f};
    bf16x8 At[4][2], B0[2][2], B1[2][2];
    const char* cA = (const char*)g.A + (size_t)cur.pm * tstep; const char* cB = (const char*)g.Bt + (size_t)cur.pn * tstep;
    S.a_ready(cur);
    if constexpr (SP2) {
        PG8_STAGE(PG8_SB(0, 0), cB, voffB); PG8_STAGE(PG8_SB(0, 1), cB + hstep, voffB); PG8_STAGE(PG8_SA(0, 0), cA, voffA); PG8_STAGE(PG8_SA(0, 1), cA + hstep, voffA);
        if (wr == 1) PG8_BAR;
        PG8_WAIT_V(2); PG8_BAR;
        PG8_STAGE(PG8_SB(1, 0), cB + kstep, voffB); PG8_STAGE(PG8_SA(1, 0), cA + kstep, voffA); PG8_STAGE(PG8_SB(1, 1), cB + hstep + kstep, voffB);
        PG8_WAIT_V(6); PG8_BAR;
    } else {
        PG8_STAGE(PG8_SB(0, 0), cB, voffB); PG8_STAGE(PG8_SA(0, 0), cA, voffA); PG8_STAGE(PG8_SB(0, 1), cB + hstep, voffB); PG8_STAGE(PG8_SA(0, 1), cA + hstep, voffA);
        if (wr == 1) PG8_BAR;
        PG8_WAIT_V(4); PG8_BAR;
        PG8_STAGE(PG8_SB(1, 0), cB + kstep, voffB); PG8_STAGE(PG8_SA(1, 0), cA + kstep, voffA); PG8_STAGE(PG8_SB(1, 1), cB + hstep + kstep, voffB);
        PG8_WAIT_V(6); PG8_BAR;
    }
    for (;;) {
        const bool has_next = S.next(ui + 1, nxt);
        const char* nA = has_next ? (const char*)g.A + (size_t)nxt.pm * tstep : cA; const char* nB = has_next ? (const char*)g.Bt + (size_t)nxt.pn * tstep : cB;
        for (int t = 0; t < nt; t += 2) {
            const bool last = (t == nt - 2);
            const char* a1 = cA + (size_t)(t + 1) * kstep;
            const char* a2 = last ? nA : cA + (size_t)(t + 2) * kstep; const char* b2 = last ? nB : cB + (size_t)(t + 2) * kstep;
            const char* a3 = a2 + kstep; const char* b3 = b2 + kstep;
            if (last && has_next) S.a_ready(nxt);
            if constexpr (SP2) {
            PG8_LDB(B0, 0, 0); PG8_LDB(B1, 0, 1); PG8_SCHED; PG8_LDA(At, 0, 0); PG8_STAGE(PG8_SA(1, 1), a1 + hstep, voffA);
            PG8_WAIT_V(8); PG8_WAIT_L(0); PG8_BAR; PG8_MMA(0, 0, At, B0); PG8_MMA(0, 1, At, B1); PG8_BAR; PG8_SCHED;
            PG8_LDA(At, 0, 1); PG8_STAGE(PG8_SB(0, 0), b2, voffB); PG8_STAGE(PG8_SB(0, 1), b2 + hstep, voffB); PG8_STAGE(PG8_SA(0, 0), a2, voffA);
            PG8_WAIT_V(8); PG8_WAIT_L(0); PG8_BAR; PG8_MMA(1, 0, At, B0); PG8_MMA(1, 1, At, B1); PG8_BAR; PG8_SCHED;
            PG8_LDB(B0, 1, 0); PG8_LDB(B1, 1, 1); PG8_SCHED; PG8_LDA(At, 1, 0); PG8_STAGE(PG8_SA(0, 1), a2 + hstep, voffA);
            PG8_WAIT_V(8); PG8_WAIT_L(0); PG8_BAR; PG8_MMA(0, 0, At, B0); PG8_MMA(0, 1, At, B1); PG8_BAR; PG8_SCHED;
            PG8_LDA(At, 1, 1); PG8_STAGE(PG8_SB(1, 0), b3, voffB); PG8_STAGE(PG8_SB(1, 1), b3 + hstep, voffB); PG8_STAGE(PG8_SA(1, 0), a3, voffA);
            PG8_WAIT_V(8); PG8_WAIT_L(0); PG8_BAR; PG8_MMA(1, 0, At, B0); PG8_MMA(1, 1, At, B1); PG8_BAR; PG8_SCHED;
            } else {
            PG8_LDB(B0, 0, 0); PG8_SCHED; PG8_LDA(At, 0, 0); PG8_STAGE(PG8_SA(1, 1), a1 + hstep, voffA);
            PG8_WAIT_L(8); PG8_BAR; PG8_WAIT_L(0); PG8_MMA(0, 0, At, B0); PG8_BAR; PG8_SCHED;
            PG8_LDB(B1, 0, 1); PG8_STAGE(PG8_SB(0, 0), b2, voffB);
            PG8_BAR; PG8_WAIT_L(0); PG8_MMA(0, 1, At, B1); PG8_BAR;
            PG8_LDA(At, 0, 1); PG8_STAGE(PG8_SA(0, 0), a2, voffA);
            PG8_BAR; PG8_WAIT_L(0); PG8_MMA(1, 0, At, B0); PG8_BAR; PG8_SCHED;
            PG8_STAGE(PG8_SB(0, 1), b2 + hstep, voffB);
            PG8_WAIT_V(6); PG8_BAR; PG8_MMA(1, 1, At, B1); PG8_BAR;
            PG8_LDB(B0, 1, 0); PG8_SCHED; PG8_LDA(At, 1, 0); PG8_STAGE(PG8_SA(0, 1), a2 + hstep, voffA);
            PG8_WAIT_L(8); PG8_BAR; PG8_WAIT_L(0); PG8_MMA(0, 0, At, B0); PG8_BAR; PG8_SCHED;
            PG8_LDB(B1, 1, 1); PG8_STAGE(PG8_SB(1, 0), b3, voffB);
            PG8_BAR; PG8_WAIT_L(0); PG8_MMA(0, 1, At, B1); PG8_BAR;
            PG8_LDA(At, 1, 1); PG8_STAGE(PG8_SA(1, 0), a3, voffA);
            PG8_BAR; PG8_WAIT_L(0); PG8_MMA(1, 0, At, B0); PG8_BAR; PG8_SCHED;
            PG8_STAGE(PG8_SB(1, 1), b3 + hstep, voffB);
            PG8_WAIT_V(6); PG8_BAR; PG8_MMA(1, 1, At, B1); PG8_BAR;
            }
        }
        if constexpr (ALIGN_EPI) { if (wr == 0) PG8_BAR; }
        if constexpr (!Epi::AFTER_DRAIN) { E(acc, cur, wr, wc, fr, fq); S.done(cur); }
        if (!has_next) break;
#pragma unroll
        for (int a = 0; a < 2; ++a)
#pragma unroll
            for (int b = 0; b < 2; ++b)
#pragma unroll
                for (int m = 0; m < 4; ++m)
#pragma unroll
                    for (int n = 0; n < 2; ++n) acc[a][b][m][n] = (f32x4){0.f, 0.f, 0.f, 0.f};
        cur = nxt; cA = nA; cB = nB; ++ui;
        if constexpr (ALIGN_EPI) { if (wr == 1) PG8_BAR; }
    }
    PG8_WAIT_V(0);
    if constexpr (!ALIGN_EPI) { if (wr == 0) PG8_BAR; }
    PG8_BAR;
    if constexpr (Epi::AFTER_DRAIN) { E.fused(acc, cur, wr, wc, fr, fq, lds, wid, lane); S.done(cur); }
#undef PG8_SA
#undef PG8_SB
#undef PG8_STAGE
#undef PG8_LDA
#undef PG8_LDB
#undef PG8_MMA
#undef PG8_WAIT_V
#undef PG8_WAIT_L
#undef PG8_BAR
#undef PG8_SCHED
}
}
#define GAS __attribute__((address_space(1)))
#define LAS __attribute__((address_space(3)))
typedef unsigned short bf16;
typedef unsigned v4u __attribute__((ext_vector_type(4)));
typedef float f32x4 __attribute__((ext_vector_type(4)));
typedef short bf16x8 __attribute__((ext_vector_type(8)));
typedef GAS unsigned gu32;
typedef GAS unsigned long long gu64;
#define RLX_AGENT __ATOMIC_RELAXED, __HIP_MEMORY_SCOPE_AGENT
#define LDS_WAIT() asm volatile("s_waitcnt lgkmcnt(0)" ::: "memory")
#define VM_WAIT() asm volatile("s_waitcnt vmcnt(0)" ::: "memory")
__device__ __forceinline__ unsigned long long rt() { return __builtin_amdgcn_s_memrealtime(); }
__device__ __forceinline__ unsigned f2bf(float f) { unsigned u = __builtin_bit_cast(unsigned, f); return (u + 0x7fffu + ((u >> 16) & 1u)) >> 16; }
__device__ __forceinline__ unsigned pk2(float lo, float hi) { return f2bf(lo) | (f2bf(hi) << 16); }
#define XB_TMO      128
#define XB_XCNT(j)  (256  + 64 * (j))
#define XB_XSUB(j)  (1280 + 64 * (j))
#define XB_XGEN(j)  (2304 + 64 * (j))
#define XB_TOP      3328
#define XB_TOPGEN   3392
#define XCD_BAR_WORDS 3456
#define XB_SPIN_CAP (1u << 18)

__device__ __forceinline__ unsigned xb_ld(unsigned* p)              { return __hip_atomic_load(p, __ATOMIC_RELAXED, __HIP_MEMORY_SCOPE_AGENT); }
__device__ __forceinline__ unsigned xb_add(unsigned* p, unsigned v) { return __hip_atomic_fetch_add(p, v, __ATOMIC_RELAXED, __HIP_MEMORY_SCOPE_AGENT); }
__device__ __forceinline__ unsigned xb_xcc_id() { return (unsigned)__builtin_amdgcn_s_getreg((3 << 11) | 20) & 0xFu; }
#define XB_SPIN(cond, bar) do { unsigned _sp = 0; while (cond) { __builtin_amdgcn_s_sleep(1); \
    if ((++_sp & 255u) == 0u) { if (xb_ld(&(bar)[XB_TMO])) break; if (_sp > XB_SPIN_CAP) { atomicAdd(&(bar)[XB_TMO], 1u); break; } } } } while (0)

struct XcdBarrier {
    unsigned* bar; unsigned x;
    volatile LAS unsigned* st;
};

__device__ __forceinline__ XcdBarrier xcd_barrier_post(unsigned* bar, volatile LAS unsigned* st) {
    XcdBarrier b; b.bar = bar; b.x = xb_xcc_id(); b.st = st;
    if (threadIdx.x == 0) (void)xb_add(&bar[XB_XCNT(b.x)], 1u);
    return b;
}
__device__ __forceinline__ void xcd_barrier_complete(unsigned* bar, unsigned x, unsigned& nloc, unsigned& nx) {
    const unsigned G = gridDim.x * gridDim.y * gridDim.z;
    unsigned sum, cnt, mine, sp = 0u;
    for (;;) {
        sum = 0u; cnt = 0u; mine = 0u;
#pragma unroll
        for (unsigned j = 0; j < 16; ++j) { const unsigned c = xb_ld(&bar[XB_XCNT(j)]); sum += c; cnt += (c > 0u) ? 1u : 0u; mine = (j == x) ? c : mine; }
        if (sum == G) break;
        __builtin_amdgcn_s_sleep(1);
        if ((++sp & 255u) == 0u) { if (xb_ld(&bar[XB_TMO])) break; if (sp > XB_SPIN_CAP) { atomicAdd(&bar[XB_TMO], 1u); break; } }
    }
    nloc = mine > 0u ? mine : 1u; nx = cnt > 0u ? cnt : 1u;
}

__device__ __forceinline__ void xcd_barrier(const XcdBarrier& b) {
    asm volatile("s_waitcnt vmcnt(0)" ::: "memory");
    __syncthreads();
    if (threadIdx.x == 0) {
        unsigned* bar = b.bar;
        __builtin_amdgcn_s_waitcnt(0);
        unsigned nloc = b.st[0], nx = b.st[1];
        if (nloc == 0u) { xcd_barrier_complete(bar, b.x, nloc, nx); b.st[0] = nloc; b.st[1] = nx; }
        const unsigned old = xb_add(&bar[XB_XSUB(b.x)], 1u);
        const unsigned gen = old / nloc;
        if (old + 1u == (gen + 1u) * nloc) {
            __builtin_amdgcn_fence(__ATOMIC_RELEASE, "agent");
            asm volatile("s_waitcnt vmcnt(0)" ::: "memory");
            const unsigned og = xb_add(&bar[XB_TOP], 1u);
            const unsigned tg = og / nx;
            if (og + 1u == (tg + 1u) * nx) xb_add(&bar[XB_TOPGEN], 1u);
            else XB_SPIN(xb_ld(&bar[XB_TOPGEN]) == tg, bar);
            __builtin_amdgcn_fence(__ATOMIC_ACQUIRE, "agent");
            xb_add(&bar[XB_XGEN(b.x)], 1u);
            asm volatile("s_waitcnt vmcnt(0)" ::: "memory");
        } else {
            XB_SPIN(xb_ld(&bar[XB_XGEN(b.x)]) == gen, bar);
            __builtin_amdgcn_fence(__ATOMIC_ACQUIRE, "agent");
            asm volatile("s_waitcnt vmcnt(0)" ::: "memory");
        }
    }
    __syncthreads();
}
__device__ __forceinline__ void p0_transpose_item(const float* W, int K, int N, bf16* WT, int row_off, LAS float* scr, int item, int lane) {
    const int nblk = N / 32, kb = item / nblk, nb = item % nblk, k0 = 64 * kb, n0 = 32 * nb;
#pragma unroll 8
    for (int i = 0; i < 32; ++i) { const int kk = 2 * i + (lane >> 5); scr[kk * 33 + (lane & 31)] = W[(size_t)(k0 + kk) * N + n0 + (lane & 31)]; }
    LDS_WAIT(); asm volatile("" ::: "memory");
    const int c = lane & 7;
#pragma unroll
    for (int j = 0; j < 4; ++j) { const int n = (lane >> 3) + 8 * j; const LAS float* s = scr + (8 * c) * 33 + n;
        v4u o; o.x = pk2(s[0 * 33], s[1 * 33]); o.y = pk2(s[2 * 33], s[3 * 33]); o.z = pk2(s[4 * 33], s[5 * 33]); o.w = pk2(s[6 * 33], s[7 * 33]);
        *(GAS v4u*)(WT + (size_t)(row_off + n0 + n) * K + k0 + 8 * c) = o; }
    LDS_WAIT(); asm volatile("" ::: "memory");
}
constexpr int DM = 2048, NB = 4, SEQ = 4096, CTXL = 256, NCTX = NB * CTXL, MLAT = NB * SEQ, MTOT = NCTX + MLAT, DFF = 8192, DEPTH = 4;
constexpr int EV_IN = 5120, OD_IN = 6176, OD_INP = 6400, NMODC = 6 * DM;
constexpr float EPS = 1e-6f;
constexpr int NWAVES = 8, NTHR = 512;

constexpr size_t MiB = 1u << 20;
constexpr size_t WS_CTL = 0, CTL_ZERO_BYTES = 1 * MiB;
constexpr size_t WS_MODS = 1 * MiB, WS_ROPE = 2 * MiB;
constexpr size_t WS_WEVIN = 3 * MiB, WS_WEVOUT = 43 * MiB, WS_WODIN = 59 * MiB, WS_WODOUT = 109 * MiB, WS_W1 = 125 * MiB, WS_W2 = 253 * MiB;
constexpr size_t WS_H = 381 * MiB, WS_U = 517 * MiB, WS_Y = 585 * MiB, WS_P = 653 * MiB, WS_SCR = 925 * MiB, WS_END = 1197 * MiB;
constexpr int CW_BAR = 4096;

constexpr int LDS_BYTES = 147456, RING_BYTES = 131072, LDSCTL_OFF = RING_BYTES, MISC_OFF = LDSCTL_OFF + 320;

struct Args { const float* in[30]; float* out; unsigned char* ws; int ph_lo, ph_hi; };
enum { I_X = 0, I_C, I_CTX, I_CCTX, I_ADAW, I_ADAB, I_N1G, I_N2G, I_W1, I_W2, I_EVWIN, I_EVWOUT, I_LQ1, I_LK1, I_LQ2, I_LK2, I_SUBG, I_CONVW, I_CONVB,
       I_WA, I_BA, I_WX, I_BX, I_LAM, I_ODWIN, I_ODWOUT, I_GW2, I_GB, I_ODNG, I_FING };

__device__ __forceinline__ float bf2f(bf16 v) { return __builtin_bit_cast(float, (unsigned)v << 16); }
__device__ __forceinline__ float wave_sum(float v) {
#pragma unroll
    for (int o = 1; o < 64; o <<= 1) v += __shfl_xor(v, o);
    return v;
}
__device__ __forceinline__ float wave_max(float v) {
#pragma unroll
    for (int o = 1; o < 64; o <<= 1) v = fmaxf(v, __shfl_xor(v, o));
    return v;
}
__device__ __forceinline__ float sigmoidf_(float x) { return 1.f / (1.f + __expf(-x)); }
__device__ __forceinline__ float siluf_(float x) { return x / (1.f + __expf(-x)); }
__device__ __forceinline__ float gelu_tanh(float x) { const float t = tanhf(0.7978845608028654f * (x + 0.044715f * x * x * x)); return 0.5f * x * (1.f + t); }
__device__ __forceinline__ int mod_row(int r) { return r < NCTX ? 4 : (r - NCTX) / SEQ; }

struct TC { int tid, lane, wave, gtid, NT, gw, NGW; };
typedef const __attribute__((address_space(4))) Args* ArgP;
__device__ __forceinline__ TC mk_tc() { int tid = threadIdx.x, bid = blockIdx.x, G = gridDim.x; asm volatile("" : "+v"(tid), "+s"(bid), "+s"(G)); TC t; t.tid = tid; t.lane = tid & 63; t.wave = __builtin_amdgcn_readfirstlane(tid >> 6);
    t.gtid = bid * NTHR + tid; t.NT = G * NTHR; t.gw = bid * NWAVES + t.wave; t.NGW = G * NWAVES; return t; }
__device__ __forceinline__ ArgP argp() { ArgP p = (ArgP)__builtin_amdgcn_kernarg_segment_ptr(); asm volatile("" : "+s"(p)); return p; }

__device__ __forceinline__ void ph_setup(ArgP A, const TC& t, LAS unsigned char* lds) {
    unsigned char* ws = A->ws;
    LAS float* sil = (LAS float*)lds;
    for (int i = t.tid; i < 5 * DM; i += NTHR) { const int r = i / DM, k = i % DM; const float v = r < 4 ? A->in[I_C][r * DM + k] : A->in[I_CCTX][k]; sil[i] = siluf_(v); }
    __syncthreads();
    float* mods = (float*)(ws + WS_MODS);
    for (int idx = t.gtid; idx < DEPTH * NMODC; idx += t.NT) {
        const int l = idx / NMODC, col = idx % NMODC;
        const float* w = A->in[I_ADAW] + (size_t)l * DM * NMODC + col;
        float acc0 = 0.f, acc1 = 0.f, acc2 = 0.f, acc3 = 0.f, acc4 = 0.f;
#pragma unroll 8
        for (int k = 0; k < DM; ++k) { const float wv = w[(size_t)k * NMODC];
            acc0 += sil[k] * wv; acc1 += sil[DM + k] * wv; acc2 += sil[2 * DM + k] * wv; acc3 += sil[3 * DM + k] * wv; acc4 += sil[4 * DM + k] * wv; }
        const float bb = A->in[I_ADAB][l * NMODC + col];
        mods[(size_t)(l * 5 + 0) * NMODC + col] = acc0 + bb; mods[(size_t)(l * 5 + 1) * NMODC + col] = acc1 + bb; mods[(size_t)(l * 5 + 2) * NMODC + col] = acc2 + bb;
        mods[(size_t)(l * 5 + 3) * NMODC + col] = acc3 + bb; mods[(size_t)(l * 5 + 4) * NMODC + col] = acc4 + bb;
    }
    LAS float* scr = (LAS float*)(lds + 40960 + t.wave * 8704);
#define CVT(Wsrc, K_, N_, Wdst) do { const int items_ = ((K_) / 64) * ((N_) / 32); for (int it = t.gw; it < items_; it += t.NGW) p0_transpose_item((Wsrc), (K_), (N_), (Wdst), 0, scr, it, t.lane); } while (0)
    for (int j = 0; j < 2; ++j) {
        CVT(A->in[I_EVWIN] + (size_t)j * DM * EV_IN, DM, EV_IN, (bf16*)(ws + WS_WEVIN) + (size_t)j * EV_IN * DM);
        CVT(A->in[I_EVWOUT] + (size_t)j * DM * DM, DM, DM, (bf16*)(ws + WS_WEVOUT) + (size_t)j * DM * DM);
        CVT(A->in[I_ODWIN] + (size_t)j * DM * OD_IN, DM, OD_IN, (bf16*)(ws + WS_WODIN) + (size_t)j * OD_INP * DM);
        CVT(A->in[I_ODWOUT] + (size_t)j * DM * DM, DM, DM, (bf16*)(ws + WS_WODOUT) + (size_t)j * DM * DM);
        GAS v4u* z = (GAS v4u*)((bf16*)(ws + WS_WODIN) + (size_t)j * OD_INP * DM + (size_t)OD_IN * DM);
        for (int i = t.gtid; i < (OD_INP - OD_IN) * DM / 8; i += t.NT) z[i] = (v4u){0u, 0u, 0u, 0u};
    }
    for (int l = 0; l < DEPTH; ++l) {
        CVT(A->in[I_W1] + (size_t)l * DM * DFF, DM, DFF, (bf16*)(ws + WS_W1) + (size_t)l * DFF * DM);
        CVT(A->in[I_W2] + (size_t)l * DFF * DM, DFF, DM, (bf16*)(ws + WS_W2) + (size_t)l * DM * DFF);
    }
#undef CVT
    if (t.gtid < 64 * 16) { const int p = t.gtid / 16, f = t.gtid % 16;
        const float inv = powf(10000.0f, -(float)f / 16.0f); const float ang = (float)p * inv;
        const double ad = (double)ang; const double kk = rint(ad * 0.15915494309189535); const float rr = (float)(ad - kk * 6.283185307179586);
        float* rope = (float*)(ws + WS_ROPE); rope[2 * t.gtid] = cosf(rr); rope[2 * t.gtid + 1] = sinf(rr); }
    { GAS f32x4* H = (GAS f32x4*)(ws + WS_H); const GAS f32x4* cx = (const GAS f32x4*)A->in[I_CTX]; const GAS f32x4* xx = (const GAS f32x4*)A->in[I_X];
      for (int i = t.gtid; i < MTOT * (DM / 4); i += t.NT) H[i] = i < NCTX * (DM / 4) ? cx[i] : xx[i - NCTX * (DM / 4)]; }
}

__device__ __forceinline__ void ph_normmod(ArgP A, const TC& t, int l, int which) {
    const float* g = A->in[which ? I_N2G : I_N1G] + l * DM;
    const float* mods = (const float*)(A->ws + WS_MODS) + (size_t)l * 5 * NMODC;
    const float* H = (const float*)(A->ws + WS_H); bf16* U = (bf16*)(A->ws + WS_U);
    for (int r = t.gw; r < MTOT; r += t.NGW) {
        const GAS f32x4* xr = (const GAS f32x4*)(H + (size_t)r * DM) + t.lane;
        f32x4 v[8]; float ss = 0.f;
#pragma unroll
        for (int j = 0; j < 8; ++j) { v[j] = xr[64 * j]; ss += (v[j].x * v[j].x + v[j].y * v[j].y) + (v[j].z * v[j].z + v[j].w * v[j].w); }
        const float rstd = 1.0f / sqrtf(wave_sum(ss) * (1.f / DM) + EPS);
        const float* mrow = mods + (size_t)mod_row(r) * NMODC + (which ? 3 : 0) * DM;
        GAS unsigned long long* o8 = (GAS unsigned long long*)(U + (size_t)r * DM) + t.lane;
#pragma unroll
        for (int j = 0; j < 8; ++j) { const int c = 4 * (t.lane + 64 * j);
            const f32x4 gg = *(const f32x4*)(g + c), sh = *(const f32x4*)(mrow + c), sc = *(const f32x4*)(mrow + DM + c);
            const f32x4 y = (v[j] * rstd * gg) * (sc + 1.0f) + sh;
            o8[64 * j] = (unsigned long long)pk2(y.x, y.y) | ((unsigned long long)pk2(y.z, y.w) << 32); }
    }
}

__device__ __forceinline__ void ph_ev_c1(ArgP A, const TC& t, int j) {
    bf16* P = (bf16*)(A->ws + WS_P); const float* rope = (const float*)(A->ws + WS_ROPE);
    for (long idx = t.gtid; idx < (long)MTOT * 1024; idx += t.NT) {
        const int r = (int)(idx >> 10), g = (int)(idx >> 5) & 31, i = (int)idx & 31;
        const int half = i >> 4, f = i & 15; const int d1 = half * 32 + f, d2 = d1 + 16;
        bf16* p = P + (size_t)r * EV_IN + g * 64;
        const float x1 = bf2f(p[d1]), x2 = bf2f(p[d2]); const float sc = g < 16 ? 0.125f : 1.0f;
        float cs = 1.f, sn = 0.f;
        if (r >= NCTX) { const int tt = (r - NCTX) % SEQ; const int pos = half ? (tt & 63) : (tt >> 6); cs = rope[2 * (pos * 16 + f)]; sn = rope[2 * (pos * 16 + f) + 1]; }
        p[d1] = (bf16)f2bf((x1 * cs - x2 * sn) * sc); p[d2] = (bf16)f2bf((x2 * cs + x1 * sn) * sc);
    }
    float* XC = (float*)(A->ws + WS_SCR);
    const float* cw = A->in[I_CONVW] + (size_t)j * 4 * 1024; const float* cb = A->in[I_CONVB] + (size_t)j * 1024;
    for (long idx = t.gtid; idx < (long)MTOT * 1024; idx += t.NT) {
        const int r = (int)(idx >> 10), ch = (int)idx & 1023;
        int lo, hi; if (r < NCTX) { lo = (r / CTXL) * CTXL; hi = lo + CTXL; } else { lo = NCTX + ((r - NCTX) / SEQ) * SEQ; hi = lo + SEQ; }
        float acc = cb[ch];
#pragma unroll
        for (int jj = 0; jj < 4; ++jj) { const int rr = r + jj - 2; if (rr >= lo && rr < hi) acc += bf2f(P[(size_t)rr * EV_IN + 4096 + ch]) * cw[jj * 1024 + ch]; }
        XC[idx] = acc;
    }
}
__device__ __forceinline__ int key_row(int b, int k) { return k < CTXL ? b * CTXL + k : NCTX + b * SEQ + (k - CTXL); }
__device__ __forceinline__ void ph_ev_c2(ArgP A, const TC& t, int l, int j) {
    const bf16* P = (const bf16*)(A->ws + WS_P); bf16* Y = (bf16*)(A->ws + WS_Y);
    const float lam_init = 0.8f - 0.6f * expf(-0.3f * (float)l);
    const float dq1 = wave_sum(A->in[I_LQ1][j * 64 + t.lane] * A->in[I_LK1][j * 64 + t.lane]);
    const float dq2 = wave_sum(A->in[I_LQ2][j * 64 + t.lane] * A->in[I_LK2][j * 64 + t.lane]);
    const float lam = expf(dq1) - expf(dq2) + lam_init;
    const float* sg = A->in[I_SUBG] + j * 128;
    for (int item = t.gw; item < MTOT * 8; item += t.NGW) {
        const int r = item >> 3, hh = item & 7; const bool isc = r < NCTX; const int b = isc ? r / CTXL : (r - NCTX) / SEQ;
        const int nblk = isc ? CTXL / 64 : (CTXL + SEQ) / 64;
        const float q1v = bf2f(P[(size_t)r * EV_IN + hh * 128 + t.lane]), q2v = bf2f(P[(size_t)r * EV_IN + hh * 128 + 64 + t.lane]);
        float m1 = -INFINITY, m2 = -INFINITY, l1 = 0.f, l2 = 0.f, o1a = 0.f, o1b = 0.f, o2a = 0.f, o2b = 0.f;
        for (int blk = 0; blk < nblk; ++blk) {
            const int kr = key_row(b, blk * 64 + t.lane);
            const v4u* kp = (const v4u*)(P + (size_t)kr * EV_IN + 1024 + hh * 128);
            float s1 = 0.f, s2 = 0.f;
#pragma unroll
            for (int c = 0; c < 8; ++c) { const v4u w = kp[c];
                const unsigned ww[4] = {w.x, w.y, w.z, w.w};
#pragma unroll
                for (int e = 0; e < 4; ++e) { s1 += __shfl(q1v, c * 8 + 2 * e) * __builtin_bit_cast(float, ww[e] << 16) + __shfl(q1v, c * 8 + 2 * e + 1) * __builtin_bit_cast(float, ww[e] & 0xffff0000u); } }
#pragma unroll
            for (int c = 0; c < 8; ++c) { const v4u w = kp[8 + c];
                const unsigned ww[4] = {w.x, w.y, w.z, w.w};
#pragma unroll
                for (int e = 0; e < 4; ++e) { s2 += __shfl(q2v, c * 8 + 2 * e) * __builtin_bit_cast(float, ww[e] << 16) + __shfl(q2v, c * 8 + 2 * e + 1) * __builtin_bit_cast(float, ww[e] & 0xffff0000u); } }
            const float n1 = fmaxf(m1, wave_max(s1)), n2 = fmaxf(m2, wave_max(s2));
            const float al1 = __expf(m1 - n1), al2 = __expf(m2 - n2);
            const float p1 = __expf(s1 - n1), p2 = __expf(s2 - n2);
            l1 = l1 * al1 + wave_sum(p1); l2 = l2 * al2 + wave_sum(p2); m1 = n1; m2 = n2;
            o1a *= al1; o1b *= al1; o2a *= al2; o2b *= al2;
            for (int jj = 0; jj < 64; ++jj) {
                const int vr = key_row(b, blk * 64 + jj);
                const float va = bf2f(P[(size_t)vr * EV_IN + 2048 + hh * 128 + t.lane]), vb = bf2f(P[(size_t)vr * EV_IN + 2048 + hh * 128 + 64 + t.lane]);
                const float pj1 = __shfl(p1, jj), pj2 = __shfl(p2, jj);
                o1a += pj1 * va; o1b += pj1 * vb; o2a += pj2 * va; o2b += pj2 * vb;
            }
        }
        const float oa = o1a / l1 - lam * (o2a / l2), ob = o1b / l1 - lam * (o2b / l2);
        const float rstd = 1.0f / sqrtf(wave_sum(oa * oa + ob * ob) * (1.f / 128.f) + EPS);
        Y[(size_t)r * DM + hh * 128 + t.lane] = (bf16)f2bf(oa * rstd * sg[t.lane] * (1.f - lam_init));
        Y[(size_t)r * DM + hh * 128 + 64 + t.lane] = (bf16)f2bf(ob * rstd * sg[64 + t.lane] * (1.f - lam_init));
    }
    const float* XC = (const float*)(A->ws + WS_SCR); float* GA = (float*)(A->ws + WS_SCR) + (size_t)MTOT * 1024;
    for (long idx = t.gtid; idx < (long)MTOT * 1024; idx += t.NT) {
        const int r = (int)(idx >> 10), ch = (int)idx & 1023, blk = ch >> 7, jc = ch & 127;
        const float xc = XC[idx];
#pragma unroll
        for (int d = 0; d < 2; ++d) {
            const float* wa = A->in[I_WA] + ((size_t)(j * 2 + d) * 8 + blk) * 128 * 128 + jc; const float* wx = A->in[I_WX] + ((size_t)(j * 2 + d) * 8 + blk) * 128 * 128 + jc;
            float ra = A->in[I_BA][(j * 2 + d) * 1024 + ch], rx = A->in[I_BX][(j * 2 + d) * 1024 + ch];
            const float* xr = XC + (size_t)r * 1024 + blk * 128;
#pragma unroll 8
            for (int i = 0; i < 128; ++i) { const float xv = xr[i]; ra += xv * wa[i * 128]; rx += xv * wx[i * 128]; }
            const float lamv = A->in[I_LAM][(j * 2 + d) * 1024 + ch];
            const float sp = log1pf(expf(-lamv));
            const float log_a = -8.0f * sigmoidf_(ra) * sp;
            const float av = expf(log_a), bv = sqrtf(-expm1f(2.0f * log_a)) * sigmoidf_(rx) * xc;
            GA[(size_t)(2 * d) * MTOT * 1024 + idx] = av; GA[(size_t)(2 * d + 1) * MTOT * 1024 + idx] = bv;
        }
    }
}
__device__ __forceinline__ void ph_ev_c3(ArgP A, const TC& t) {
    float* GA = (float*)(A->ws + WS_SCR) + (size_t)MTOT * 1024;
    for (int idx = t.gtid; idx < NB * 1024 * 2; idx += t.NT) {
        const int ch = idx & 1023, b = (idx >> 10) & 3, d = idx >> 12;
        const float* A = GA + (size_t)(2 * d) * MTOT * 1024 + ch; float* Bv = GA + (size_t)(2 * d + 1) * MTOT * 1024 + ch;
        float h = 0.f;
        for (int n = 0; n < CTXL + SEQ; ++n) {
            int r; if (d == 0) r = n < CTXL ? b * CTXL + n : NCTX + b * SEQ + (n - CTXL); else r = n < CTXL ? b * CTXL + (CTXL - 1 - n) : NCTX + b * SEQ + (SEQ - 1 - (n - CTXL));
            h = A[(size_t)r * 1024] * h + Bv[(size_t)r * 1024]; Bv[(size_t)r * 1024] = h;
        }
    }
}
__device__ __forceinline__ void ph_ev_c4(ArgP A, const TC& t) {
    const float* GA = (const float*)(A->ws + WS_SCR) + (size_t)MTOT * 1024; const bf16* P = (const bf16*)(A->ws + WS_P); bf16* Y = (bf16*)(A->ws + WS_Y);
    for (long idx = t.gtid; idx < (long)MTOT * 1024; idx += t.NT) {
        const int r = (int)(idx >> 10), ch = (int)idx & 1023;
        const float h = GA[(size_t)1 * MTOT * 1024 + idx] + GA[(size_t)3 * MTOT * 1024 + idx];
        Y[(size_t)r * DM + 1024 + ch] = (bf16)f2bf(gelu_tanh(bf2f(P[(size_t)r * EV_IN + 3072 + ch])) * h);
    }
}

__device__ __forceinline__ void ph_od_c1(ArgP A, const TC& t, int j) {
    const bf16* P = (const bf16*)(A->ws + WS_P); float* LA = (float*)(A->ws + WS_SCR);
    for (long idx = t.gtid; idx < (long)2 * MTOT * 1024; idx += t.NT) {
        const int c = (int)idx & 1023; const int r = (int)((idx >> 10) % MTOT), d = (int)((idx >> 10) / MTOT);
        const float* w = A->in[I_GW2] + (size_t)(j * 2 + d) * 16 * 1024 + c; float x = A->in[I_GB][(j * 2 + d) * 1024 + c];
#pragma unroll
        for (int i = 0; i < 16; ++i) x += bf2f(P[(size_t)r * OD_INP + 6144 + d * 16 + i]) * w[i * 1024];
        const float ls = fminf(x, 0.f) - log1pf(expf(-fabsf(x)));
        LA[idx] = ls * (1.f / 16.f);
    }
}
__device__ __forceinline__ void ph_od_c23(ArgP A, const TC& t, int d, LAS unsigned char* lds) {
    const bf16* P = (const bf16*)(A->ws + WS_P); const float* LA = (const float*)(A->ws + WS_SCR) + (size_t)d * MTOT * 1024; float* O = (float*)(A->ws + WS_SCR) + (size_t)2 * MTOT * 1024;
    constexpr int T = 16;
    LAS float* eg = (LAS float*)lds; LAS float* kk = eg + T * 256; LAS float* qq = kk + T * 256;
    const int qt = t.tid & 3, vc = t.tid >> 2;
    for (int item = blockIdx.x; item < NB * 4 * 4; item += gridDim.x) {
        const int vq = item & 3, hh = (item >> 2) & 3, b = item >> 4;
        float S[64];
#pragma unroll
        for (int i = 0; i < 64; ++i) S[i] = 0.f;
        for (int n0 = 0; n0 < CTXL + SEQ; n0 += T) {
            __syncthreads();
            for (int e = t.tid; e < T * 256; e += NTHR) { const int s = e >> 8, kr = e & 255; const int n = n0 + s;
                int r; if (d == 0) r = n < CTXL ? b * CTXL + n : NCTX + b * SEQ + (n - CTXL); else r = n < CTXL ? b * CTXL + (CTXL - 1 - n) : NCTX + b * SEQ + (SEQ - 1 - (n - CTXL));
                eg[e] = __expf(LA[(size_t)r * 1024 + hh * 256 + kr]); kk[e] = bf2f(P[(size_t)r * OD_INP + 1024 + hh * 256 + kr]); qq[e] = bf2f(P[(size_t)r * OD_INP + hh * 256 + kr]) * 0.0625f; }
            __syncthreads();
            for (int s = 0; s < T; ++s) { const int n = n0 + s;
                int r; if (d == 0) r = n < CTXL ? b * CTXL + n : NCTX + b * SEQ + (n - CTXL); else r = n < CTXL ? b * CTXL + (CTXL - 1 - n) : NCTX + b * SEQ + (SEQ - 1 - (n - CTXL));
                const float v = bf2f(P[(size_t)r * OD_INP + 2048 + hh * 512 + vq * 128 + vc]);
                float po = 0.f;
#pragma unroll
                for (int i4 = 0; i4 < 16; ++i4) { const f32x4 e4 = *(const LAS f32x4*)(eg + s * 256 + qt * 64 + i4 * 4), k4 = *(const LAS f32x4*)(kk + s * 256 + qt * 64 + i4 * 4), q4 = *(const LAS f32x4*)(qq + s * 256 + qt * 64 + i4 * 4);
#pragma unroll
                    for (int e = 0; e < 4; ++e) { S[i4 * 4 + e] = e4[e] * S[i4 * 4 + e] + k4[e] * v; po += q4[e] * S[i4 * 4 + e]; } }
                po += __shfl_xor(po, 1); po += __shfl_xor(po, 2);
                if (qt == 0) { float* op = O + (size_t)r * DM + hh * 512 + vq * 128 + vc; if (d == 0) *op = po; else *op += po; }
            }
        }
    }
}
__device__ __forceinline__ void ph_od_c4(ArgP A, const TC& t, int j) {
    const bf16* P = (const bf16*)(A->ws + WS_P); const float* O = (const float*)(A->ws + WS_SCR) + (size_t)2 * MTOT * 1024; bf16* Y = (bf16*)(A->ws + WS_Y);
    const float* ng = A->in[I_ODNG] + j * 512;
    for (int item = t.gw; item < MTOT * 4; item += t.NGW) {
        const int r = item >> 2, hh = item & 3;
        float o[8]; float ss = 0.f;
#pragma unroll
        for (int e = 0; e < 8; ++e) { o[e] = O[(size_t)r * DM + hh * 512 + e * 64 + t.lane]; ss += o[e] * o[e]; }
        const float rstd = 1.0f / sqrtf(wave_sum(ss) * (1.f / 512.f) + EPS);
#pragma unroll
        for (int e = 0; e < 8; ++e) { const int c = hh * 512 + e * 64 + t.lane; const float rg = bf2f(P[(size_t)r * OD_INP + 4096 + c]);
            Y[(size_t)r * DM + c] = (bf16)f2bf(o[e] * rstd * ng[e * 64 + t.lane] * siluf_(rg)); }
    }
}
__device__ __forceinline__ void ph_final(ArgP A, const TC& t) {
    const float* H = (const float*)(A->ws + WS_H); const float* g = A->in[I_FING];
    for (int r = t.gw; r < MLAT; r += t.NGW) {
        const GAS f32x4* xr = (const GAS f32x4*)(H + (size_t)(NCTX + r) * DM) + t.lane;
        f32x4 v[8]; float ss = 0.f;
#pragma unroll
        for (int j = 0; j < 8; ++j) { v[j] = xr[64 * j]; ss += (v[j].x * v[j].x + v[j].y * v[j].y) + (v[j].z * v[j].z + v[j].w * v[j].w); }
        const float rstd = 1.0f / sqrtf(wave_sum(ss) * (1.f / DM) + EPS);
        GAS f32x4* o = (GAS f32x4*)(A->out + (size_t)r * DM) + t.lane;
#pragma unroll
        for (int j = 0; j < 8; ++j) { const f32x4 gg = *(const f32x4*)(g + 4 * (t.lane + 64 * j)); o[64 * j] = v[j] * rstd * gg; }
    }
}

constexpr int PH_PER_LAYER = 10, N_PHASES = 2 + DEPTH * PH_PER_LAYER;
template <int MR, int N, int K, class Epi> __device__ __forceinline__ void run_gemm(LAS unsigned char* lds, const bf16* Aop, const bf16* Wt, const Epi& E) {
    pg8::Gemm g{Aop, Wt, MR, N, K}; pg8::StaticOrder S; S.init(MR, N, gridDim.x, (int)blockIdx.x);
    pg8::gemm_phase<Epi, pg8::StaticOrder, true, true>(lds, g, S, E);
}
__global__ void __launch_bounds__(NTHR, 2) mega(Args args) {
    extern __shared__ __attribute__((aligned(16))) unsigned char lds_raw[];
    LAS unsigned char* lds = (LAS unsigned char*)lds_raw;
    volatile LAS unsigned* MISC = (volatile LAS unsigned*)(lds + MISC_OFF);
    for (int u = threadIdx.x; u < (LDS_BYTES - LDSCTL_OFF) / 4; u += NTHR) ((LAS unsigned*)(lds + LDSCTL_OFF))[u] = 0u;
    __syncthreads();
    const int lo = argp()->ph_lo, hi = argp()->ph_hi;
    const bool use_bar = (hi - lo) > 1;
    XcdBarrier bar; bar.bar = (unsigned*)(argp()->ws + WS_CTL) + CW_BAR; bar.x = 0; bar.st = nullptr;
    if (use_bar) bar = xcd_barrier_post((unsigned*)(argp()->ws + WS_CTL) + CW_BAR, MISC + 8);
#define IN(k) (lo <= (k) && (k) < hi)
#define SEAM(k) do { if (IN(k) && IN((k) + 1)) xcd_barrier(bar); } while (0)
    if (IN(0)) { ph_setup(argp(), mk_tc(), lds); SEAM(0); }
    for (int l = 0; l < DEPTH; ++l) {
        const int pb = 1 + l * PH_PER_LAYER, j = l >> 1; const bool even = (l & 1) == 0;
        if (IN(pb + 0)) { ph_normmod(argp(), mk_tc(), l, 0); SEAM(pb + 0); }
        if (IN(pb + 1)) {
            unsigned char* ws = argp()->ws;
            if (even) { pg8::EpiStore<0> E{(bf16*)(ws + WS_P), EV_IN}; run_gemm<MTOT, EV_IN, DM>(lds, (const bf16*)(ws + WS_U), (const bf16*)(ws + WS_WEVIN) + (size_t)j * EV_IN * DM, E); }
            else      { pg8::EpiStore<0> E{(bf16*)(ws + WS_P), OD_INP}; run_gemm<MTOT, OD_INP, DM>(lds, (const bf16*)(ws + WS_U), (const bf16*)(ws + WS_WODIN) + (size_t)j * OD_INP * DM, E); }
            SEAM(pb + 1);
        }
        if (even) {
            if (IN(pb + 2)) { ph_ev_c1(argp(), mk_tc(), j); SEAM(pb + 2); }
            if (IN(pb + 3)) { ph_ev_c2(argp(), mk_tc(), l, j); SEAM(pb + 3); }
            if (IN(pb + 4)) { ph_ev_c3(argp(), mk_tc()); SEAM(pb + 4); }
            if (IN(pb + 5)) { ph_ev_c4(argp(), mk_tc()); SEAM(pb + 5); }
        } else {
            if (IN(pb + 2)) { ph_od_c1(argp(), mk_tc(), j); SEAM(pb + 2); }
            if (IN(pb + 3)) { ph_od_c23(argp(), mk_tc(), 0, lds); SEAM(pb + 3); }
            if (IN(pb + 4)) { ph_od_c23(argp(), mk_tc(), 1, lds); SEAM(pb + 4); }
            if (IN(pb + 5)) { ph_od_c4(argp(), mk_tc(), j); SEAM(pb + 5); }
        }
        if (IN(pb + 6)) {
            unsigned char* ws = argp()->ws;
            const bf16* Wt = (const bf16*)(ws + (even ? WS_WEVOUT : WS_WODOUT)) + (size_t)j * DM * DM;
            pg8::EpiResid E{(float*)(ws + WS_H), (const float*)(ws + WS_MODS) + (size_t)l * 5 * NMODC, 2, 0};
            run_gemm<MTOT, DM, DM>(lds, (const bf16*)(ws + WS_Y), Wt, E);
            SEAM(pb + 6);
        }
        if (IN(pb + 7)) { ph_normmod(argp(), mk_tc(), l, 1); SEAM(pb + 7); }
        if (IN(pb + 8)) {
            unsigned char* ws = argp()->ws;
            pg8::EpiStore<1> E{(bf16*)(ws + WS_P), DFF};
            run_gemm<MTOT, DFF, DM>(lds, (const bf16*)(ws + WS_U), (const bf16*)(ws + WS_W1) + (size_t)l * DFF * DM, E);
            SEAM(pb + 8);
        }
        if (IN(pb + 9)) {
            unsigned char* ws = argp()->ws;
            pg8::EpiResid E{(float*)(ws + WS_H), (const float*)(ws + WS_MODS) + (size_t)l * 5 * NMODC, 5, 0};
            run_gemm<MTOT, DM, DFF>(lds, (const bf16*)(ws + WS_P), (const bf16*)(ws + WS_W2) + (size_t)l * DM * DFF, E);
            SEAM(pb + 9);
        }
    }
    if (IN(N_PHASES - 1)) ph_final(argp(), mk_tc());
#undef IN
#undef SEAM
}

extern "C" void kernel_launch(void* const* d_in, const int* in_sizes, int n_in, void* d_out, int out_size, void* d_ws, size_t ws_size, hipStream_t stream) {
    static int grid = 0;
    if (grid == 0) {
        if (n_in != 30 || ws_size < WS_END) { fprintf(stderr, "kernel_launch: bad n_in %d or ws %zu\n", n_in, ws_size); grid = -1; return; }
        int dev = 0, cus = 0;
        if (hipGetDevice(&dev) != hipSuccess || hipDeviceGetAttribute(&cus, hipDeviceAttributeMultiprocessorCount, dev) != hipSuccess) { grid = -1; return; }
        if (hipFuncSetAttribute((const void*)mega, hipFuncAttributeMaxDynamicSharedMemorySize, LDS_BYTES) != hipSuccess) { grid = -1; return; }
        (void)hipGetLastError();
        grid = cus;
    }
    if (grid < 0) return;
    (void)hipMemsetAsync((char*)d_ws + WS_CTL, 0, CTL_ZERO_BYTES, stream);
    Args a{};
    for (int i = 0; i < 30; ++i) a.in[i] = (const float*)d_in[i];
    a.out = (float*)d_out; a.ws = (unsigned char*)d_ws;
#ifndef ONE_LAUNCH
    for (int ph = 0; ph < N_PHASES; ++ph) { a.ph_lo = ph; a.ph_hi = ph + 1; hipLaunchKernelGGL(mega, dim3(grid), dim3(NTHR), LDS_BYTES, stream, a); }
#else
    a.ph_lo = 0; a.ph_hi = N_PHASES; hipLaunchKernelGGL(mega, dim3(grid), dim3(NTHR), LDS_BYTES, stream, a);
#endif
}
```

```cpp
#include <hip/hip_runtime.h>
#include <cstdio>
#include <cstdint>
#include <cmath>
#define ONE_LAUNCH 1
#define XL_DPP(v, ctrl) __builtin_bit_cast(float, __builtin_amdgcn_update_dpp(0, __builtin_bit_cast(int, (v)), (ctrl), 0xf, 0xf, true))
__device__ __forceinline__ float sum_row16(float v) { v += XL_DPP(v, 0xB1); v += XL_DPP(v, 0x4E); v += XL_DPP(v, 0x141); v += XL_DPP(v, 0x140); return v; }
__device__ __forceinline__ float max_row16(float v) { v = fmaxf(v, XL_DPP(v, 0xB1)); v = fmaxf(v, XL_DPP(v, 0x4E)); v = fmaxf(v, XL_DPP(v, 0x141)); v = fmaxf(v, XL_DPP(v, 0x140)); return v; }
__device__ __forceinline__ void xl_swap16(unsigned& a, unsigned& b) { asm volatile("s_nop 1\n\tv_permlane16_swap_b32 %0, %1" : "+v"(a), "+v"(b)); }
__device__ __forceinline__ unsigned xl_copy(unsigned a) { unsigned b = a; asm volatile("" : "+v"(b)); return b; }
__device__ __forceinline__ float sum_x16(float v) { unsigned a = __builtin_bit_cast(unsigned, v), b = a; xl_swap16(a, b); return __builtin_bit_cast(float, a) + __builtin_bit_cast(float, b); }
__device__ __forceinline__ float max_x16(float v) { unsigned a = __builtin_bit_cast(unsigned, v), b = a; xl_swap16(a, b); return fmaxf(__builtin_bit_cast(float, a), __builtin_bit_cast(float, b)); }
__device__ __forceinline__ void xl_swap32(unsigned& a, unsigned& b) { asm volatile("s_nop 1\n\tv_permlane32_swap_b32 %0, %1" : "+v"(a), "+v"(b)); }
__device__ __forceinline__ float sum_x32(float v) { unsigned a = __builtin_bit_cast(unsigned, v), b = a; xl_swap32(a, b); return __builtin_bit_cast(float, a) + __builtin_bit_cast(float, b); }
__device__ __forceinline__ float max_x32(float v) { unsigned a = __builtin_bit_cast(unsigned, v), b = a; xl_swap32(a, b); return fmaxf(__builtin_bit_cast(float, a), __builtin_bit_cast(float, b)); }
namespace pg8 {
#define PG8_LAS __attribute__((address_space(3)))
typedef unsigned short bf16_t;
typedef short bf16x8 __attribute__((ext_vector_type(8)));
typedef float f32x4 __attribute__((ext_vector_type(4)));
typedef unsigned u32x4 __attribute__((ext_vector_type(4)));
constexpr int BM = 256, BK = 64, HALF = 128, HTB = HALF * BK * 2  , STAGE_BYTES = 8 * HTB, NXCD = 8, WGM = 8;

__host__ __device__ __forceinline__ int lds_byte(int r, int c) { const int st = (r >> 4) * 2 + (c >> 5), rr = r & 15, cc = c & 31, ob = rr * 64 + cc * 2; return st * 1024 + (ob ^ (((ob >> 9) & 1) << 5)); }
__host__ __device__ __forceinline__ void stage_rc(int b, int& R, int& C) { const int st = b / 1024, sb = b % 1024, swz = sb ^ (((sb >> 9) & 1) << 5); R = (st >> 1) * 16 + swz / 64; C = (st & 1) * 32 + (swz % 64) / 2; }
__host__ __device__ __forceinline__ int perm32(int rho) { const int n = rho >> 4, i = rho & 15; return 8 * (i >> 2) + 4 * n + (i & 3); }

struct Unit { int pm, pn; };
struct Gemm { const bf16_t* A; const bf16_t* Bt; int M, N, K, LD; };

struct StaticOrder {
    int nM, nN, nwg, G, c, wgm;
    __host__ __device__ void init(int M, int N, int G_, int c_, int wgm_ = WGM) { nM = M / BM; nN = N / BM; nwg = nM * nN; G = G_; c = c_; wgm = wgm_; }
    __host__ __device__ bool next(int i, Unit& u) const {
        const long L = (long)i * G + c; if (L >= nwg) return false;
        int wgid = (int)L; { const int q = nwg / NXCD, r = nwg % NXCD, xcd = wgid % NXCD, off = wgid / NXCD; wgid = (xcd < r ? xcd * (q + 1) : r * (q + 1) + (xcd - r) * q) + off; }
        const int nig = wgm * nN, gid = wgid / nig, fm = gid * wgm, gsz = (nM - fm) < wgm ? (nM - fm) : wgm;
        u.pm = fm + ((wgid % nig) % gsz); u.pn = (wgid % nig) / gsz; return true;
    }
    __device__ __forceinline__ void a_ready(const Unit&) const {}
    __device__ __forceinline__ void done(const Unit&) const {}
};

__device__ __forceinline__ unsigned cvt_pk_bf16(float lo, float hi) { unsigned r; asm volatile("v_cvt_pk_bf16_f32 %0, %1, %2" : "=v"(r) : "v"(lo), "v"(hi)); return r; }
typedef float f32x2 __attribute__((ext_vector_type(2)));
template <int ACT, bool ROPE> struct EpiIn {
    static constexpr bool PERM = true, AFTER_DRAIN = false;
    bf16_t* O; int ldc; const float* rowss; const float* bias; int nb; const float* rope; int row_base;
    template <bool COLHALF> __device__ __forceinline__ void body(f32x4 (&acc)[2][2][4][2], const Unit& u, int wr, int wc, int fr_, int fq_) const {
        int fr = fr_, fq = fq_; asm volatile("" : "+v"(fr), "+v"(fq));
        const int prow = row_base + u.pm * BM;
        const int mr = prow < 1024 ? 4 : (prow - 1024) / 4096;
        const int row0 = prow + wr * 64 + fr; const int col0 = u.pn * BM + wc * 32 + 8 * fq;
        {   f32x4 bv[2][2];
#pragma unroll
            for (int bj = 0; bj < 2; ++bj) { bv[bj][0] = *(const f32x4*)(bias + (size_t)mr * nb + col0 + bj * HALF); bv[bj][1] = *(const f32x4*)(bias + (size_t)mr * nb + col0 + bj * HALF + 4); }
            float pq[8][2];
#pragma unroll
            for (int i = 0; i < 8; ++i) { const int row = row0 + (i >> 2) * HALF + (i & 3) * 16; pq[i][0] = rowss[(size_t)(2 * fq) * 17408 + row]; pq[i][1] = rowss[(size_t)(2 * fq + 1) * 17408 + row]; }
#pragma unroll
            for (int i = 0; i < 8; ++i) { float s = pq[i][0] + pq[i][1]; s = ::sum_x32(::sum_x16(s)); const float rs = __builtin_amdgcn_rsqf(s * (1.f / 2048.f) + 1e-6f);
#pragma unroll
                for (int bj = 0; bj < 2; ++bj) { acc[i >> 2][bj][i & 3][0] = acc[i >> 2][bj][i & 3][0] * rs + bv[bj][0]; acc[i >> 2][bj][i & 3][1] = acc[i >> 2][bj][i & 3][1] * rs + bv[bj][1]; } }
        }
        const bool ropeq = ROPE && (u.pn < 8); const bool dorope = ropeq && (prow >= 1024); const float qs = (ROPE && u.pn < 4) ? 0.125f * 1.4426950408889634f : 1.0f;
        f32x4 cc[COLHALF ? 4 : 2][2];
#pragma unroll
        for (int i = 0; i < (COLHALF ? 4 : 2); ++i) { cc[i][0] = (f32x4){1.f, 0.f, 1.f, 0.f}; cc[i][1] = (f32x4){1.f, 0.f, 1.f, 0.f}; }
        if (ROPE) { if (dorope) {
#pragma unroll
            for (int i = 0; i < (COLHALF ? 4 : 2); ++i) { const int tt = (row0 + (COLHALF ? i * 16 : i * HALF) - 1024) & 4095; const int pos = COLHALF ? (tt & 63) : (tt >> 6);
                cc[i][0] = *(const f32x4*)(rope + (pos * 16 + 4 * fq) * 2); cc[i][1] = *(const f32x4*)(rope + (pos * 16 + 4 * fq) * 2 + 4); } } }
#pragma unroll
        for (int ai = 0; ai < 2; ++ai)
#pragma unroll
            for (int m = 0; m < 4; ++m) { const int row = row0 + ai * HALF + m * 16; bf16_t* rowp = O + (size_t)row * ldc + col0;
                const f32x4 c0 = cc[COLHALF ? m : ai][0], c1 = cc[COLHALF ? m : ai][1];
#pragma unroll
                for (int bj = 0; bj < 2; ++bj) { f32x4 v0 = acc[ai][bj][m][0], v1 = acc[ai][bj][m][1];
                    if (ROPE) { if (ropeq) {
                        const f32x4 r0 = {(v0[0] * c0[0] - v0[1] * c0[1]) * qs, (v0[1] * c0[0] + v0[0] * c0[1]) * qs, (v0[2] * c0[2] - v0[3] * c0[3]) * qs, (v0[3] * c0[2] + v0[2] * c0[3]) * qs};
                        const f32x4 r1 = {(v1[0] * c1[0] - v1[1] * c1[1]) * qs, (v1[1] * c1[0] + v1[0] * c1[1]) * qs, (v1[2] * c1[2] - v1[3] * c1[3]) * qs, (v1[3] * c1[2] + v1[2] * c1[3]) * qs};
                        v0 = r0; v1 = r1; } }
                    if (ACT == 1) {
#pragma unroll
                        for (int e = 0; e < 4; ++e) { float a = v0[e] > 0.f ? v0[e] : 0.f; v0[e] = a * a; float b = v1[e] > 0.f ? v1[e] : 0.f; v1[e] = b * b; } }
                    u32x4 w; w.x = cvt_pk_bf16(v0[0], v0[1]); w.y = cvt_pk_bf16(v0[2], v0[3]); w.z = cvt_pk_bf16(v1[0], v1[1]); w.w = cvt_pk_bf16(v1[2], v1[3]);
                    *(u32x4*)(rowp + bj * HALF) = w; } }
    }
    __device__ __forceinline__ void operator()(f32x4 (&acc)[2][2][4][2], const Unit& u, int wr, int wc, int fr, int fq) const {
        if (ROPE && (wc & 1)) body<true>(acc, u, wr, wc, fr, fq); else body<false>(acc, u, wr, wc, fr, fq);
    }
};
struct EpiResid {
    static constexpr bool PERM = true, AFTER_DRAIN = false;
    bf16_t* H; const float* gatev; int row_base;
    bf16_t* U; const float* ng; const float* scv; float* rowss;
    PG8_LAS float* red;
    __device__ __forceinline__ void operator()(const f32x4 (&acc)[2][2][4][2], const Unit& u, int wr, int wc, int fr_, int fq_) const {
        int fr = fr_, fq = fq_; asm volatile("" : "+v"(fr), "+v"(fq));
        const int prow = row_base + u.pm * BM;
        const int mr = prow < 1024 ? 4 : (prow - 1024) / 4096;
        const float* gate = gatev + (size_t)mr * 12288;
        const int col0 = u.pn * BM + wc * 32 + 8 * fq;
        const size_t rowoff = (size_t)(prow + wr * 64 + fr) * 2048 + col0;
        float ss[8];
#pragma unroll
        for (int i = 0; i < 8; ++i) ss[i] = 0.f;
#pragma unroll
        for (int bj = 0; bj < 2; ++bj) { const int co = bj * HALF; const f32x4 g0 = *(const f32x4*)(gate + col0 + co), g1 = *(const f32x4*)(gate + col0 + co + 4);
            u32x4 hv[8];
#pragma unroll
            for (int ai = 0; ai < 2; ++ai)
#pragma unroll
                for (int m = 0; m < 4; ++m) hv[ai * 4 + m] = *(const u32x4*)(H + rowoff + (size_t)(ai * HALF + m * 16) * 2048 + co);
            f32x4 s0 = {0.f, 0.f, 0.f, 0.f}, s1 = s0;
            if (U) { s0 = *(const f32x4*)(ng + col0 + co) * (*(const f32x4*)(scv + (size_t)mr * 12288 + col0 + co) + 1.0f); s1 = *(const f32x4*)(ng + col0 + co + 4) * (*(const f32x4*)(scv + (size_t)mr * 12288 + col0 + co + 4) + 1.0f); }
#pragma unroll
            for (int ai = 0; ai < 2; ++ai)
#pragma unroll
                for (int m = 0; m < 4; ++m) { const u32x4 hw = hv[ai * 4 + m];
                    const f32x4 h0 = {__builtin_bit_cast(float, hw.x << 16), __builtin_bit_cast(float, hw.x & 0xffff0000u), __builtin_bit_cast(float, hw.y << 16), __builtin_bit_cast(float, hw.y & 0xffff0000u)};
                    const f32x4 h1 = {__builtin_bit_cast(float, hw.z << 16), __builtin_bit_cast(float, hw.z & 0xffff0000u), __builtin_bit_cast(float, hw.w << 16), __builtin_bit_cast(float, hw.w & 0xffff0000u)};
                    const f32x4 n0 = h0 + g0 * acc[ai][bj][m][0], n1 = h1 + g1 * acc[ai][bj][m][1];
                    u32x4 w; w.x = cvt_pk_bf16(n0[0], n0[1]); w.y = cvt_pk_bf16(n0[2], n0[3]); w.z = cvt_pk_bf16(n1[0], n1[1]); w.w = cvt_pk_bf16(n1[2], n1[3]);
                    *(u32x4*)(H + rowoff + (size_t)(ai * HALF + m * 16) * 2048 + co) = w;
                    if (U) { const f32x4 a0 = n0 * s0, a1 = n1 * s1; ss[ai * 4 + m] += ((n0[0] * n0[0] + n0[1] * n0[1]) + (n0[2] * n0[2] + n0[3] * n0[3])) + ((n1[0] * n1[0] + n1[1] * n1[1]) + (n1[2] * n1[2] + n1[3] * n1[3]));
                        u32x4 v; v.x = cvt_pk_bf16(a0[0], a0[1]); v.y = cvt_pk_bf16(a0[2], a0[3]); v.z = cvt_pk_bf16(a1[0], a1[1]); v.w = cvt_pk_bf16(a1[2], a1[3]);
                        *(u32x4*)(U + rowoff + (size_t)(ai * HALF + m * 16) * 2048 + co) = v; } }
        }
        if (U) {
#pragma unroll
            for (int i = 0; i < 8; ++i) { float s = ss[i]; s = ::sum_x32(::sum_x16(s));
                if (fq == 0) red[wc * 256 + (i >> 2) * HALF + wr * 64 + (i & 3) * 16 + fr] = s; }
            asm volatile("s_waitcnt lgkmcnt(0)" ::: "memory"); __builtin_amdgcn_s_barrier(); asm volatile("" ::: "memory");
            const int tl = (wr * 4 + wc) * 64 + fq * 16 + fr;
            if (tl < 256) rowss[(size_t)u.pn * 17408 + prow + tl] = (red[tl] + red[256 + tl]) + (red[512 + tl] + red[768 + tl]);
        }
    }
};
struct EpiPartial {
    static constexpr bool PERM = false, AFTER_DRAIN = false;
    float* slab;
    __device__ __forceinline__ void operator()(const f32x4 (&acc)[2][2][4][2], const Unit& u, int wr, int wc, int fr_, int fq_) const {
        int fr = fr_, fq = fq_; asm volatile("" : "+v"(fr), "+v"(fq));
        float* p = slab + (size_t)(u.pm * BM + wr * 64 + fr) * 2048 + u.pn * BM + wc * 32 + 4 * fq;
#pragma unroll
        for (int ai = 0; ai < 2; ++ai)
#pragma unroll
            for (int m = 0; m < 4; ++m)
#pragma unroll
                for (int bj = 0; bj < 2; ++bj)
#pragma unroll
                    for (int n = 0; n < 2; ++n) *(f32x4*)(p + (size_t)(ai * HALF + m * 16) * 2048 + bj * HALF + n * 16) = acc[ai][bj][m][n];
    }
};
struct OneUnit {
    int pm, pn; bool has;
    __device__ __forceinline__ bool next(int i, Unit& u) const { if (i > 0 || !has) return false; u.pm = pm; u.pn = pn; return true; }
    __device__ __forceinline__ void a_ready(const Unit&) const {}
    __device__ __forceinline__ void done(const Unit&) const {}
};
template <class Epi, class Sched, bool ALIGN_EPI = false, bool SP2 = false>
__device__ __forceinline__ void gemm_phase(PG8_LAS unsigned char* lds, const Gemm g, const Sched& S, const Epi& E) {
    int tid_ = threadIdx.x; asm volatile("" : "+v"(tid_)); const int tid = tid_, wid = __builtin_amdgcn_readfirstlane(tid >> 6), lane = tid & 63, wr = wid >> 2, wc = wid & 3, fr = lane & 15, fq = lane >> 4;
    const int K = g.LD, nt = g.K / BK;
    unsigned voffA[2], voffB[2];
#pragma unroll
    for (int i = 0; i < 2; ++i) { int R, C; stage_rc(tid * 16 + i * 8192, R, C); const int Rb = Epi::PERM ? ((R & ~31) + perm32(R & 31)) : R;
        voffA[i] = (unsigned)(R * K + C) * 2u; voffB[i] = (unsigned)(Rb * K + C) * 2u; }
    const size_t kstep = (size_t)(BK * 2);
    const size_t hstep = (size_t)HALF * K * 2;
    const size_t tstep = 2 * hstep;
    const unsigned ldsw = (unsigned)wid * 1024u;
    const int aoff = lds_byte(wr * 64 + fr, fq * 8), boff = lds_byte(wc * 32 + fr, fq * 8);
#define PG8_SA(b, h) (((b) * 2 + (h)) * HTB)
#define PG8_SB(b, h) ((4 + (b) * 2 + (h)) * HTB)
#define PG8_STAGE(bufoff, gbase, voff) do { _Pragma("unroll") for (int _i = 0; _i < 2; ++_i) \
        __builtin_amdgcn_global_load_lds((const unsigned*)((const char*)(gbase) + (voff)[_i]), (PG8_LAS unsigned*)(lds + (bufoff) + ldsw + _i * 8192), 16, 0, 0); } while (0)
#define PG8_LDA(dst, b, h) do { _Pragma("unroll") for (int m = 0; m < 4; ++m) _Pragma("unroll") for (int k = 0; k < 2; ++k) dst[m][k] = *(const PG8_LAS bf16x8*)(lds + PG8_SA(b, h) + aoff + m * 2048 + k * 1024); } while (0)
#define PG8_LDB(dst, b, h) do { _Pragma("unroll") for (int n = 0; n < 2; ++n) _Pragma("unroll") for (int k = 0; k < 2; ++k) dst[n][k] = *(const PG8_LAS bf16x8*)(lds + PG8_SB(b, h) + boff + n * 2048 + k * 1024); } while (0)
#define PG8_MMA(ai, bj, At, Bt) do { __builtin_amdgcn_s_setprio(1); _Pragma("unroll") for (int m = 0; m < 4; ++m) _Pragma("unroll") for (int n = 0; n < 2; ++n) _Pragma("unroll") for (int k = 0; k < 2; ++k) \
        acc[ai][bj][m][n] = __builtin_amdgcn_mfma_f32_16x16x32_bf16(Bt[n][k], At[m][k], acc[ai][bj][m][n], 0, 0, 0); __builtin_amdgcn_s_setprio(0); } while (0)
#define PG8_WAIT_V(n) asm volatile("s_waitcnt vmcnt(" #n ")" ::: "memory")
#define PG8_WAIT_L(n) asm volatile("s_waitcnt lgkmcnt(" #n ")" ::: "memory")
#define PG8_BAR __builtin_amdgcn_s_barrier()
#define PG8_SCHED __builtin_amdgcn_sched_barrier(0)
    Unit cur, nxt; int ui = 0;
    if (!S.next(0, cur)) return;
    f32x4 acc[2][2][4][2];
#pragma unroll
    for (int a = 0; a < 2; ++a)
#pragma unroll
        for (int b = 0; b < 2; ++b)
#pragma unroll
            for (int m = 0; m < 4; ++m)
#pragma unroll
                for (int n = 0; n < 2; ++n) acc[a][b][m][n] = (f32x4){0.f, 0.f, 0.f, 0.f};
    bf16x8 At[4][2], B0[2][2], B1[2][2];
    const char* cA = (const char*)g.A + (size_t)cur.pm * tstep; const char* cB = (const char*)g.Bt + (size_t)cur.pn * tstep;
    S.a_ready(cur);
    if constexpr (SP2) {
        PG8_STAGE(PG8_SB(0, 0), cB, voffB); PG8_STAGE(PG8_SB(0, 1), cB + hstep, voffB); PG8_STAGE(PG8_SA(0, 0), cA, voffA); PG8_STAGE(PG8_SA(0, 1), cA + hstep, voffA);
        if (wr == 1) PG8_BAR;
        PG8_WAIT_V(2); PG8_BAR;
        PG8_STAGE(PG8_SB(1, 0), cB + kstep, voffB); PG8_STAGE(PG8_SA(1, 0), cA + kstep, voffA); PG8_STAGE(PG8_SB(1, 1), cB + hstep + kstep, voffB);
        PG8_WAIT_V(6); PG8_BAR;
    } else {
        PG8_STAGE(PG8_SB(0, 0), cB, voffB); PG8_STAGE(PG8_SA(0, 0), cA, voffA); PG8_STAGE(PG8_SB(0, 1), cB + hstep, voffB); PG8_STAGE(PG8_SA(0, 1), cA + hstep, voffA);
        if (wr == 1) PG8_BAR;
        PG8_WAIT_V(4); PG8_BAR;
        PG8_STAGE(PG8_SB(1, 0), cB + kstep, voffB); PG8_STAGE(PG8_SA(1, 0), cA + kstep, voffA); PG8_STAGE(PG8_SB(1, 1), cB + hstep + kstep, voffB);
        PG8_WAIT_V(6); PG8_BAR;
    }
    for (;;) {
        const bool has_next = S.next(ui + 1, nxt);
        const char* nA = has_next ? (const char*)g.A + (size_t)nxt.pm * tstep : cA; const char* nB = has_next ? (const char*)g.Bt + (size_t)nxt.pn * tstep : cB;
        for (int t = 0; t < nt; t += 2) {
            const bool last = (t == nt - 2);
            const char* a1 = cA + (size_t)(t + 1) * kstep;
            const char* a2 = last ? nA : cA + (size_t)(t + 2) * kstep; const char* b2 = last ? nB : cB + (size_t)(t + 2) * kstep;
            const char* a3 = a2 + kstep; const char* b3 = b2 + kstep;
            if (last && has_next) S.a_ready(nxt);
            if constexpr (SP2) {
            PG8_LDB(B0, 0, 0); PG8_LDB(B1, 0, 1); PG8_SCHED; PG8_LDA(At, 0, 0); PG8_STAGE(PG8_SA(1, 1), a1 + hstep, voffA);
            PG8_WAIT_V(8); PG8_WAIT_L(0); PG8_BAR; PG8_MMA(0, 0, At, B0); PG8_MMA(0, 1, At, B1); PG8_BAR; PG8_SCHED;
            PG8_LDA(At, 0, 1); PG8_STAGE(PG8_SB(0, 0), b2, voffB); PG8_STAGE(PG8_SB(0, 1), b2 + hstep, voffB); PG8_STAGE(PG8_SA(0, 0), a2, voffA);
            PG8_WAIT_V(8); PG8_WAIT_L(0); PG8_BAR; PG8_MMA(1, 0, At, B0); PG8_MMA(1, 1, At, B1); PG8_BAR; PG8_SCHED;
            PG8_LDB(B0, 1, 0); PG8_LDB(B1, 1, 1); PG8_SCHED; PG8_LDA(At, 1, 0); PG8_STAGE(PG8_SA(0, 1), a2 + hstep, voffA);
            PG8_WAIT_V(8); PG8_WAIT_L(0); PG8_BAR; PG8_MMA(0, 0, At, B0); PG8_MMA(0, 1, At, B1); PG8_BAR; PG8_SCHED;
            PG8_LDA(At, 1, 1); PG8_STAGE(PG8_SB(1, 0), b3, voffB); PG8_STAGE(PG8_SB(1, 1), b3 + hstep, voffB); PG8_STAGE(PG8_SA(1, 0), a3, voffA);
            PG8_WAIT_V(8); PG8_WAIT_L(0); PG8_BAR; PG8_MMA(1, 0, At, B0); PG8_MMA(1, 1, At, B1); PG8_BAR; PG8_SCHED;
            } else {
            PG8_LDB(B0, 0, 0); PG8_SCHED; PG8_LDA(At, 0, 0); PG8_STAGE(PG8_SA(1, 1), a1 + hstep, voffA);
            PG8_WAIT_L(8); PG8_BAR; PG8_WAIT_L(0); PG8_MMA(0, 0, At, B0); PG8_BAR; PG8_SCHED;
            PG8_LDB(B1, 0, 1); PG8_STAGE(PG8_SB(0, 0), b2, voffB);
            PG8_BAR; PG8_WAIT_L(0); PG8_MMA(0, 1, At, B1); PG8_BAR;
            PG8_LDA(At, 0, 1); PG8_STAGE(PG8_SA(0, 0), a2, voffA);
            PG8_BAR; PG8_WAIT_L(0); PG8_MMA(1, 0, At, B0); PG8_BAR; PG8_SCHED;
            PG8_STAGE(PG8_SB(0, 1), b2 + hstep, voffB);
            PG8_WAIT_V(6); PG8_BAR; PG8_MMA(1, 1, At, B1); PG8_BAR;
            PG8_LDB(B0, 1, 0); PG8_SCHED; PG8_LDA(At, 1, 0); PG8_STAGE(PG8_SA(0, 1), a2 + hstep, voffA);
            PG8_WAIT_L(8); PG8_BAR; PG8_WAIT_L(0); PG8_MMA(0, 0, At, B0); PG8_BAR; PG8_SCHED;
            PG8_LDB(B1, 1, 1); PG8_STAGE(PG8_SB(1, 0), b3, voffB);
            PG8_BAR; PG8_WAIT_L(0); PG8_MMA(0, 1, At, B1); PG8_BAR;
            PG8_LDA(At, 1, 1); PG8_STAGE(PG8_SA(1, 0), a3, voffA);
            PG8_BAR; PG8_WAIT_L(0); PG8_MMA(1, 0, At, B0); PG8_BAR; PG8_SCHED;
            PG8_STAGE(PG8_SB(1, 1), b3 + hstep, voffB);
            PG8_WAIT_V(6); PG8_BAR; PG8_MMA(1, 1, At, B1); PG8_BAR;
            }
        }
        if constexpr (ALIGN_EPI) { if (wr == 0) PG8_BAR; }
        if constexpr (!Epi::AFTER_DRAIN) { E(acc, cur, wr, wc, fr, fq); S.done(cur); }
        if (!has_next) break;
#pragma unroll
        for (int a = 0; a < 2; ++a)
#pragma unroll
            for (int b = 0; b < 2; ++b)
#pragma unroll
                for (int m = 0; m < 4; ++m)
#pragma unroll
                    for (int n = 0; n < 2; ++n) acc[a][b][m][n] = (f32x4){0.f, 0.f, 0.f, 0.f};
        cur = nxt; cA = nA; cB = nB; ++ui;
        if constexpr (ALIGN_EPI) { if (wr == 1) PG8_BAR; }
    }
    PG8_WAIT_V(0);
    if constexpr (!ALIGN_EPI) { if (wr == 0) PG8_BAR; }
    PG8_BAR;
    if constexpr (Epi::AFTER_DRAIN) { E.fused(acc, cur, wr, wc, fr, fq, lds, wid, lane); S.done(cur); }
#undef PG8_SA
#undef PG8_SB
#undef PG8_STAGE
#undef PG8_LDA
#undef PG8_LDB
#undef PG8_MMA
#undef PG8_WAIT_V
#undef PG8_WAIT_L
#undef PG8_BAR
#undef PG8_SCHED
}
}
#define GAS __attribute__((address_space(1)))
#define LAS __attribute__((address_space(3)))
typedef unsigned short bf16;
typedef unsigned v4u __attribute__((ext_vector_type(4)));
typedef float f32x4 __attribute__((ext_vector_type(4)));
typedef short bf16x8 __attribute__((ext_vector_type(8)));
typedef GAS unsigned gu32;
typedef GAS unsigned long long gu64;
#define RLX_AGENT __ATOMIC_RELAXED, __HIP_MEMORY_SCOPE_AGENT
#define LDS_WAIT() asm volatile("s_waitcnt lgkmcnt(0)" ::: "memory")
#define VM_WAIT() asm volatile("s_waitcnt vmcnt(0)" ::: "memory")
__device__ __forceinline__ unsigned long long rt() { return __builtin_amdgcn_s_memrealtime(); }
typedef __bf16 xbf2_t __attribute__((ext_vector_type(2)));
typedef float xf2_t __attribute__((ext_vector_type(2)));
__device__ __forceinline__ unsigned pk2(float lo, float hi) { return __builtin_bit_cast(unsigned, __builtin_convertvector((xf2_t){lo, hi}, xbf2_t)); }
__device__ __forceinline__ unsigned f2bf(float f) { return (unsigned)__builtin_bit_cast(unsigned short, (__bf16)f); }
#define XB_TMO      128
#define XB_XCNT(j)  (256  + 64 * (j))
#define XB_XSUB(j)  (1280 + 64 * (j))
#define XB_XGEN(j)  (2304 + 64 * (j))
#define XB_TOP      3328
#define XB_TOPGEN   3392
#define XCD_BAR_WORDS 3456
#define XB_SPIN_CAP (1u << 18)

__device__ __forceinline__ unsigned xb_ld(unsigned* p)              { return __hip_atomic_load(p, __ATOMIC_RELAXED, __HIP_MEMORY_SCOPE_AGENT); }
__device__ __forceinline__ unsigned xb_add(unsigned* p, unsigned v) { return __hip_atomic_fetch_add(p, v, __ATOMIC_RELAXED, __HIP_MEMORY_SCOPE_AGENT); }
__device__ __forceinline__ unsigned xb_xcc_id() { return (unsigned)__builtin_amdgcn_s_getreg((3 << 11) | 20) & 0xFu; }
#define XB_SPIN(cond, bar) do { unsigned _sp = 0; while (cond) { __builtin_amdgcn_s_sleep(1); \
    if ((++_sp & 255u) == 0u) { if (xb_ld(&(bar)[XB_TMO])) break; if (_sp > XB_SPIN_CAP) { atomicAdd(&(bar)[XB_TMO], 1u); break; } } } } while (0)

struct XcdBarrier {
    unsigned* bar; unsigned x;
    volatile LAS unsigned* st;
};

__device__ __forceinline__ XcdBarrier xcd_barrier_post(unsigned* bar, volatile LAS unsigned* st) {
    XcdBarrier b; b.bar = bar; b.x = xb_xcc_id(); b.st = st;
    if (threadIdx.x == 0) (void)xb_add(&bar[XB_XCNT(b.x)], 1u);
    return b;
}
__device__ __forceinline__ void xcd_barrier_complete(unsigned* bar, unsigned x, unsigned& nloc, unsigned& nx) {
    const unsigned G = gridDim.x * gridDim.y * gridDim.z;
    unsigned sum, cnt, mine, sp = 0u;
    for (;;) {
        sum = 0u; cnt = 0u; mine = 0u;
#pragma unroll
        for (unsigned j = 0; j < 16; ++j) { const unsigned c = xb_ld(&bar[XB_XCNT(j)]); sum += c; cnt += (c > 0u) ? 1u : 0u; mine = (j == x) ? c : mine; }
        if (sum == G) break;
        __builtin_amdgcn_s_sleep(1);
        if ((++sp & 255u) == 0u) { if (xb_ld(&bar[XB_TMO])) break; if (sp > XB_SPIN_CAP) { atomicAdd(&bar[XB_TMO], 1u); break; } }
    }
    nloc = mine > 0u ? mine : 1u; nx = cnt > 0u ? cnt : 1u;
}

__device__ __forceinline__ void xcd_barrier(const XcdBarrier& b) {
    asm volatile("s_waitcnt vmcnt(0)" ::: "memory");
    __syncthreads();
    if (threadIdx.x == 0) {
        unsigned* bar = b.bar;
        __builtin_amdgcn_s_waitcnt(0);
        unsigned nloc = b.st[0], nx = b.st[1];
        if (nloc == 0u) { xcd_barrier_complete(bar, b.x, nloc, nx); b.st[0] = nloc; b.st[1] = nx; }
        const unsigned old = xb_add(&bar[XB_XSUB(b.x)], 1u);
        const unsigned gen = old / nloc;
        if (old + 1u == (gen + 1u) * nloc) {
            __builtin_amdgcn_fence(__ATOMIC_RELEASE, "agent");
            asm volatile("s_waitcnt vmcnt(0)" ::: "memory");
            const unsigned og = xb_add(&bar[XB_TOP], 1u);
            const unsigned tg = og / nx;
            if (og + 1u == (tg + 1u) * nx) xb_add(&bar[XB_TOPGEN], 1u);
            else XB_SPIN(xb_ld(&bar[XB_TOPGEN]) == tg, bar);
            __builtin_amdgcn_fence(__ATOMIC_ACQUIRE, "agent");
            xb_add(&bar[XB_XGEN(b.x)], 1u);
            asm volatile("s_waitcnt vmcnt(0)" ::: "memory");
        } else {
            XB_SPIN(xb_ld(&bar[XB_XGEN(b.x)]) == gen, bar);
            __builtin_amdgcn_fence(__ATOMIC_ACQUIRE, "agent");
            asm volatile("s_waitcnt vmcnt(0)" ::: "memory");
        }
    }
    __syncthreads();
}
template <bool ROPEPERM = false> __device__ __forceinline__ void p0_transpose_item(const float* W, int K, int N, bf16* WT, int row_off, LAS float* scr, int item, int lane) {
    const int nblk = N / 32, kb = item / nblk, nb = item % nblk, k0 = 64 * kb, n0 = 32 * nb;
    float wv[32];
#pragma unroll
    for (int i = 0; i < 32; ++i) wv[i] = W[(size_t)(k0 + 2 * i + (lane >> 5)) * N + n0 + (lane & 31)];
#pragma unroll
    for (int i = 0; i < 32; ++i) scr[(2 * i + (lane >> 5)) * 33 + (lane & 31)] = wv[i];
    LDS_WAIT(); asm volatile("" ::: "memory");
    const int c = lane & 7;
#pragma unroll
    for (int j = 0; j < 4; ++j) { const int n = (lane >> 3) + 8 * j; const LAS float* s = scr + (8 * c) * 33 + n; const int nd = (ROPEPERM && n0 < 2048) ? 2 * (n & 15) + (n >> 4) : n;
        v4u o; o.x = pk2(s[0 * 33], s[1 * 33]); o.y = pk2(s[2 * 33], s[3 * 33]); o.z = pk2(s[4 * 33], s[5 * 33]); o.w = pk2(s[6 * 33], s[7 * 33]);
        *(GAS v4u*)(WT + (size_t)(row_off + n0 + nd) * K + k0 + 8 * c) = o; }
    LDS_WAIT(); asm volatile("" ::: "memory");
}
namespace att {
using bf16x8 = __attribute__((ext_vector_type(8))) short;
using s16x4  = __attribute__((ext_vector_type(4))) short;
using f32x16 = __attribute__((ext_vector_type(16))) float;
using u32x4  = __attribute__((ext_vector_type(4))) unsigned;
constexpr int KVBLK = 64, LDP = 5120;
constexpr int SHM_V = KVBLK * 128 * 2, SHM_K = KVBLK * 128 * 2;
constexpr float THRN = 8.f;
#define ATT_KSWZ(row, colB) ((row) * 256 + ((colB) ^ (((row) & 7) << 4)))
#define ATT_SBAR() __builtin_amdgcn_sched_barrier(0)
__device__ __forceinline__ int crow(int r, int hi) { return (r & 3) + 8 * (r >> 2) + 4 * hi; }
__device__ __forceinline__ unsigned cvtpk(float lo, float hi) { unsigned r; asm volatile("v_cvt_pk_bf16_f32 %0, %1, %2" : "=v"(r) : "v"(lo), "v"(hi)); return r; }
constexpr float THR2 = 8.f * 1.4426950408889634f;
typedef float f32x2_t __attribute__((ext_vector_type(2)));
template <bool FIRST> __device__ __forceinline__ void partialSM(f32x16& p0, f32x16& p1, float& m_ref, float& alpha) {
  float pmax = p0[0];
#pragma unroll
  for (int r = 1; r < 16; ++r) pmax = fmaxf(pmax, p0[r]);
#pragma unroll
  for (int r = 0; r < 16; ++r) pmax = fmaxf(pmax, p1[r]);
  { auto rr = __builtin_amdgcn_permlane32_swap(__float_as_uint(pmax), __float_as_uint(pmax), false, false);
    pmax = fmaxf(__uint_as_float(rr[0]), __uint_as_float(rr[1])); }
  alpha = 1.f;
  if (FIRST) m_ref = pmax;
  else if (!__builtin_expect(__all(pmax - m_ref <= THR2), 1)) { const float mn = fmaxf(m_ref, pmax); alpha = __builtin_amdgcn_exp2f(m_ref - mn); m_ref = mn; }
  const f32x2_t nm = {-m_ref, -m_ref};
#pragma unroll
  for (int r = 0; r < 16; r += 2) { const f32x2_t a = (f32x2_t){p0[r], p0[r + 1]} + nm, b = (f32x2_t){p1[r], p1[r + 1]} + nm; p0[r] = a.x; p0[r + 1] = a.y; p1[r] = b.x; p1[r + 1] = b.y; }
#pragma unroll
  for (int r = 0; r < 16; ++r) p0[r] = __builtin_amdgcn_exp2f(p0[r]);
}
__device__ __forceinline__ void finishSM(f32x16& p0, f32x16& p1, float alpha, float& l_reg, bf16x8& pa0, bf16x8& pa1, bf16x8& pa2, bf16x8& pa3) {
#pragma unroll
  for (int r = 0; r < 16; ++r) p1[r] = __builtin_amdgcn_exp2f(p1[r]);
  float ps = 0;
#pragma unroll
  for (int r = 0; r < 16; ++r) ps += p0[r];
#pragma unroll
  for (int r = 0; r < 16; ++r) ps += p1[r];
  { auto rr = __builtin_amdgcn_permlane32_swap(__float_as_uint(ps), __float_as_uint(ps), false, false);
    ps = __uint_as_float(rr[0]) + __uint_as_float(rr[1]); }
  l_reg = l_reg * alpha + ps;
#define ATT_PK4(P, BASE, OUT) do { unsigned a0 = cvtpk(P[BASE + 0], P[BASE + 1]), a1 = cvtpk(P[BASE + 2], P[BASE + 3]);   \
    unsigned b0 = cvtpk(P[BASE + 4], P[BASE + 5]), b1 = cvtpk(P[BASE + 6], P[BASE + 7]);                              \
    auto r0 = __builtin_amdgcn_permlane32_swap(a0, b0, false, false); auto r1 = __builtin_amdgcn_permlane32_swap(a1, b1, false, false); \
    u32x4 w = {r0[0], r1[0], r0[1], r1[1]}; OUT = *reinterpret_cast<bf16x8*>(&w); } while (0)
  ATT_PK4(p0, 0, pa0); ATT_PK4(p0, 8, pa1); ATT_PK4(p1, 0, pa2); ATT_PK4(p1, 8, pa3);
#undef ATT_PK4
}
__device__ __forceinline__ void qkt(f32x16& p0, f32x16& p1, const LAS unsigned char* Ks, const bf16x8* qr, int r32, int hi, int mp) {
  p0 = f32x16{}; p1 = f32x16{};
#pragma unroll
  for (int d0 = 0; d0 < 4; ++d0) { const int cb = ((mp * 4 + d0) * 16 + hi * 8) * 2;
    const bf16x8 b0 = *(const LAS bf16x8*)(Ks + ATT_KSWZ(r32, cb));
    const bf16x8 b1 = *(const LAS bf16x8*)(Ks + ATT_KSWZ(32 + r32, cb));
    p0 = __builtin_amdgcn_mfma_f32_32x32x16_bf16(b0, qr[d0], p0, 0, 0, 0);
    p1 = __builtin_amdgcn_mfma_f32_32x32x16_bf16(b1, qr[d0], p1, 0, 0, 0); }
}
__device__ __forceinline__ int v_st(int k, int c) { const int kk = (k & ~0xC) | ((k & 4) << 1) | ((k & 8) >> 1); return ((kk >> 3) * 4 + (c >> 5)) * 512 + ((kk & 7) * 32 + (c & 31)) * 2; }
__device__ __forceinline__ int v_rd_base(int lane) { return ((lane & 3) << 3) | (((lane >> 2) & 3) << 6) | (((lane >> 4) & 1) << 5) | (((lane >> 5) & 1) << 8); }
constexpr int v_rd_off(int d0, int ks, int half) { return d0 * 512 + ks * 4096 + half * 2048; }
template <int OFF> __device__ __forceinline__ s16x4 tr_read(int vb) {
  s16x4 r; asm volatile("ds_read_b64_tr_b16 %0, %1 offset:%2" : "=&v"(r) : "v"(vb), "i"(OFF) : "memory"); return r;
}
template <int D0> __device__ __forceinline__ void pv_one(f32x16& od, int vb, bf16x8 pa0, bf16x8 pa1, bf16x8 pa2, bf16x8 pa3) {
  const s16x4 l0 = tr_read<v_rd_off(D0, 0, 0)>(vb), h0 = tr_read<v_rd_off(D0, 0, 1)>(vb), l1 = tr_read<v_rd_off(D0, 1, 0)>(vb), h1 = tr_read<v_rd_off(D0, 1, 1)>(vb);
  const s16x4 l2 = tr_read<v_rd_off(D0, 2, 0)>(vb), h2 = tr_read<v_rd_off(D0, 2, 1)>(vb), l3 = tr_read<v_rd_off(D0, 3, 0)>(vb), h3 = tr_read<v_rd_off(D0, 3, 1)>(vb);
  asm volatile("s_waitcnt lgkmcnt(0)" ::: "memory"); ATT_SBAR();
#define ATT_PK(L, H) (bf16x8){L[0], L[1], L[2], L[3], H[0], H[1], H[2], H[3]}
  od = __builtin_amdgcn_mfma_f32_32x32x16_bf16(pa0, ATT_PK(l0, h0), od, 0, 0, 0);
  od = __builtin_amdgcn_mfma_f32_32x32x16_bf16(pa1, ATT_PK(l1, h1), od, 0, 0, 0);
  od = __builtin_amdgcn_mfma_f32_32x32x16_bf16(pa2, ATT_PK(l2, h2), od, 0, 0, 0);
  od = __builtin_amdgcn_mfma_f32_32x32x16_bf16(pa3, ATT_PK(l3, h3), od, 0, 0, 0);
#undef ATT_PK
}
__device__ __forceinline__ void pv_d0(f32x16* o, int vb, bf16x8 pa0, bf16x8 pa1, bf16x8 pa2, bf16x8 pa3) {
  pv_one<0>(o[0], vb, pa0, pa1, pa2, pa3); pv_one<1>(o[1], vb, pa0, pa1, pa2, pa3); pv_one<2>(o[2], vb, pa0, pa1, pa2, pa3); pv_one<3>(o[3], vb, pa0, pa1, pa2, pa3);
}

#define ATT_PIN(x) asm volatile("" : "+v"(x))
__device__ __forceinline__ bf16x8 mk_pa(unsigned a, unsigned b, unsigned c, unsigned d) { u32x4 w = {a, b, c, d}; return *reinterpret_cast<bf16x8*>(&w); }
__device__ __forceinline__ void firstSM(f32x16& p0, f32x16& p1, float& m_ref) {
  float pmax = p0[0];
#pragma unroll
  for (int r = 1; r < 16; ++r) pmax = fmaxf(pmax, p0[r]);
#pragma unroll
  for (int r = 0; r < 16; ++r) pmax = fmaxf(pmax, p1[r]);
  { auto rr = __builtin_amdgcn_permlane32_swap(__float_as_uint(pmax), __float_as_uint(pmax), false, false);
    pmax = fmaxf(__uint_as_float(rr[0]), __uint_as_float(rr[1])); }
  m_ref = pmax;
#pragma unroll
  for (int r = 0; r < 16; ++r) { p0[r] = __builtin_amdgcn_exp2f(p0[r] - pmax); p1[r] = __builtin_amdgcn_exp2f(p1[r] - pmax); }
}
__device__ __forceinline__ void finishOnly(const f32x16& p0, const f32x16& p1, float alpha, float& l_reg, bf16x8& pa0, bf16x8& pa1, bf16x8& pa2, bf16x8& pa3) {
  float s0 = 0.f, s1 = 0.f;
#pragma unroll
  for (int r = 0; r < 16; r += 2) { s0 += p0[r]; s1 += p0[r + 1]; }
#pragma unroll
  for (int r = 0; r < 16; r += 2) { s0 += p1[r]; s1 += p1[r + 1]; }
  l_reg = l_reg * alpha + (s0 + s1);
  pa0 = mk_pa(cvtpk(p0[0], p0[1]), cvtpk(p0[2], p0[3]), cvtpk(p0[4], p0[5]), cvtpk(p0[6], p0[7]));
  pa1 = mk_pa(cvtpk(p0[8], p0[9]), cvtpk(p0[10], p0[11]), cvtpk(p0[12], p0[13]), cvtpk(p0[14], p0[15]));
  pa2 = mk_pa(cvtpk(p1[0], p1[1]), cvtpk(p1[2], p1[3]), cvtpk(p1[4], p1[5]), cvtpk(p1[6], p1[7]));
  pa3 = mk_pa(cvtpk(p1[8], p1[9]), cvtpk(p1[10], p1[11]), cvtpk(p1[12], p1[13]), cvtpk(p1[14], p1[15]));
}
__device__ __forceinline__ void phaseA(f32x16& S0, f32x16& S1, const LAS unsigned char* Ks, const bf16x8* qr, int r32, int hi, int mp,
                                       const f32x16& P0, const f32x16& P1, float alphaP, float& l_reg, bf16x8& pa0, bf16x8& pa1, bf16x8& pa2, bf16x8& pa3, float& m0,
                                       int vb, s16x4& vl0, s16x4& vh0, s16x4& vl1, s16x4& vh1, s16x4& vl2, s16x4& vh2, s16x4& vl3, s16x4& vh3) {
  const int cbb = (mp * 64 + hi * 8) * 2;
#define ATT_KF(row, d0) (*(const LAS bf16x8*)(Ks + ATT_KSWZ((row), cbb + (d0) * 32)))
  bf16x8 ka0 = ATT_KF(r32, 0), ka1 = ATT_KF(r32, 1), ka2 = ATT_KF(r32, 2), ka3 = ATT_KF(r32, 3), kb0, kb1, kb2, kb3;
  float s0 = 0.f, s1 = 0.f; unsigned c0, c1, c2, c3, c4, c5, c6, c7;
  S0 = f32x16{}; S1 = f32x16{};
#define ATT_FA(P, B, CA, CB) do { s0 += P[B]; s1 += P[B + 1]; s0 += P[B + 2]; s1 += P[B + 3]; CA = cvtpk(P[B], P[B + 1]); CB = cvtpk(P[B + 2], P[B + 3]); ATT_PIN(s0); ATT_PIN(s1); } while (0)
  ATT_SBAR();
  S0 = __builtin_amdgcn_mfma_f32_32x32x16_bf16(ka0, qr[0], S0, 0, 0, 0); ATT_FA(P0, 0, c0, c1); kb0 = ATT_KF(32 + r32, 0); kb1 = ATT_KF(32 + r32, 1); ATT_SBAR();
  S0 = __builtin_amdgcn_mfma_f32_32x32x16_bf16(ka1, qr[1], S0, 0, 0, 0); ATT_FA(P0, 4, c2, c3); kb2 = ATT_KF(32 + r32, 2); kb3 = ATT_KF(32 + r32, 3); ATT_SBAR();
  pa0 = mk_pa(c0, c1, c2, c3);
  S0 = __builtin_amdgcn_mfma_f32_32x32x16_bf16(ka2, qr[2], S0, 0, 0, 0); ATT_FA(P0, 8, c4, c5); ATT_SBAR();
  S0 = __builtin_amdgcn_mfma_f32_32x32x16_bf16(ka3, qr[3], S0, 0, 0, 0); ATT_FA(P0, 12, c6, c7); ATT_SBAR();
  pa1 = mk_pa(c4, c5, c6, c7);
  S1 = __builtin_amdgcn_mfma_f32_32x32x16_bf16(kb0, qr[0], S1, 0, 0, 0); ATT_FA(P1, 0, c0, c1); vl0 = tr_read<v_rd_off(0, 0, 0)>(vb); vh0 = tr_read<v_rd_off(0, 0, 1)>(vb); ATT_SBAR();
  float ma, mb;
  S1 = __builtin_amdgcn_mfma_f32_32x32x16_bf16(kb1, qr[1], S1, 0, 0, 0); ATT_FA(P1, 4, c2, c3);
  ma = fmaxf(fmaxf(S0[0], S0[1]), S0[2]); mb = fmaxf(fmaxf(S0[3], S0[4]), S0[5]); ATT_PIN(ma); ATT_PIN(mb); vl1 = tr_read<v_rd_off(0, 1, 0)>(vb); vh1 = tr_read<v_rd_off(0, 1, 1)>(vb); ATT_SBAR();
  pa2 = mk_pa(c0, c1, c2, c3);
  S1 = __builtin_amdgcn_mfma_f32_32x32x16_bf16(kb2, qr[2], S1, 0, 0, 0); ATT_FA(P1, 8, c4, c5);
  ma = fmaxf(fmaxf(ma, S0[6]), S0[7]); mb = fmaxf(fmaxf(mb, S0[8]), S0[9]); ma = fmaxf(fmaxf(ma, S0[10]), S0[11]); ATT_PIN(ma); ATT_PIN(mb); vl2 = tr_read<v_rd_off(0, 2, 0)>(vb); vh2 = tr_read<v_rd_off(0, 2, 1)>(vb); ATT_SBAR();
  S1 = __builtin_amdgcn_mfma_f32_32x32x16_bf16(kb3, qr[3], S1, 0, 0, 0); ATT_FA(P1, 12, c6, c7);
  mb = fmaxf(fmaxf(mb, S0[12]), S0[13]); ma = fmaxf(fmaxf(ma, S0[14]), S0[15]); ATT_PIN(ma); ATT_PIN(mb); vl3 = tr_read<v_rd_off(0, 3, 0)>(vb); vh3 = tr_read<v_rd_off(0, 3, 1)>(vb); ATT_SBAR();
  pa3 = mk_pa(c4, c5, c6, c7);
  m0 = fmaxf(ma, mb);
  l_reg = l_reg * alphaP + (s0 + s1);
#undef ATT_FA
#undef ATT_KF
}
__device__ __forceinline__ void decideSM(const f32x16& S1, float m0, float& m_ref, float& alpha) {
  float ma = fmaxf(fmaxf(m0, S1[0]), S1[1]), mb = fmaxf(fmaxf(S1[2], S1[3]), S1[4]);
  ma = fmaxf(fmaxf(ma, S1[5]), S1[6]); mb = fmaxf(fmaxf(mb, S1[7]), S1[8]); ma = fmaxf(fmaxf(ma, S1[9]), S1[10]); mb = fmaxf(fmaxf(mb, S1[11]), S1[12]);
  ma = fmaxf(fmaxf(ma, S1[13]), S1[14]); float pmax = fmaxf(fmaxf(ma, mb), S1[15]);
  alpha = 1.f;
  if (!__builtin_expect(__all(pmax - m_ref <= THR2), 1)) {
    auto rr = __builtin_amdgcn_permlane32_swap(__float_as_uint(pmax), __float_as_uint(pmax), false, false);
    pmax = fmaxf(__uint_as_float(rr[0]), __uint_as_float(rr[1]));
    const float mn = fmaxf(m_ref, pmax); alpha = __builtin_amdgcn_exp2f(m_ref - mn); m_ref = mn; }
}
#define ATT_PK(L, H) (bf16x8){L[0], L[1], L[2], L[3], H[0], H[1], H[2], H[3]}
#define ATT_EXP2(S, E) do { float x0_ = __builtin_amdgcn_exp2f(S[E] - m_ref), x1_ = __builtin_amdgcn_exp2f(S[E + 1] - m_ref); ATT_PIN(x0_); ATT_PIN(x1_); S[E] = x0_; S[E + 1] = x1_; } while (0)
#define ATT_PVG(OD, L0, H0, L1, H1, L2, H2, L3, H3, SX, E0, RDNEXT, D0N, NL0, NH0, NL1, NH1, NL2, NH2, NL3, NH3) do { \
    OD = __builtin_amdgcn_mfma_f32_32x32x16_bf16(pa0, ATT_PK(L0, H0), OD, 0, 0, 0); ATT_EXP2(SX, E0);     if (RDNEXT) { NL0 = tr_read<v_rd_off(D0N, 0, 0)>(vb); NH0 = tr_read<v_rd_off(D0N, 0, 1)>(vb); } ATT_SBAR(); \
    OD = __builtin_amdgcn_mfma_f32_32x32x16_bf16(pa1, ATT_PK(L1, H1), OD, 0, 0, 0); ATT_EXP2(SX, E0 + 2); if (RDNEXT) { NL1 = tr_read<v_rd_off(D0N, 1, 0)>(vb); NH1 = tr_read<v_rd_off(D0N, 1, 1)>(vb); } ATT_SBAR(); \
    OD = __builtin_amdgcn_mfma_f32_32x32x16_bf16(pa2, ATT_PK(L2, H2), OD, 0, 0, 0); ATT_EXP2(SX, E0 + 4); if (RDNEXT) { NL2 = tr_read<v_rd_off(D0N, 2, 0)>(vb); NH2 = tr_read<v_rd_off(D0N, 2, 1)>(vb); } ATT_SBAR(); \
    OD = __builtin_amdgcn_mfma_f32_32x32x16_bf16(pa3, ATT_PK(L3, H3), OD, 0, 0, 0); ATT_EXP2(SX, E0 + 6); if (RDNEXT) { NL3 = tr_read<v_rd_off(D0N, 3, 0)>(vb); NH3 = tr_read<v_rd_off(D0N, 3, 1)>(vb); } \
    asm volatile("s_waitcnt lgkmcnt(0)" ::: "memory"); ATT_SBAR(); } while (0)
__device__ __forceinline__ void phaseB(f32x16* o, int vb, bf16x8 pa0, bf16x8 pa1, bf16x8 pa2, bf16x8 pa3, f32x16& S0, f32x16& S1, float m_ref,
                                       s16x4 al0, s16x4 ah0, s16x4 al1, s16x4 ah1, s16x4 al2, s16x4 ah2, s16x4 al3, s16x4 ah3) {
  s16x4 bl0, bh0, bl1, bh1, bl2, bh2, bl3, bh3;
  asm volatile("s_waitcnt lgkmcnt(0)" ::: "memory"); ATT_SBAR();
  ATT_PVG(o[0], al0, ah0, al1, ah1, al2, ah2, al3, ah3, S0, 0, true, 1, bl0, bh0, bl1, bh1, bl2, bh2, bl3, bh3);
  ATT_PVG(o[1], bl0, bh0, bl1, bh1, bl2, bh2, bl3, bh3, S0, 8, true, 2, al0, ah0, al1, ah1, al2, ah2, al3, ah3);
  ATT_PVG(o[2], al0, ah0, al1, ah1, al2, ah2, al3, ah3, S1, 0, true, 3, bl0, bh0, bl1, bh1, bl2, bh2, bl3, bh3);
  ATT_PVG(o[3], bl0, bh0, bl1, bh1, bl2, bh2, bl3, bh3, S1, 8, false, 3, al0, ah0, al1, ah1, al2, ah2, al3, ah3);
}
__device__ __forceinline__ int tile_row(int b, int t) { return t < 4 ? b * 256 + 64 * t : 1024 + b * 4096 + 64 * (t - 4); }

__device__ __forceinline__ void att_glds(const void* gbase, unsigned voffB, unsigned lds_dst) { unsigned keep;
  asm volatile("s_mov_b32 %0, m0\n\ts_mov_b32 m0, %3\n\ts_nop 0\n\tglobal_load_lds_dwordx4 %1, %2\n\ts_mov_b32 m0, %0" : "=&s"(keep) : "v"(voffB), "s"(gbase), "s"(lds_dst) : "memory"); }
constexpr int SLOT_BYTES = SHM_K + SHM_V;
__device__ __forceinline__ void attn_unit(const unsigned short* __restrict__ P, unsigned short* __restrict__ Y, int b, int hh, int qrow0, int NT, float lam, float post, const float* __restrict__ sg, LAS unsigned char* lds) {
  int tid_ = threadIdx.x; asm volatile("" : "+v"(tid_)); const int tid = tid_, wid = __builtin_amdgcn_readfirstlane(tid >> 6), lane = tid & 63, r32 = lane & 31, hi = lane >> 5, mp = wid >> 2, wq = wid & 3;
  LAS float* wsf = (LAS float*)(lds + 3 * SLOT_BYTES) + wid * 64; LAS float* li_l = wsf; LAS float* al_l = wsf + 32;
  float m_reg = 0.f, l_reg = 0; f32x16 o[4] = {}; bf16x8 qr[4];
  const unsigned short* Qw = P + (size_t)(qrow0 + wq * 32 + r32) * LDP + hh * 128 + mp * 64 + hi * 8;
#pragma unroll
  for (int d0 = 0; d0 < 4; ++d0) qr[d0] = *(const bf16x8*)(Qw + d0 * 16);
  unsigned koff, voff;
  { const int u = wid * 64 + lane;
      { const int row = u >> 4, c16 = (u & 15) ^ (row & 7); koff = (unsigned)(row * LDP + 1024 + hh * 128 + c16 * 8) * 2u; }
      { const int sub = u >> 5, within = u & 31, kk = (sub >> 2) * 8 + (within >> 2), k = kk, c = (sub & 3) * 32 + (within & 3) * 8; voff = (unsigned)(k * LDP + 2048 + hh * 128 + c) * 2u; } }
  const unsigned koff2 = koff + 32u * LDP * 2u, voff2 = voff + 32u * LDP * 2u;
  const unsigned lds0 = (unsigned)(uintptr_t)lds;
#define ATT_DMA(t, slot_off) do { const unsigned short* tb_ = P + (size_t)tile_row(b, (t)) * LDP; const unsigned d_ = lds0 + (slot_off); \
    att_glds(tb_, koff, (unsigned)__builtin_amdgcn_readfirstlane(d_ + wid * 1024)); att_glds(tb_, koff2, (unsigned)__builtin_amdgcn_readfirstlane(d_ + (wid + 8) * 1024)); \
    att_glds(tb_, voff, (unsigned)__builtin_amdgcn_readfirstlane(d_ + SHM_K + wid * 1024)); att_glds(tb_, voff2, (unsigned)__builtin_amdgcn_readfirstlane(d_ + SHM_K + (wid + 8) * 1024)); } while (0)
#define ATT_RESC(a) do { if (__any((a) < 1.f)) { if (hi == 0) al_l[r32] = (a); asm volatile("s_waitcnt lgkmcnt(0)" ::: "memory"); \
    _Pragma("unroll") for (int d = 0; d < 4; ++d) _Pragma("unroll") for (int r = 0; r < 16; ++r) o[d][r] *= al_l[crow(r, hi)]; } } while (0)
#define ATT_WAITBAR(N) asm volatile("s_waitcnt vmcnt(" #N ") lgkmcnt(0)\n\ts_barrier" ::: "memory")
  const int vb0 = (int)lds0 + SHM_K + v_rd_base(lane);
  f32x16 pA0, pA1, pB0, pB1; float alA, alB; bf16x8 pa0, pa1, pa2, pa3;
  int s_cur = 0, s_nxt = SLOT_BYTES, s_nn = 2 * SLOT_BYTES;
#define ATT_ROT() do { const int t_ = s_cur; s_cur = s_nxt; s_nxt = s_nn; s_nn = t_; } while (0)
  ATT_DMA(0, 0); ATT_DMA(1, SLOT_BYTES);
  ATT_WAITBAR(4);
  if (2 < NT) ATT_DMA(2, 2 * SLOT_BYTES);
  qkt(pA0, pA1, lds + s_cur, qr, r32, hi, mp); firstSM(pA0, pA1, m_reg); alA = 1.f;
  if (2 < NT) ATT_WAITBAR(4); else ATT_WAITBAR(0);
  float m0; s16x4 vl0, vh0, vl1, vh1, vl2, vh2, vl3, vh3;
  for (int t = 0; t + 1 < NT; t += 2) {
    phaseA(pB0, pB1, lds + s_nxt, qr, r32, hi, mp, pA0, pA1, alA, l_reg, pa0, pa1, pa2, pa3, m0, vb0 + s_cur, vl0, vh0, vl1, vh1, vl2, vh2, vl3, vh3);
    decideSM(pB1, m0, m_reg, alB); ATT_SBAR();
    phaseB(o, vb0 + s_cur, pa0, pa1, pa2, pa3, pB0, pB1, m_reg, vl0, vh0, vl1, vh1, vl2, vh2, vl3, vh3);
    ATT_RESC(alB);
    ATT_WAITBAR(0);
    if (t + 3 < NT) ATT_DMA(t + 3, s_cur);
    ATT_ROT();
    if (t + 2 < NT) {
      phaseA(pA0, pA1, lds + s_nxt, qr, r32, hi, mp, pB0, pB1, alB, l_reg, pa0, pa1, pa2, pa3, m0, vb0 + s_cur, vl0, vh0, vl1, vh1, vl2, vh2, vl3, vh3);
      decideSM(pA1, m0, m_reg, alA); ATT_SBAR();
      phaseB(o, vb0 + s_cur, pa0, pa1, pa2, pa3, pA0, pA1, m_reg, vl0, vh0, vl1, vh1, vl2, vh2, vl3, vh3);
      ATT_RESC(alA);
      ATT_WAITBAR(0);
      if (t + 4 < NT) ATT_DMA(t + 4, s_cur);
      ATT_ROT();
    }
  }
  finishOnly(pB0, pB1, alB, l_reg, pa0, pa1, pa2, pa3); ATT_SBAR();
  pv_d0(o, vb0 + s_cur, pa0, pa1, pa2, pa3);
  { auto rr = __builtin_amdgcn_permlane32_swap(__float_as_uint(l_reg), __float_as_uint(l_reg), false, false); l_reg = __uint_as_float(rr[0]) + __uint_as_float(rr[1]); }
  if (hi == 0) li_l[r32] = l_reg; asm volatile("s_waitcnt lgkmcnt(0)" ::: "memory");
  float rli[16];
#pragma unroll
  for (int r = 0; r < 16; ++r) rli[r] = __builtin_amdgcn_rcpf(li_l[crow(r, hi)]);
  __syncthreads();
  LAS float* X = (LAS float*)lds;
  if (mp == 1) {
#pragma unroll
    for (int r = 0; r < 16; ++r)
#pragma unroll
      for (int d0 = 0; d0 < 4; ++d0) X[(wq * 32 + crow(r, hi)) * 128 + d0 * 32 + r32] = o[d0][r] * rli[r] * lam;
  }
  __syncthreads();
  if (mp == 0) {
    float ss[16];
#pragma unroll
    for (int r = 0; r < 16; ++r) { float s = 0.f;
#pragma unroll
      for (int d0 = 0; d0 < 4; ++d0) { const float v = o[d0][r] * rli[r] - X[(wq * 32 + crow(r, hi)) * 128 + d0 * 32 + r32]; o[d0][r] = v; s += v * v; }
      ss[r] = s; }
#pragma unroll
    for (int r = 0; r < 16; ++r) {
      ss[r] = ::sum_x16(::sum_row16(ss[r]));
      ss[r] = post * __builtin_amdgcn_rsqf(ss[r] * (1.f / 128.f) + 1e-6f); }
    float gg[4];
#pragma unroll
    for (int d0 = 0; d0 < 4; ++d0) gg[d0] = sg[d0 * 32 + r32];
    unsigned short* Yw = Y + (size_t)(qrow0 + wq * 32) * 2048 + hh * 128 + r32;
#pragma unroll
    for (int r = 0; r < 16; ++r)
#pragma unroll
      for (int d0 = 0; d0 < 4; ++d0) Yw[(size_t)crow(r, hi) * 2048 + d0 * 32] = (unsigned short)f2bf(o[d0][r] * ss[r] * gg[d0]);
  }
  __syncthreads();
#undef ATT_DMA
#undef ATT_WAITBAR
#undef ATT_ROT
#undef ATT_RESC
}
}
namespace gla {
using bf16x8 = __attribute__((ext_vector_type(8))) short;
using f32x4 = __attribute__((ext_vector_type(4))) float;
using u32x4 = __attribute__((ext_vector_type(4))) unsigned;
typedef float f32x2 __attribute__((ext_vector_type(2)));
constexpr int LDP = 6400, NCH = 68;
constexpr int QE_BYTES = 32768, KDT_BYTES = 32768 + 1024, ATT_BYTES = 8192, VT_BYTES = 65536;
constexpr size_t QEI_OFF = 0, KDI_OFF = QEI_OFF + (size_t)2 * 16 * NCH * QE_BYTES, ATT_OFF = KDI_OFF + (size_t)2 * 16 * NCH * KDT_BYTES, VT_OFF = ATT_OFF + (size_t)2 * 16 * NCH * ATT_BYTES,
                 IMG_END = VT_OFF + (size_t)16 * NCH * VT_BYTES;
__device__ __forceinline__ int chunk_row(int b, int c) { return c < 4 ? b * 256 + 64 * c : 1024 + b * 4096 + 64 * (c - 4); }
__device__ __forceinline__ unsigned cvtpk(float lo, float hi) { unsigned r; asm volatile("v_cvt_pk_bf16_f32 %0, %1, %2" : "=v"(r) : "v"(lo), "v"(hi)); return r; }
__device__ __forceinline__ float bf2f_(unsigned short v) { return __builtin_bit_cast(float, (unsigned)v << 16); }
__device__ __forceinline__ int qe_off(int t, int k) { const int ks = k >> 5, k5 = k & 31, g = (k5 & 15) >> 2, j = (k5 & 3) + ((k5 >> 4) << 2); const int ch = (4 * ks + g) ^ (t & 15); return t * 512 + ch * 16 + j * 2; }
__device__ __forceinline__ int r128_off(int r, int cidx) { return r * 128 + ((cidx ^ ((r >> 1) & 7)) << 4); }

__device__ __forceinline__ void prep_item(const unsigned short* __restrict__ P, unsigned char* __restrict__ img, const float* __restrict__ gw2, const float* __restrict__ gb, int c, int b, int hh, LAS unsigned char* lds) {
    int tid_ = threadIdx.x; asm volatile("" : "+v"(tid_)); const int tid = tid_, lane = tid & 63, wid = __builtin_amdgcn_readfirstlane(tid >> 6), g = lane >> 4, r16 = lane & 15;
    const int rb = chunk_row(b, c); const int bh = b * 4 + hh;
    LAS unsigned char* QEI = lds; LAS unsigned char* KEI = lds + 32768; LAS unsigned char* KDI = lds + 65536; LAS unsigned char* ATI = lds + 65536 + KDT_BYTES;
    LAS float* ZT = (LAS float*)(lds + 65536 + KDT_BYTES + ATT_BYTES); LAS float* SEG = ZT + 64 * 32;
    {
        { const int tb = tid & 7, vg = tid >> 3; u32x4 xr[8];
#pragma unroll
          for (int j = 0; j < 8; ++j) xr[j] = *(const u32x4*)(P + (size_t)(rb + 8 * tb + j) * LDP + 2048 + hh * 512 + 8 * vg);
#pragma unroll
          for (int q = 0; q < 8; ++q) { const int v = 8 * vg + q; unsigned ow[4];
#pragma unroll
              for (int w = 0; w < 4; ++w) { const unsigned a = xr[2 * w][q >> 1], bq = xr[2 * w + 1][q >> 1]; ow[w] = (q & 1) ? ((a >> 16) | (bq & 0xffff0000u)) : ((a & 0xffffu) | (bq << 16)); }
              *(LAS u32x4*)(lds + r128_off(v, tb)) = (u32x4){ow[0], ow[1], ow[2], ow[3]}; } }
        for (int e = tid; e < 64 * 32; e += 512) { const int t = e >> 5, i = e & 31; ZT[e] = bf2f_(P[(size_t)(rb + t) * LDP + 6144 + i]); }
        __syncthreads();
        unsigned char* dst = img + VT_OFF + (size_t)(bh * NCH + c) * VT_BYTES;
#pragma unroll
        for (int i = 0; i < 8; ++i) { const int e = tid + i * 512; *(u32x4*)(dst + (size_t)e * 16) = *(const LAS u32x4*)(lds + e * 16); }
        __syncthreads();
    }
    const int k = tid & 255, th = tid >> 8;
#pragma unroll
    for (int i = 0; i < 4; ++i) { const int e = tid + i * 512, t = e >> 5, c16 = e & 31; const size_t ro = (size_t)(rb + t) * LDP + hh * 256 + c16 * 8;
        *(LAS u32x4*)(QEI + t * 512 + c16 * 16) = *(const u32x4*)(P + ro); *(LAS u32x4*)(KEI + t * 512 + c16 * 16) = *(const u32x4*)(P + ro + 1024); }
    __syncthreads();
    float qreg[32], kreg[32];
#pragma unroll
    for (int i = 0; i < 32; ++i) { qreg[i] = bf2f_(*(const LAS unsigned short*)(QEI + (32 * th + i) * 512 + k * 2)) * 0.0625f; kreg[i] = bf2f_(*(const LAS unsigned short*)(KEI + (32 * th + i) * 512 + k * 2)); }
#pragma unroll
    for (int d = 0; d < 2; ++d) {
        f32x2 w2p[8];
#pragma unroll
        for (int i = 0; i < 8; ++i) w2p[i] = (f32x2){gw2[(size_t)(d * 16 + 2 * i) * 1024 + hh * 256 + k], gw2[(size_t)(d * 16 + 2 * i + 1) * 1024 + hh * 256 + k]};
        const float bias = gb[d * 1024 + hh * 256 + k];
        float bc[32]; float run = 0.f;
#pragma unroll
        for (int i = 0; i < 32; ++i) { const int t = d == 0 ? 32 * th + i : 32 * th + 31 - i;
            f32x2 acc = {bias, 0.f};
#pragma unroll
            for (int q4 = 0; q4 < 4; ++q4) { const f32x4 z4 = *(const LAS f32x4*)(ZT + t * 32 + d * 16 + 4 * q4);
                acc = __builtin_elementwise_fma((f32x2){z4[0], z4[1]}, w2p[2 * q4], acc); acc = __builtin_elementwise_fma((f32x2){z4[2], z4[3]}, w2p[2 * q4 + 1], acc); }
            const float x = acc.x + acc.y;
            const float l2 = __builtin_amdgcn_logf(1.0f + __builtin_amdgcn_exp2f(fabsf(x) * -1.4426950408889634f));
            run += __builtin_fmaf(fminf(x, 0.f), 0.0625f * 1.4426950408889634f, l2 * -0.0625f); bc[i] = run; }
        SEG[th * 256 + k] = run;
        __syncthreads();
        const float s0 = SEG[k], s1 = SEG[256 + k]; const float bend = s0 + s1;
        const float pre = d == 0 ? (th == 1 ? s0 : 0.f) : (th == 0 ? s1 : 0.f);
        unsigned kdp[16];
#pragma unroll
        for (int i = 0; i < 16; ++i) kdp[i] = 0u;
#pragma unroll
        for (int i = 0; i < 32; ++i) { const int t = d == 0 ? 32 * th + i : 32 * th + 31 - i; const float bcum = bc[i] + pre;
            const float qv = qreg[d == 0 ? i : 31 - i], kv = kreg[d == 0 ? i : 31 - i];
            const float qe = qv * __builtin_amdgcn_exp2f(bcum), ke = kv * __builtin_amdgcn_exp2f(-bcum), kd = kv * __builtin_amdgcn_exp2f(bend - bcum);
            *(LAS unsigned short*)(QEI + qe_off(t, k)) = (unsigned short)f2bf(qe);
            *(LAS unsigned short*)(KEI + qe_off(t, k)) = (unsigned short)f2bf(ke);
            const int tl = t & 31;
            const unsigned hv = f2bf(kd);
            if (tl & 1) kdp[tl >> 1] = (kdp[tl >> 1] & 0xffffu) | (hv << 16); else kdp[tl >> 1] = (kdp[tl >> 1] & 0xffff0000u) | hv; }
#pragma unroll
        for (int cc = 0; cc < 4; ++cc) *(LAS u32x4*)(KDI + r128_off(k, 4 * th + cc)) = (u32x4){kdp[4 * cc], kdp[4 * cc + 1], kdp[4 * cc + 2], kdp[4 * cc + 3]};
        if (th == 0) *(LAS float*)(KDI + 32768 + 4 * k) = __builtin_amdgcn_exp2f(bend);
        __syncthreads();
        { const int tt = wid >> 1; f32x4 acc[2] = {};
#pragma unroll
          for (int ks = 0; ks < 8; ++ks) { const int trow = 16 * tt + r16; const bf16x8 af = *(const LAS bf16x8*)(QEI + trow * 512 + (((4 * ks + g) ^ (trow & 15)) << 4));
#pragma unroll
            for (int mi = 0; mi < 2; ++mi) { const int mrow = 16 * (2 * (wid & 1) + mi) + r16; const bf16x8 bfr = *(const LAS bf16x8*)(KEI + mrow * 512 + (((4 * ks + g) ^ (mrow & 15)) << 4));
                acc[mi] = __builtin_amdgcn_mfma_f32_16x16x32_bf16(af, bfr, acc[mi], 0, 0, 0); } }
#pragma unroll
          for (int mi = 0; mi < 2; ++mi) { const int m = 16 * (2 * (wid & 1) + mi) + r16;
#pragma unroll
            for (int rg = 0; rg < 4; ++rg) { const int t = 16 * tt + 4 * g + rg; const bool keep = d == 0 ? (m <= t) : (m >= t);
                *(LAS unsigned short*)(ATI + r128_off(t, m >> 3) + (m & 7) * 2) = (unsigned short)f2bf(keep ? acc[mi][rg] : 0.f); } } }
        __syncthreads();
        { const size_t ii = (size_t)((d * 16 + bh) * NCH + c);
          unsigned char* dq = img + QEI_OFF + ii * QE_BYTES; unsigned char* dk = img + KDI_OFF + ii * KDT_BYTES; unsigned char* da = img + ATT_OFF + ii * ATT_BYTES;
#pragma unroll
          for (int i = 0; i < 4; ++i) { const int e = tid + i * 512; *(u32x4*)(dq + (size_t)e * 16) = *(const LAS u32x4*)(QEI + e * 16); }
          for (int e = tid; e < KDT_BYTES / 16; e += 512) *(u32x4*)(dk + (size_t)e * 16) = *(const LAS u32x4*)(KDI + e * 16);
          *(u32x4*)(da + (size_t)tid * 16) = *(const LAS u32x4*)(ATI + tid * 16); }
        __syncthreads();
    }
}

template <int DD> __device__ __forceinline__ void prep_half(const unsigned short* __restrict__ P, unsigned char* __restrict__ img, const float* __restrict__ gw2, const float* __restrict__ gb, int c, int b, int hh, LAS unsigned char* lds) {
    int tid_ = threadIdx.x; asm volatile("" : "+v"(tid_)); const int tid = tid_, lane = tid & 63, wid = __builtin_amdgcn_readfirstlane(tid >> 6), g = lane >> 4, r16 = lane & 15;
    const int rb = chunk_row(b, c); const int bh = b * 4 + hh;
    LAS unsigned char* QEI = lds; LAS unsigned char* KEI = lds + 32768; LAS unsigned char* KDI = lds + 65536; LAS unsigned char* ATI = lds + 65536 + KDT_BYTES;
    LAS float* ZT = (LAS float*)(lds + 65536 + KDT_BYTES + ATT_BYTES); LAS float* SEG = ZT + 64 * 32;
    __syncthreads();
    if (DD == 0) {
        { const int tb = tid & 7, vg = tid >> 3; u32x4 xr[8];
#pragma unroll
          for (int j = 0; j < 8; ++j) xr[j] = *(const u32x4*)(P + (size_t)(rb + 8 * tb + j) * LDP + 2048 + hh * 512 + 8 * vg);
#pragma unroll
          for (int q = 0; q < 8; ++q) { const int v = 8 * vg + q; unsigned ow[4];
#pragma unroll
              for (int w = 0; w < 4; ++w) { const unsigned a = xr[2 * w][q >> 1], bq = xr[2 * w + 1][q >> 1]; ow[w] = (q & 1) ? ((a >> 16) | (bq & 0xffff0000u)) : ((a & 0xffffu) | (bq << 16)); }
              *(LAS u32x4*)(lds + r128_off(v, tb)) = (u32x4){ow[0], ow[1], ow[2], ow[3]}; } }
        __syncthreads();
        unsigned char* dst = img + VT_OFF + (size_t)(bh * NCH + c) * VT_BYTES;
#pragma unroll
        for (int i = 0; i < 8; ++i) { const int e = tid + i * 512; *(u32x4*)(dst + (size_t)e * 16) = *(const LAS u32x4*)(lds + e * 16); }
        __syncthreads();
    }
    for (int e = tid; e < 64 * 32; e += 512) { const int t = e >> 5, i = e & 31; ZT[e] = bf2f_(P[(size_t)(rb + t) * LDP + 6144 + i]); }
    __syncthreads();
    const int k = tid & 255, th = tid >> 8;
#pragma unroll
    for (int i = 0; i < 4; ++i) { const int e = tid + i * 512, t = e >> 5, c16 = e & 31; const size_t ro = (size_t)(rb + t) * LDP + hh * 256 + c16 * 8;
        *(LAS u32x4*)(QEI + t * 512 + c16 * 16) = *(const u32x4*)(P + ro); *(LAS u32x4*)(KEI + t * 512 + c16 * 16) = *(const u32x4*)(P + ro + 1024); }
    __syncthreads();
    float qreg[32], kreg[32];
#pragma unroll
    for (int i = 0; i < 32; ++i) { qreg[i] = bf2f_(*(const LAS unsigned short*)(QEI + (32 * th + i) * 512 + k * 2)) * 0.0625f; kreg[i] = bf2f_(*(const LAS unsigned short*)(KEI + (32 * th + i) * 512 + k * 2)); }
    { constexpr int d = DD;
        f32x2 w2p[8];
#pragma unroll
        for (int i = 0; i < 8; ++i) w2p[i] = (f32x2){gw2[(size_t)(d * 16 + 2 * i) * 1024 + hh * 256 + k], gw2[(size_t)(d * 16 + 2 * i + 1) * 1024 + hh * 256 + k]};
        const float bias = gb[d * 1024 + hh * 256 + k];
        float bc[32]; float run = 0.f;
#pragma unroll
        for (int i = 0; i < 32; ++i) { const int t = d == 0 ? 32 * th + i : 32 * th + 31 - i;
            f32x2 acc = {bias, 0.f};
#pragma unroll
            for (int q4 = 0; q4 < 4; ++q4) { const f32x4 z4 = *(const LAS f32x4*)(ZT + t * 32 + d * 16 + 4 * q4);
                acc = __builtin_elementwise_fma((f32x2){z4[0], z4[1]}, w2p[2 * q4], acc); acc = __builtin_elementwise_fma((f32x2){z4[2], z4[3]}, w2p[2 * q4 + 1], acc); }
            const float x = acc.x + acc.y;
            const float l2 = __builtin_amdgcn_logf(1.0f + __builtin_amdgcn_exp2f(fabsf(x) * -1.4426950408889634f));
            run += __builtin_fmaf(fminf(x, 0.f), 0.0625f * 1.4426950408889634f, l2 * -0.0625f); bc[i] = run; }
        SEG[th * 256 + k] = run;
        __syncthreads();
        const float s0 = SEG[k], s1 = SEG[256 + k]; const float bend = s0 + s1;
        const float pre = d == 0 ? (th == 1 ? s0 : 0.f) : (th == 0 ? s1 : 0.f);
        unsigned kdp[16];
#pragma unroll
        for (int i = 0; i < 16; ++i) kdp[i] = 0u;
#pragma unroll
        for (int i = 0; i < 32; ++i) { const int t = d == 0 ? 32 * th + i : 32 * th + 31 - i; const float bcum = bc[i] + pre;
            const float qv = qreg[d == 0 ? i : 31 - i], kv = kreg[d == 0 ? i : 31 - i];
            const float qe = qv * __builtin_amdgcn_exp2f(bcum), ke = kv * __builtin_amdgcn_exp2f(-bcum), kd = kv * __builtin_amdgcn_exp2f(bend - bcum);
            *(LAS unsigned short*)(QEI + qe_off(t, k)) = (unsigned short)f2bf(qe);
            *(LAS unsigned short*)(KEI + qe_off(t, k)) = (unsigned short)f2bf(ke);
            const int tl = t & 31;
            const unsigned hv = f2bf(kd);
            if (tl & 1) kdp[tl >> 1] = (kdp[tl >> 1] & 0xffffu) | (hv << 16); else kdp[tl >> 1] = (kdp[tl >> 1] & 0xffff0000u) | hv; }
#pragma unroll
        for (int cc = 0; cc < 4; ++cc) *(LAS u32x4*)(KDI + r128_off(k, 4 * th + cc)) = (u32x4){kdp[4 * cc], kdp[4 * cc + 1], kdp[4 * cc + 2], kdp[4 * cc + 3]};
        if (th == 0) *(LAS float*)(KDI + 32768 + 4 * k) = __builtin_amdgcn_exp2f(bend);
        __syncthreads();
        { const int tt = wid >> 1; f32x4 acc[2] = {};
#pragma unroll
          for (int ks = 0; ks < 8; ++ks) { const int trow = 16 * tt + r16; const bf16x8 af = *(const LAS bf16x8*)(QEI + trow * 512 + (((4 * ks + g) ^ (trow & 15)) << 4));
#pragma unroll
            for (int mi = 0; mi < 2; ++mi) { const int mrow = 16 * (2 * (wid & 1) + mi) + r16; const bf16x8 bfr = *(const LAS bf16x8*)(KEI + mrow * 512 + (((4 * ks + g) ^ (mrow & 15)) << 4));
                acc[mi] = __builtin_amdgcn_mfma_f32_16x16x32_bf16(af, bfr, acc[mi], 0, 0, 0); } }
#pragma unroll
          for (int mi = 0; mi < 2; ++mi) { const int m = 16 * (2 * (wid & 1) + mi) + r16;
#pragma unroll
            for (int rg = 0; rg < 4; ++rg) { const int t = 16 * tt + 4 * g + rg; const bool keep = d == 0 ? (m <= t) : (m >= t);
                *(LAS unsigned short*)(ATI + r128_off(t, m >> 3) + (m & 7) * 2) = (unsigned short)f2bf(keep ? acc[mi][rg] : 0.f); } } }
        __syncthreads();
        { const size_t ii = (size_t)((d * 16 + bh) * NCH + c);
          unsigned char* dq = img + QEI_OFF + ii * QE_BYTES; unsigned char* dk = img + KDI_OFF + ii * KDT_BYTES; unsigned char* da = img + ATT_OFF + ii * ATT_BYTES;
#pragma unroll
          for (int i = 0; i < 4; ++i) { const int e = tid + i * 512; *(u32x4*)(dq + (size_t)e * 16) = *(const LAS u32x4*)(QEI + e * 16); }
          for (int e = tid; e < KDT_BYTES / 16; e += 512) *(u32x4*)(dk + (size_t)e * 16) = *(const LAS u32x4*)(KDI + e * 16);
          *(u32x4*)(da + (size_t)tid * 16) = *(const LAS u32x4*)(ATI + tid * 16); }
        __syncthreads();
    }
}

__device__ __forceinline__ void gl_dma(const void* gbase, unsigned voffB, unsigned lds_dst) { unsigned keep;
  asm volatile("s_mov_b32 %0, m0\n\ts_mov_b32 m0, %3\n\ts_nop 0\n\tglobal_load_lds_dwordx4 %1, %2\n\ts_mov_b32 m0, %0" : "=&s"(keep) : "v"(voffB), "s"(gbase), "s"(lds_dst) : "memory"); }
__device__ __forceinline__ void oq_store(unsigned short* __restrict__ OQ, size_t elt0, unsigned so0, const f32x4 (&oa)[4], const f32x4 (&ob)[4]) {
    unsigned char* base = (unsigned char*)(OQ + elt0);
#pragma unroll
    for (int tt = 0; tt < 4; ++tt) { const f32x4 o = oa[tt] + ob[tt]; const unsigned p01 = cvtpk(o[0], o[1]), p23 = cvtpk(o[2], o[3]);
        unsigned f0 = so0 + (tt * 16 + 0) * 4096, f1 = so0 + (tt * 16 + 1) * 4096, f2 = so0 + (tt * 16 + 2) * 4096, f3 = so0 + (tt * 16 + 3) * 4096;
        asm volatile("" : "+v"(f0), "+v"(f1), "+v"(f2), "+v"(f3));
        *(unsigned short*)(base + f0) = (unsigned short)p01; *(unsigned short*)(base + f1) = (unsigned short)(p01 >> 16);
        *(unsigned short*)(base + f2) = (unsigned short)p23; *(unsigned short*)(base + f3) = (unsigned short)(p23 >> 16); }
}
constexpr int STAGE_BYTES = QE_BYTES + KDT_BYTES, SEQ_LDS = 2 * STAGE_BYTES + 16384;
__device__ __forceinline__ void seq_unit(const unsigned char* __restrict__ img, unsigned short* __restrict__ OQ  , int b, int hh, int d, int vs, LAS unsigned char* lds) {
    int tid_ = threadIdx.x; asm volatile("" : "+v"(tid_)); const int tid = tid_, lane = tid & 63, wid = __builtin_amdgcn_readfirstlane(tid >> 6), g = lane >> 4, r16 = lane & 15, kh = wid >> 2, vq = wid & 3;
    const int bh = b * 4 + hh;
    LAS float* XCH = (LAS float*)(lds + 2 * STAGE_BYTES);
    f32x4 S[8] = {}; f32x4 oprev[4] = {}; int rb_prev = 0;
    bf16x8 vfr[2], afr[4];
    const int vrow = vs * 64 + vq * 16 + r16;
    const unsigned vo0 = (unsigned)(wid * 1024 + lane * 16);
    const unsigned so0 = (unsigned)((4 * g * 2048 + vq * 16 + r16) * 2);
#define GLA_CSEQ(i) (d == 0 ? (i) : ((i) < 4 ? 3 - (i) : 71 - (i)))
#define GLA_ISSUE(ci, bufsel) do { const int c_ = (ci); const size_t ii_ = (size_t)((d * 16 + bh) * NCH + c_); \
        const unsigned char* sq_ = img + QEI_OFF + ii_ * QE_BYTES; const unsigned char* sk_ = img + KDI_OFF + ii_ * KDT_BYTES; LAS unsigned char* db_ = lds + (bufsel) * STAGE_BYTES; \
        const unsigned dl_ = (unsigned)(uintptr_t)db_ + wid * 1024; \
        _Pragma("unroll") for (int r_ = 0; r_ < 4; ++r_) { gl_dma(sq_ + r_ * 8192, vo0, (unsigned)__builtin_amdgcn_readfirstlane(dl_ + r_ * 8192)); gl_dma(sk_ + r_ * 8192, vo0, (unsigned)__builtin_amdgcn_readfirstlane(dl_ + 32768 + r_ * 8192)); } \
        if (wid == 0) gl_dma(sk_ + 32768, vo0, (unsigned)__builtin_amdgcn_readfirstlane(dl_ + 65536)); \
        const unsigned char* sv_ = img + VT_OFF + (size_t)(bh * NCH + c_) * VT_BYTES; \
        vfr[0] = *(const bf16x8*)(sv_ + r128_off(vrow, g)); vfr[1] = *(const bf16x8*)(sv_ + r128_off(vrow, 4 + g)); \
        const unsigned char* sa_ = img + ATT_OFF + ii_ * ATT_BYTES; \
        _Pragma("unroll") for (int tt = 0; tt < 4; ++tt) afr[tt] = *(const bf16x8*)(sa_ + r128_off(16 * tt + r16, 4 * kh + g)); } while (0)
    __syncthreads();
    GLA_ISSUE(GLA_CSEQ(0), 0);
    for (int i = 0; i < NCH; ++i) {
        const int c = GLA_CSEQ(i); const int rb = chunk_row(b, c);
        LAS unsigned char* QEI = lds + (i & 1) * STAGE_BYTES; LAS unsigned char* KDI = QEI + QE_BYTES; LAS float* EB = (LAS float*)(KDI + 32768);
        if (kh == 0 && i >= 2) asm volatile("s_waitcnt vmcnt(16) lgkmcnt(0)\n\ts_barrier" ::: "memory");
        else asm volatile("s_waitcnt vmcnt(0) lgkmcnt(0)\n\ts_barrier" ::: "memory");
        const bf16x8 vf0 = vfr[0], vf1 = vfr[1]; bf16x8 af[4];
#pragma unroll
        for (int tt = 0; tt < 4; ++tt) af[tt] = afr[tt];
        if (i + 1 < NCH) GLA_ISSUE(GLA_CSEQ(i + 1), (i + 1) & 1);
        f32x4 xin[4];
        if (i > 0 && kh == 0) {
#pragma unroll
            for (int tt = 0; tt < 4; ++tt) xin[tt] = *(const LAS f32x4*)(XCH + ((vq * 4 + tt) * 64 + lane) * 4); }
        asm volatile("s_waitcnt lgkmcnt(0)\n\ts_barrier" ::: "memory");
        bf16x8 qa[4][4];
#define GLA_QRD(tt) do { const int trow_ = 16 * (tt) + r16; _Pragma("unroll") for (int ks = 0; ks < 4; ++ks) qa[tt][ks] = *(const LAS bf16x8*)(QEI + trow_ * 512 + (((16 * kh + 4 * ks + g) ^ (trow_ & 15)) << 4)); } while (0)
#define GLA_QMF(tt) do { _Pragma("unroll") for (int ks = 0; ks < 4; ++ks) o[tt] = __builtin_amdgcn_mfma_f32_16x16x32_bf16(qa[tt][ks], sb[ks], o[tt], 0, 0, 0); \
            o[tt] = __builtin_amdgcn_mfma_f32_16x16x32_bf16(af[tt], kh == 0 ? vf0 : vf1, o[tt], 0, 0, 0); } while (0)
        GLA_QRD(0);
        if (i > 0 && kh == 0) oq_store(OQ, ((size_t)d * 17408 + rb_prev) * 2048 + hh * 512 + vs * 64, so0, oprev, xin);
        bf16x8 sb[4];
#pragma unroll
        for (int ks = 0; ks < 4; ++ks) { u32x4 w; w.x = cvtpk(S[2 * ks][0], S[2 * ks][1]); w.y = cvtpk(S[2 * ks][2], S[2 * ks][3]); w.z = cvtpk(S[2 * ks + 1][0], S[2 * ks + 1][1]); w.w = cvtpk(S[2 * ks + 1][2], S[2 * ks + 1][3]);
            sb[ks] = __builtin_bit_cast(bf16x8, w); }
        f32x4 o[4] = {};
        __builtin_amdgcn_sched_barrier(0);
        GLA_QRD(1);
        __builtin_amdgcn_sched_barrier(0);
        GLA_QMF(0); GLA_QRD(2);
        __builtin_amdgcn_sched_barrier(0);
        GLA_QMF(1); GLA_QRD(3);
        __builtin_amdgcn_sched_barrier(0);
        GLA_QMF(2);
        __builtin_amdgcn_sched_barrier(0);
        GLA_QMF(3);
        __builtin_amdgcn_sched_barrier(0);
#undef GLA_QRD
#undef GLA_QMF
        if (kh == 1) {
#pragma unroll
            for (int tt = 0; tt < 4; ++tt) *(LAS f32x4*)(XCH + ((vq * 4 + tt) * 64 + lane) * 4) = o[tt];
        } else {
#pragma unroll
            for (int tt = 0; tt < 4; ++tt) oprev[tt] = o[tt];
        }
        rb_prev = rb;
        f32x4 e4[8]; bf16x8 ka0[8], ka1[8];
#define GLA_SRD(kt) do { const int krow0_ = 128 * kh + 16 * (kt), kr_ = krow0_ + r16; e4[kt] = *(const LAS f32x4*)(EB + krow0_ + 4 * g); \
            ka0[kt] = *(const LAS bf16x8*)(KDI + r128_off(kr_, g)); ka1[kt] = *(const LAS bf16x8*)(KDI + r128_off(kr_, 4 + g)); } while (0)
#define GLA_SUP(k0) do { S[k0] = S[k0] * e4[k0]; S[(k0) + 1] = S[(k0) + 1] * e4[(k0) + 1]; \
            S[k0] = __builtin_amdgcn_mfma_f32_16x16x32_bf16(ka0[k0], vf0, S[k0], 0, 0, 0); S[(k0) + 1] = __builtin_amdgcn_mfma_f32_16x16x32_bf16(ka0[(k0) + 1], vf0, S[(k0) + 1], 0, 0, 0); \
            S[k0] = __builtin_amdgcn_mfma_f32_16x16x32_bf16(ka1[k0], vf1, S[k0], 0, 0, 0); S[(k0) + 1] = __builtin_amdgcn_mfma_f32_16x16x32_bf16(ka1[(k0) + 1], vf1, S[(k0) + 1], 0, 0, 0); } while (0)
        GLA_SRD(0); GLA_SRD(1); GLA_SRD(2); GLA_SRD(3);
        __builtin_amdgcn_sched_barrier(0);
        GLA_SUP(0); GLA_SRD(4); GLA_SRD(5);
        __builtin_amdgcn_sched_barrier(0);
        GLA_SUP(2); GLA_SRD(6); GLA_SRD(7);
        __builtin_amdgcn_sched_barrier(0);
        GLA_SUP(4);
        __builtin_amdgcn_sched_barrier(0);
        GLA_SUP(6);
#undef GLA_SRD
#undef GLA_SUP
    }
    __syncthreads();
    if (kh == 0) { f32x4 xl[4];
#pragma unroll
        for (int tt = 0; tt < 4; ++tt) xl[tt] = *(const LAS f32x4*)(XCH + ((vq * 4 + tt) * 64 + lane) * 4);
        oq_store(OQ, ((size_t)d * 17408 + rb_prev) * 2048 + hh * 512 + vs * 64, so0, oprev, xl); }
    __syncthreads();
#undef GLA_ISSUE
#undef GLA_CSEQ
}
}
namespace lru {
using bf16x8 = __attribute__((ext_vector_type(8))) short;
using f32x4 = __attribute__((ext_vector_type(4))) float;
using u32x4 = __attribute__((ext_vector_type(4))) unsigned;
constexpr int LDP = 5120, NCH = 68, MROWS = 17408;
constexpr size_t HL_OFF = 0, AC_OFF = (size_t)2 * MROWS * 1024 * 2, AGGA_OFF = (size_t)4 * MROWS * 1024 * 2, AGGH_OFF = AGGA_OFF + (size_t)2 * 4 * NCH * 1024 * 4, LRU_END = AGGH_OFF + (size_t)2 * 4 * NCH * 1024 * 4;
__device__ __forceinline__ int chunk_row(int b, int c) { return c < 4 ? b * 256 + 64 * c : 1024 + b * 4096 + 64 * (c - 4); }
__device__ __forceinline__ float bf2f_(unsigned short v) { return __builtin_bit_cast(float, (unsigned)v << 16); }
__device__ __forceinline__ float sigm(float x) { return __builtin_amdgcn_rcpf(1.f + __builtin_amdgcn_exp2f(x * -1.4426950408889634f)); }
#define LRU_CSEQ(d, i) ((d) == 0 ? (i) : ((i) < 4 ? 3 - (i) : 71 - (i)))
#define LRU_POS(d, c) ((d) == 0 ? (c) : ((c) < 4 ? 3 - (c) : 71 - (c)))

struct Wreg { bf16x8 w[2][2][4]; float ba[2], bx[2], sp[2]; };

__device__ __forceinline__ void load_w(Wreg& W, const unsigned short* __restrict__ WT  , const float* __restrict__ ba, const float* __restrict__ bx, const float* __restrict__ lam  ,
                                       int n, int wid, int lane) {
    const int d = wid >> 2, g = lane >> 4, r16 = lane & 15;
#pragma unroll
    for (int mat = 0; mat < 2; ++mat)
#pragma unroll
        for (int ct = 0; ct < 2; ++ct) { const int j = 16 * (2 * (wid & 3) + ct) + r16;
#pragma unroll
            for (int ks = 0; ks < 4; ++ks) W.w[mat][ct][ks] = *(const bf16x8*)(WT + ((size_t)(((d * 2 + mat) * 8 + n) * 128 + j)) * 128 + 32 * ks + 8 * g); }
#pragma unroll
    for (int ct = 0; ct < 2; ++ct) { const int ch = n * 128 + 16 * (2 * (wid & 3) + ct) + r16;
        W.ba[ct] = ba[d * 1024 + ch]; W.bx[ct] = bx[d * 1024 + ch]; W.sp[ct] = -8.0f * 1.4426950408889634f * log1pf(expf(-lam[d * 1024 + ch])); }
}

template <int d> __device__ __forceinline__ void lru_scan(const Wreg& W, const LAS unsigned char* XB, const LAS float* XF, LAS unsigned short* OUTB, int wid, int g, int r16, float (&cA)[2], float (&cH)[2]) {
#pragma unroll
    for (int ti = 0; ti < 4; ++ti) { const int tt = d == 0 ? ti : 3 - ti;
        f32x4 acc[2][2] = {};
#pragma unroll
        for (int ks = 0; ks < 4; ++ks) { const int trow = 16 * tt + r16; const bf16x8 af = *(const LAS bf16x8*)(XB + trow * 256 + (((4 * ks + g) ^ (trow & 15)) << 4));
#pragma unroll
            for (int mat = 0; mat < 2; ++mat)
#pragma unroll
                for (int ct = 0; ct < 2; ++ct) acc[mat][ct] = __builtin_amdgcn_mfma_f32_16x16x32_bf16(af, W.w[mat][ct][ks], acc[mat][ct], 0, 0, 0); }
#pragma unroll
        for (int ct = 0; ct < 2; ++ct) { const int chl = 16 * (2 * (wid & 3) + ct) + r16;
            float av[4], bv[4];
#pragma unroll
            for (int rg = 0; rg < 4; ++rg) { const int t = 16 * tt + 4 * g + rg; const float xc = XF[t * 128 + chl];
                const float r = sigm(acc[0][ct][rg] + W.ba[ct]), gi = sigm(acc[1][ct][rg] + W.bx[ct]);
                const float a = __builtin_amdgcn_exp2f(r * W.sp[ct]); av[rg] = a; bv[rg] = __builtin_amdgcn_sqrtf(__builtin_fmaf(-a, a, 1.0f)) * gi * xc; }
            float hl[4], al[4]; float h = 0.f, Ap = 1.f;
#pragma unroll
            for (int q = 0; q < 4; ++q) { const int rg = d == 0 ? q : 3 - q; h = av[rg] * h + bv[rg]; Ap *= av[rg]; hl[rg] = h; al[rg] = Ap; }
            float gA[4], gH[4];
            {
              unsigned pa[2] = {__builtin_bit_cast(unsigned, Ap), __builtin_bit_cast(unsigned, Ap)}, ph[2] = {__builtin_bit_cast(unsigned, h), __builtin_bit_cast(unsigned, h)}; ::xl_swap16(pa[0], pa[1]); ::xl_swap16(ph[0], ph[1]);
              unsigned a02[2] = {pa[0], pa[0]}, a13[2] = {pa[1], pa[1]}, h02[2] = {ph[0], ph[0]}, h13[2] = {ph[1], ph[1]};
              ::xl_swap32(a02[0], a02[1]); ::xl_swap32(a13[0], a13[1]); ::xl_swap32(h02[0], h02[1]); ::xl_swap32(h13[0], h13[1]);
              gA[0] = __builtin_bit_cast(float, a02[0]); gA[1] = __builtin_bit_cast(float, a13[0]); gA[2] = __builtin_bit_cast(float, a02[1]); gA[3] = __builtin_bit_cast(float, a13[1]);
              gH[0] = __builtin_bit_cast(float, h02[0]); gH[1] = __builtin_bit_cast(float, h13[0]); gH[2] = __builtin_bit_cast(float, h02[1]); gH[3] = __builtin_bit_cast(float, h13[1]); }
            float Ain = cA[ct], hin = cH[ct]; float Aall = cA[ct], hall = cH[ct];
#pragma unroll
            for (int q = 0; q < 4; ++q) { const int s = d == 0 ? q : 3 - q; const bool before = d == 0 ? (s < g) : (s > g);
                if (before) { hin = gA[s] * hin + gH[s]; Ain *= gA[s]; }
                hall = gA[s] * hall + gH[s]; Aall *= gA[s]; }
            cA[ct] = Aall; cH[ct] = hall;
#pragma unroll
            for (int rg = 0; rg < 4; ++rg) { const int ox = (d * 64 + 16 * tt + 4 * g + rg) * 128 + (chl ^ (g << 4));
                OUTB[ox] = (unsigned short)f2bf(hl[rg] + al[rg] * hin); OUTB[2 * 64 * 128 + ox] = (unsigned short)f2bf(al[rg] * Ain); }
        }
    }
}
__device__ __forceinline__ void lru1_item(const unsigned short* __restrict__ P, unsigned char* __restrict__ buf, const float* __restrict__ cw, const float* __restrict__ cb, const Wreg& W, int c, int b, int n, LAS unsigned char* lds) {
    int tid_ = threadIdx.x; asm volatile("" : "+v"(tid_)); const int tid = tid_, lane = tid & 63, wid = __builtin_amdgcn_readfirstlane(tid >> 6), g = lane >> 4, r16 = lane & 15, d = wid >> 2;
    const int rb = chunk_row(b, c); const int lo = c < 4 ? b * 256 : 1024 + b * 4096, hi = c < 4 ? lo + 256 : lo + 4096;
    LAS unsigned char* XB = lds;
    LAS float* XF = (LAS float*)(lds + 16384);
    LAS unsigned short* OUTB = (LAS unsigned short*)(lds + 49152);
    __syncthreads();
#pragma unroll
    for (int q = 0; q < 2; ++q) { const int e = tid + q * 512, t = e >> 4, c8 = (e & 15) * 8; const int ch0 = n * 128 + c8;
        float acc[8];
#pragma unroll
        for (int i = 0; i < 8; ++i) acc[i] = cb[ch0 + i];
#pragma unroll
        for (int jj = 0; jj < 4; ++jj) { const int rr = rb + t + jj - 2;
            if (rr >= lo && rr < hi) { const u32x4 w = *(const u32x4*)(P + (size_t)rr * LDP + 4096 + ch0); const unsigned ww[4] = {w.x, w.y, w.z, w.w};
#pragma unroll
                for (int i = 0; i < 8; ++i) { const float xv = (i & 1) ? __builtin_bit_cast(float, ww[i >> 1] & 0xffff0000u) : __builtin_bit_cast(float, ww[i >> 1] << 16); acc[i] += xv * cw[jj * 1024 + ch0 + i]; } } }
        u32x4 pk; pk.x = pk2(acc[0], acc[1]); pk.y = pk2(acc[2], acc[3]); pk.z = pk2(acc[4], acc[5]); pk.w = pk2(acc[6], acc[7]);
        *(LAS u32x4*)(XB + t * 256 + ((((c8 >> 3)) ^ (t & 15)) << 4)) = pk;
        *(LAS f32x4*)(XF + t * 128 + c8) = (f32x4){acc[0], acc[1], acc[2], acc[3]}; *(LAS f32x4*)(XF + t * 128 + c8 + 4) = (f32x4){acc[4], acc[5], acc[6], acc[7]}; }
    __syncthreads();
    float cA[2] = {1.f, 1.f}, cH[2] = {0.f, 0.f};
    if (d == 0) lru_scan<0>(W, XB, XF, OUTB, wid, g, r16, cA, cH); else lru_scan<1>(W, XB, XF, OUTB, wid, g, r16, cA, cH);
    __syncthreads();
#pragma unroll
    for (int q = 0; q < 4; ++q) { const int e = tid + q * 512; const int dd = (e >> 10) & 1, t = (e >> 4) & 63, c8 = (e & 15) * 8;
        const u32x4 w = *(const LAS u32x4*)(OUTB + ((2 + dd) * 64 + t) * 128 + (c8 ^ (((t >> 2) & 3) << 4)));
        *(u32x4*)((unsigned short*)(buf + AC_OFF) + (size_t)dd * MROWS * 1024 + (size_t)(rb + t) * 1024 + n * 128 + c8) = w; }
#pragma unroll
    for (int q = 0; q < 2; ++q) { const int e = tid + q * 512; const int t = (e >> 4) & 63, c8 = (e & 15) * 8;
        const int cs = c8 ^ (((t >> 2) & 3) << 4);
        const u32x4 w0 = *(const LAS u32x4*)(OUTB + (0 * 64 + t) * 128 + cs), w1 = *(const LAS u32x4*)(OUTB + (1 * 64 + t) * 128 + cs);
        const unsigned a[4] = {w0.x, w0.y, w0.z, w0.w}, bq[4] = {w1.x, w1.y, w1.z, w1.w}; unsigned o[4];
#pragma unroll
        for (int i = 0; i < 4; ++i) o[i] = pk2(__builtin_bit_cast(float, a[i] << 16) + __builtin_bit_cast(float, bq[i] << 16), __builtin_bit_cast(float, a[i] & 0xffff0000u) + __builtin_bit_cast(float, bq[i] & 0xffff0000u));
        *(u32x4*)((unsigned short*)(buf + HL_OFF) + (size_t)(rb + t) * 1024 + n * 128 + c8) = (u32x4){o[0], o[1], o[2], o[3]}; }
    if (g == 0) {
#pragma unroll
        for (int ct = 0; ct < 2; ++ct) { const int ch = n * 128 + 16 * (2 * (wid & 3) + ct) + r16; const size_t ix = ((size_t)(d * 4 + b) * NCH + c) * 1024 + ch;
            ((float*)(buf + AGGA_OFF))[ix] = cA[ct]; ((float*)(buf + AGGH_OFF))[ix] = cH[ct]; }
    }
}

__device__ __forceinline__ float gelu_t(float x) { const float u = 0.7978845608028654f * (x + 0.044715f * x * x * x); const float e = __expf(2.f * u); const float th = 1.f - 2.f * __builtin_amdgcn_rcpf(e + 1.f); return 0.5f * x * (1.f + th); }

__device__ __forceinline__ void merge_range(const unsigned short* __restrict__ P, const unsigned char* __restrict__ buf, unsigned short* __restrict__ Y, int c0, int len, int b, int cq, LAS unsigned char* lds) {
    int tid_ = threadIdx.x; asm volatile("" : "+v"(tid_)); const int tid = tid_;
    LAS float* CAR = (LAS float*)lds;
    __syncthreads();
    { const int d = tid >> 8, chl = tid & 255, ch = cq * 256 + chl;
      const float* GA = (const float*)(buf + AGGA_OFF) + (size_t)(d * 4 + b) * NCH * 1024 + ch; const float* GH = (const float*)(buf + AGGH_OFF) + (size_t)(d * 4 + b) * NCH * 1024 + ch;
      float h = 0.f;
      if (d == 0) {
#pragma unroll 16
          for (int i = 0; i < c0; ++i) h = GA[(size_t)i * 1024] * h + GH[(size_t)i * 1024];
          for (int k = 0; k < len; ++k) { CAR[(0 * 5 + k) * 256 + chl] = h; h = GA[(size_t)(c0 + k) * 1024] * h + GH[(size_t)(c0 + k) * 1024]; }
      } else {
          const int pos = LRU_POS(1, c0 + len - 1);
#pragma unroll 16
          for (int i = 0; i < pos; ++i) { const int cc = LRU_CSEQ(1, i); h = GA[(size_t)cc * 1024] * h + GH[(size_t)cc * 1024]; }
          for (int k = len - 1; k >= 0; --k) { CAR[(1 * 5 + k) * 256 + chl] = h; h = GA[(size_t)(c0 + k) * 1024] * h + GH[(size_t)(c0 + k) * 1024]; }
      } }
    __syncthreads();
    const unsigned short* HL0 = (const unsigned short*)(buf + HL_OFF);
    const unsigned short* AC0 = (const unsigned short*)(buf + AC_OFF); const unsigned short* AC1 = AC0 + (size_t)MROWS * 1024;
    for (int k = 0; k < len; ++k) { const int rb = chunk_row(b, c0 + k); const LAS float* C0 = CAR + (0 * 5 + k) * 256; const LAS float* C1 = CAR + (1 * 5 + k) * 256;
#pragma unroll
      for (int q = 0; q < 4; ++q) { const int e = tid + q * 512, t = e >> 5, c8 = (e & 31) * 8; const size_t ix = (size_t)(rb + t) * 1024 + cq * 256 + c8;
        const u32x4 h0 = *(const u32x4*)(HL0 + ix), a0 = *(const u32x4*)(AC0 + ix), a1 = *(const u32x4*)(AC1 + ix);
        const u32x4 gt = *(const u32x4*)(P + (size_t)(rb + t) * LDP + 3072 + cq * 256 + c8);
        const unsigned h0w[4] = {h0.x, h0.y, h0.z, h0.w}, a0w[4] = {a0.x, a0.y, a0.z, a0.w}, a1w[4] = {a1.x, a1.y, a1.z, a1.w}, gw[4] = {gt.x, gt.y, gt.z, gt.w};
        float y[8];
#pragma unroll
        for (int i = 0; i < 8; ++i) {
#define LRU_EL(W) ((i & 1) ? __builtin_bit_cast(float, W[i >> 1] & 0xffff0000u) : __builtin_bit_cast(float, W[i >> 1] << 16))
            const float hs = LRU_EL(h0w) + LRU_EL(a0w) * C0[c8 + i] + LRU_EL(a1w) * C1[c8 + i];
            y[i] = gelu_t(LRU_EL(gw)) * hs;
#undef LRU_EL
        }
        u32x4 o; o.x = pk2(y[0], y[1]); o.y = pk2(y[2], y[3]); o.z = pk2(y[4], y[5]); o.w = pk2(y[6], y[7]);
        *(u32x4*)(Y + (size_t)(rb + t) * 2048 + 1024 + cq * 256 + c8) = o; } }
}
}
constexpr int DM = 2048, NB = 4, SEQ = 4096, CTXL = 256, NCTX = NB * CTXL, MLAT = NB * SEQ, MTOT = NCTX + MLAT, DFF = 8192, DEPTH = 4;
constexpr int EV_IN = 5120, OD_IN = 6176, OD_INP = 6400, NMODC = 6 * DM;
constexpr float EPS = 1e-6f;
constexpr int NWAVES = 8, NTHR = 512;

constexpr size_t MiB = 1u << 20;
constexpr size_t WS_CTL = 0, CTL_ZERO_BYTES = 1 * MiB;
constexpr size_t WS_MODS = 1 * MiB, WS_ROPE = 2 * MiB;
constexpr size_t WS_WEVIN = 3 * MiB, WS_WEVOUT = 43 * MiB, WS_WODIN = 59 * MiB, WS_WODOUT = 109 * MiB, WS_W1 = 125 * MiB, WS_W2 = 253 * MiB;
constexpr size_t WS_H = 381 * MiB, WS_U = 517 * MiB, WS_Y = 585 * MiB, WS_P = 653 * MiB, WS_SCR = 925 * MiB, WS_OQ = 1197 * MiB, WS_WT = 1333 * MiB, WS_BIN = 1335 * MiB, WS_BUP = 1336 * MiB, WS_RSA = 1337 * MiB, WS_RSB = 1340 * MiB, WS_SLAB = 1343 * MiB, WS_END = 1407 * MiB;
constexpr int CW_BAR = 4096;

constexpr int RING_BYTES = 131072, LDSCTL_OFF = 153600, MISC_OFF = LDSCTL_OFF + 320, RED_OFF = LDSCTL_OFF + 1024, LDS_BYTES = RED_OFF + 4096;

struct Args { const float* in[30]; float* out; unsigned char* ws; int ph_lo, ph_hi; };
enum { I_X = 0, I_C, I_CTX, I_CCTX, I_ADAW, I_ADAB, I_N1G, I_N2G, I_W1, I_W2, I_EVWIN, I_EVWOUT, I_LQ1, I_LK1, I_LQ2, I_LK2, I_SUBG, I_CONVW, I_CONVB,
       I_WA, I_BA, I_WX, I_BX, I_LAM, I_ODWIN, I_ODWOUT, I_GW2, I_GB, I_ODNG, I_FING };

__device__ __forceinline__ float bf2f(bf16 v) { return __builtin_bit_cast(float, (unsigned)v << 16); }
__device__ __forceinline__ float wave_sum(float v) { return sum_x32(sum_x16(sum_row16(v))); }
__device__ __forceinline__ float wave_max(float v) { return max_x32(max_x16(max_row16(v))); }
__device__ __forceinline__ float sigmoidf_(float x) { return __builtin_amdgcn_rcpf(1.f + __builtin_amdgcn_exp2f(x * -1.4426950408889634f)); }
__device__ __forceinline__ float siluf_(float x) { return x * __builtin_amdgcn_rcpf(1.f + __builtin_amdgcn_exp2f(x * -1.4426950408889634f)); }
__device__ __forceinline__ float gelu_tanh(float x) { const float t = tanhf(0.7978845608028654f * (x + 0.044715f * x * x * x)); return 0.5f * x * (1.f + t); }
__device__ __forceinline__ int mod_row(int r) { return r < NCTX ? 4 : (r - NCTX) / SEQ; }

struct TC { int tid, lane, wave, gtid, NT, gw, NGW; };
typedef const __attribute__((address_space(4))) Args* ArgP;
__device__ __forceinline__ TC mk_tc() { int tid = threadIdx.x, bid = blockIdx.x, G = gridDim.x; asm volatile("" : "+v"(tid), "+s"(bid), "+s"(G)); TC t; t.tid = tid; t.lane = tid & 63; t.wave = __builtin_amdgcn_readfirstlane(tid >> 6);
    t.gtid = bid * NTHR + tid; t.NT = G * NTHR; t.gw = bid * NWAVES + t.wave; t.NGW = G * NWAVES; return t; }
__device__ __forceinline__ ArgP argp() { ArgP p = (ArgP)__builtin_amdgcn_kernarg_segment_ptr(); asm volatile("" : "+s"(p)); return p; }

__device__ __forceinline__ int cvt_items_win(int L) { return (L & 1) ? (DM / 64) * (OD_IN / 32) : (DM / 64) * (EV_IN / 32); }
constexpr int CVT_I_WOUT = (DM / 64) * (DM / 32), CVT_I_W1 = (DM / 64) * (DFF / 32), CVT_I_W2 = (DFF / 64) * (DM / 32);
__device__ __forceinline__ int cvt_items_total(int L) { return cvt_items_win(L) + CVT_I_WOUT + CVT_I_W1 + CVT_I_W2; }
__device__ __forceinline__ void cvt_layer(ArgP A, int L, int it0, int it1, int gw, int ngw, int lane, LAS float* scr) {
    unsigned char* ws = A->ws; const int j = L >> 1, n_in = cvt_items_win(L);
    for (int it = it0 + gw; it < it1; it += ngw) {
        int r = it;
        if (r < n_in) { if (L & 1) p0_transpose_item<false>(A->in[I_ODWIN] + (size_t)j * DM * OD_IN, DM, OD_IN, (bf16*)(ws + WS_WODIN) + (size_t)j * OD_INP * DM, 0, scr, r, lane);
                        else p0_transpose_item<true>(A->in[I_EVWIN] + (size_t)j * DM * EV_IN, DM, EV_IN, (bf16*)(ws + WS_WEVIN) + (size_t)j * EV_IN * DM, 0, scr, r, lane); continue; }
        r -= n_in;
        if (r < CVT_I_WOUT) { p0_transpose_item<false>(A->in[(L & 1) ? I_ODWOUT : I_EVWOUT] + (size_t)j * DM * DM, DM, DM, (bf16*)(ws + ((L & 1) ? WS_WODOUT : WS_WEVOUT)) + (size_t)j * DM * DM, 0, scr, r, lane); continue; }
        r -= CVT_I_WOUT;
        if (r < CVT_I_W1) { p0_transpose_item<false>(A->in[I_W1] + (size_t)L * DM * DFF, DM, DFF, (bf16*)(ws + WS_W1) + (size_t)L * DFF * DM, 0, scr, r, lane); continue; }
        r -= CVT_I_W1;
        p0_transpose_item<false>(A->in[I_W2] + (size_t)L * DFF * DM, DFF, DM, (bf16*)(ws + WS_W2) + (size_t)L * DM * DFF, 0, scr, r, lane);
    }
}
__device__ __forceinline__ void ph_setup(ArgP A, const TC& t, LAS unsigned char* lds) {
    unsigned char* ws = A->ws;
    LAS float* sil = (LAS float*)lds;
    for (int i = t.tid; i < 5 * DM; i += NTHR) { const int r = i / DM, k = i % DM; const float v = r < 4 ? A->in[I_C][r * DM + k] : A->in[I_CCTX][k]; sil[i] = siluf_(v); }
    __syncthreads();
    float* mods = (float*)(ws + WS_MODS);
    { LAS float* part = (LAS float*)(lds + 40960);
      const int cl = t.tid & 63, kq = t.tid >> 6;
      for (int it = blockIdx.x; it < DEPTH * NMODC / 64; it += gridDim.x) { const int l = it / (NMODC / 64), col = (it % (NMODC / 64)) * 64 + cl;
        const float* w = A->in[I_ADAW] + ((size_t)l * DM + kq * 256) * NMODC + col; const LAS float* sk = sil + kq * 256;
        float acc0 = 0.f, acc1 = 0.f, acc2 = 0.f, acc3 = 0.f, acc4 = 0.f;
#pragma unroll 16
        for (int k = 0; k < 256; ++k) { const float wv = w[(size_t)k * NMODC];
            acc0 += sk[k] * wv; acc1 += sk[DM + k] * wv; acc2 += sk[2 * DM + k] * wv; acc3 += sk[3 * DM + k] * wv; acc4 += sk[4 * DM + k] * wv; }
        LAS float* pp = part + (kq * 64 + cl) * 5; pp[0] = acc0; pp[1] = acc1; pp[2] = acc2; pp[3] = acc3; pp[4] = acc4;
        __syncthreads();
        if (t.tid < 320) { const int r = t.tid / 64, c2 = t.tid & 63; float s = 0.f;
#pragma unroll
            for (int q = 0; q < 8; ++q) s += part[(q * 64 + c2) * 5 + r];
            mods[(size_t)(l * 5 + r) * NMODC + (it % (NMODC / 64)) * 64 + c2] = s + A->in[I_ADAB][l * NMODC + (it % (NMODC / 64)) * 64 + c2]; }
        __syncthreads(); } }
    LAS float* scr = (LAS float*)(lds + 40960 + t.wave * 8704);
    cvt_layer(A, 0, 0, cvt_items_total(0), t.gw, t.NGW, t.lane, scr);
    for (int j = 0; j < 2; ++j) {
        GAS v4u* z = (GAS v4u*)((bf16*)(ws + WS_WODIN) + (size_t)j * OD_INP * DM + (size_t)OD_IN * DM);
        for (int i = t.gtid; i < (OD_INP - OD_IN) * DM / 8; i += t.NT) z[i] = (v4u){0u, 0u, 0u, 0u};
    }
    if (t.gtid < 64 * 16) { const int p = t.gtid / 16, f = t.gtid % 16;
        const float inv = powf(10000.0f, -(float)f / 16.0f); const float ang = (float)p * inv;
        const double ad = (double)ang; const double kk = rint(ad * 0.15915494309189535); const float rr = (float)(ad - kk * 6.283185307179586);
        float* rope = (float*)(ws + WS_ROPE); rope[2 * t.gtid] = cosf(rr); rope[2 * t.gtid + 1] = sinf(rr); }
    { bf16* WT = (bf16*)(ws + WS_WT);
      for (int idx = t.gtid; idx < 2 * 2 * 2 * 8 * 128 * 128; idx += t.NT) { const int i = idx & 127, jo = (idx >> 7) & 127, n = (idx >> 14) & 7, mat = (idx >> 17) & 1, d = (idx >> 18) & 1, jj = idx >> 19;
          const float* src = A->in[mat ? I_WX : I_WA] + ((size_t)((jj * 2 + d) * 8 + n) * 128 + i) * 128 + jo; WT[idx] = (bf16)f2bf(*src); } }
    { GAS unsigned long long* H = (GAS unsigned long long*)(ws + WS_H); const GAS f32x4* cx = (const GAS f32x4*)A->in[I_CTX]; const GAS f32x4* xx = (const GAS f32x4*)A->in[I_X];
      for (int i = t.gtid; i < MTOT * (DM / 4); i += t.NT) { const f32x4 v = i < NCTX * (DM / 4) ? cx[i] : xx[i - NCTX * (DM / 4)]; H[i] = (unsigned long long)pk2(v.x, v.y) | ((unsigned long long)pk2(v.z, v.w) << 32); } }
}


__device__ __forceinline__ void bias_rows(const bf16* Wt, int N, const float* shiftv  , float* out  , int nb, const TC& t, LAS float* sh  ) {
    __syncthreads();
    for (int i = t.tid; i < 5 * DM / 4; i += NTHR) { const int r = i / (DM / 4), c4 = i % (DM / 4); *(LAS f32x4*)(sh + r * DM + 4 * c4) = *(const f32x4*)(shiftv + (size_t)r * NMODC + 4 * c4); }
    __syncthreads();
    for (int n = t.gw; n < N; n += t.NGW) {
        float acc[5] = {0.f, 0.f, 0.f, 0.f, 0.f};
#pragma unroll
        for (int i = 0; i < 4; ++i) { const int k0 = (i * 64 + t.lane) * 8; const v4u w = *(const v4u*)(Wt + (size_t)n * DM + k0); const unsigned ww[4] = {w.x, w.y, w.z, w.w};
#pragma unroll
            for (int r = 0; r < 5; ++r) { const f32x4 s0 = *(const LAS f32x4*)(sh + r * DM + k0), s1 = *(const LAS f32x4*)(sh + r * DM + k0 + 4);
                acc[r] += __builtin_bit_cast(float, ww[0] << 16) * s0.x + __builtin_bit_cast(float, ww[0] & 0xffff0000u) * s0.y + __builtin_bit_cast(float, ww[1] << 16) * s0.z + __builtin_bit_cast(float, ww[1] & 0xffff0000u) * s0.w
                        + __builtin_bit_cast(float, ww[2] << 16) * s1.x + __builtin_bit_cast(float, ww[2] & 0xffff0000u) * s1.y + __builtin_bit_cast(float, ww[3] << 16) * s1.z + __builtin_bit_cast(float, ww[3] & 0xffff0000u) * s1.w; } }
#pragma unroll
        for (int r = 0; r < 5; ++r) { const float s = wave_sum(acc[r]); if (t.lane == 0) __hip_atomic_store(out + (size_t)r * nb + n, s, __ATOMIC_RELAXED, __HIP_MEMORY_SCOPE_AGENT); }
    }
}
__device__ __forceinline__ void layer_biases(ArgP A, const TC& t, int l, LAS unsigned char* lds) {
    unsigned char* ws = A->ws; const float* ml = (const float*)(ws + WS_MODS) + (size_t)l * 5 * NMODC; LAS float* sh = (LAS float*)lds; const int j = l >> 1;
    if ((l & 1) == 0) bias_rows((const bf16*)(ws + WS_WEVIN) + (size_t)j * EV_IN * DM, EV_IN, ml, (float*)(ws + WS_BIN) + (size_t)l * 5 * OD_INP, OD_INP, t, sh);
    else bias_rows((const bf16*)(ws + WS_WODIN) + (size_t)j * OD_INP * DM, OD_INP, ml, (float*)(ws + WS_BIN) + (size_t)l * 5 * OD_INP, OD_INP, t, sh);
    bias_rows((const bf16*)(ws + WS_W1) + (size_t)l * DFF * DM, DFF, ml + 3 * DM, (float*)(ws + WS_BUP) + (size_t)l * 5 * DFF, DFF, t, sh);
}
__device__ __forceinline__ void ph_setup_b(ArgP A, const TC& t, LAS unsigned char* lds) {
    unsigned char* ws = A->ws; const float* mods = (const float*)(ws + WS_MODS); LAS float* sh = (LAS float*)lds;
    { const int l = 0; const int j = l >> 1; const float* ml = mods + (size_t)l * 5 * NMODC;
        if ((l & 1) == 0) bias_rows((const bf16*)(ws + WS_WEVIN) + (size_t)j * EV_IN * DM, EV_IN, ml, (float*)(ws + WS_BIN) + (size_t)l * 5 * OD_INP, OD_INP, t, sh);
        else bias_rows((const bf16*)(ws + WS_WODIN) + (size_t)j * OD_INP * DM, OD_INP, ml, (float*)(ws + WS_BIN) + (size_t)l * 5 * OD_INP, OD_INP, t, sh);
        bias_rows((const bf16*)(ws + WS_W1) + (size_t)l * DFF * DM, DFF, ml + 3 * DM, (float*)(ws + WS_BUP) + (size_t)l * 5 * DFF, DFF, t, sh); }
    const float* g = A->in[I_N1G]; const bf16* H = (const bf16*)(ws + WS_H); bf16* U = (bf16*)(ws + WS_U); float* rsa = (float*)(ws + WS_RSA);
    for (int r = t.gw; r < MTOT; r += t.NGW) {
        const float* sc = mods + (size_t)mod_row(r) * NMODC + DM; float ss = 0.f;
#pragma unroll
        for (int jj = 0; jj < 4; ++jj) { const int c = 8 * (t.lane + 64 * jj); const v4u hw = *(const v4u*)(H + (size_t)r * DM + c); const unsigned ww[4] = {hw.x, hw.y, hw.z, hw.w};
            float y[8];
#pragma unroll
            for (int i = 0; i < 8; ++i) { const float v = (i & 1) ? __builtin_bit_cast(float, ww[i >> 1] & 0xffff0000u) : __builtin_bit_cast(float, ww[i >> 1] << 16); ss += v * v; y[i] = v * (g[c + i] * (sc[c + i] + 1.0f)); }
            v4u o; o.x = pk2(y[0], y[1]); o.y = pk2(y[2], y[3]); o.z = pk2(y[4], y[5]); o.w = pk2(y[6], y[7]); *(v4u*)(U + (size_t)r * DM + c) = o; }
        ss = wave_sum(ss); if (t.lane < 8) __hip_atomic_store(rsa + (size_t)t.lane * MTOT + r, t.lane == 0 ? ss : 0.f, __ATOMIC_RELAXED, __HIP_MEMORY_SCOPE_AGENT);
    }
}
__device__ __forceinline__ void ph_attn_fast(ArgP A, int l, int j, LAS unsigned char* lds) {
    const int lane = threadIdx.x & 63;
    const float lam_init = 0.8f - 0.6f * expf(-0.3f * (float)l);
    const float dq1 = wave_sum(A->in[I_LQ1][j * 64 + lane] * A->in[I_LK1][j * 64 + lane]);
    const float dq2 = wave_sum(A->in[I_LQ2][j * 64 + lane] * A->in[I_LK2][j * 64 + lane]);
    const float lam = expf(dq1) - expf(dq2) + lam_init;
    const bf16* P = (const bf16*)(A->ws + WS_P); bf16* Y = (bf16*)(A->ws + WS_Y); const float* sg = A->in[I_SUBG] + j * 128;
    const int G = gridDim.x, bid = blockIdx.x; const int vcu = (G % 8 == 0) ? (bid & 7) * (G >> 3) + (bid >> 3) : bid;
    constexpr int NBIG = NB * 8 * 32, NSMALL = NB * 8 * 2;
    for (int u0 = vcu; u0 < NBIG + G; u0 += G) {
        int u = u0; if (u0 >= NBIG) { const int v = u0 - NBIG - G / 2; if (v < 0 || v >= NSMALL) continue; u = NBIG + v; }
        int b, hh, qrow0, NT;
        if (u < NBIG) { b = u >> 8; hh = (u >> 5) & 7; qrow0 = NCTX + b * SEQ + (u & 31) * 128; NT = 68; }
        else { const int v = u - NBIG; b = v >> 4; hh = (v >> 1) & 7; qrow0 = b * CTXL + (v & 1) * 128; NT = 4; }
        att::attn_unit(P, Y, b, hh, qrow0, NT, lam, 1.f - lam_init, sg, lds);
    }
}

__device__ __forceinline__ void ph_lru1(ArgP A, int j, LAS unsigned char* lds) {
    const bf16* P = (const bf16*)(A->ws + WS_P); unsigned char* buf = A->ws + WS_SCR;
    const bf16* WT = (const bf16*)(A->ws + WS_WT) + (size_t)j * 2 * 2 * 8 * 128 * 128;
    const float* cw = A->in[I_CONVW] + (size_t)j * 4 * 1024; const float* cb = A->in[I_CONVB] + (size_t)j * 1024;
    const float* ba = A->in[I_BA] + (size_t)j * 2 * 1024; const float* bx = A->in[I_BX] + (size_t)j * 2 * 1024; const float* lam = A->in[I_LAM] + (size_t)j * 2 * 1024;
    const int G = gridDim.x, bid = blockIdx.x; const int vcu = (G % 8 == 0) ? (bid & 7) * (G >> 3) + (bid >> 3) : bid;
    int tid_ = threadIdx.x; asm volatile("" : "+v"(tid_)); const int wid = __builtin_amdgcn_readfirstlane(tid_ >> 6), lane = tid_ & 63;
    lru::Wreg W; int ncur = -1;
    for (int it = vcu; it < lru::NCH * 4 * 8; it += G) { const int n = it & 7, cb_ = it >> 3; const int c = cb_ % lru::NCH, b = cb_ / lru::NCH;
        if (n != ncur) { lru::load_w(W, WT, ba, bx, lam, n, wid, lane); ncur = n; }
        lru::lru1_item(P, buf, cw, cb, W, c, b, n, lds); }
}
__device__ __forceinline__ void ph_lru_merge(ArgP A, LAS unsigned char* lds) {
    const bf16* P = (const bf16*)(A->ws + WS_P); const unsigned char* buf = A->ws + WS_SCR; bf16* Y = (bf16*)(A->ws + WS_Y);
    for (int u = blockIdx.x; u < 256; u += gridDim.x) { const int ri = u & 15, bq = u >> 4;
        int c0, len; if (ri == 0) { c0 = 0; len = 4; } else { const int i = ri - 1; c0 = 4 + (i < 4 ? 5 * i : 20 + 4 * (i - 4)); len = i < 4 ? 5 : 4; }
        lru::merge_range(P, buf, Y, c0, len, bq >> 2, bq & 3, lds); }
}
__device__ __forceinline__ void ph_gla_prep(ArgP A, int j, LAS unsigned char* lds) {
    const bf16* P = (const bf16*)(A->ws + WS_P); unsigned char* img = A->ws + WS_SCR;
    const float* gw2 = A->in[I_GW2] + (size_t)j * 2 * 16 * 1024; const float* gb = A->in[I_GB] + (size_t)j * 2 * 1024;
    const int G = gridDim.x, NIT = gla::NCH * 16, NFULL = (NIT / G) * G;
    for (int it = blockIdx.x; it < NFULL; it += G) { const int c = it % gla::NCH, bh = it / gla::NCH; gla::prep_item(P, img, gw2, gb, c, bh >> 2, bh & 3, lds); }
    { const int hb = blockIdx.x; if (hb < 2 * (NIT - NFULL)) { const int it = NFULL + (hb >> 1), c = it % gla::NCH, bh = it / gla::NCH;
        if (hb & 1) gla::prep_half<1>(P, img, gw2, gb, c, bh >> 2, bh & 3, lds); else gla::prep_half<0>(P, img, gw2, gb, c, bh >> 2, bh & 3, lds); } }
}
__device__ __forceinline__ void ph_gla_seq(ArgP A, LAS unsigned char* lds) {
    const unsigned char* img = A->ws + WS_SCR; bf16* OQ = (bf16*)(A->ws + WS_OQ);
    const int G = gridDim.x, bid = blockIdx.x; const int vcu = (G % 8 == 0) ? (bid & 7) * (G >> 3) + (bid >> 3) : bid;
    for (int u = vcu; u < 256; u += G) { const int vs = u & 7, d = (u >> 3) & 1, bh = u >> 4; gla::seq_unit(img, OQ, bh >> 2, bh & 3, d, vs, lds); }
}
__device__ __forceinline__ void ph_od_c4(ArgP A, const TC& t, int j) {
    const bf16* P = (const bf16*)(A->ws + WS_P); const bf16* OQ = (const bf16*)(A->ws + WS_OQ); bf16* Y = (bf16*)(A->ws + WS_Y);
    const float* ng = A->in[I_ODNG] + j * 512;
    f32x4 g0 = *(const f32x4*)(ng + 8 * t.lane), g1 = *(const f32x4*)(ng + 8 * t.lane + 4);
    const float gg[8] = {g0.x, g0.y, g0.z, g0.w, g1.x, g1.y, g1.z, g1.w};
    for (int r = t.gw; r < MTOT; r += t.NGW) {
        v4u oa[4], ob[4], rg[4];
#pragma unroll
        for (int hh = 0; hh < 4; ++hh) { const size_t ix = (size_t)r * DM + hh * 512 + 8 * t.lane;
            oa[hh] = *(const v4u*)(OQ + ix); ob[hh] = *(const v4u*)(OQ + (size_t)MTOT * DM + ix); rg[hh] = *(const v4u*)(P + (size_t)r * OD_INP + 4096 + hh * 512 + 8 * t.lane); }
#pragma unroll
        for (int hh = 0; hh < 4; ++hh) {
            const unsigned aw[4] = {oa[hh].x, oa[hh].y, oa[hh].z, oa[hh].w}, bw[4] = {ob[hh].x, ob[hh].y, ob[hh].z, ob[hh].w}, rw[4] = {rg[hh].x, rg[hh].y, rg[hh].z, rg[hh].w};
            float o[8]; float ss = 0.f;
#pragma unroll
            for (int i = 0; i < 8; ++i) {
#define EL_(W) ((i & 1) ? __builtin_bit_cast(float, W[i >> 1] & 0xffff0000u) : __builtin_bit_cast(float, W[i >> 1] << 16))
                o[i] = EL_(aw) + EL_(bw); ss += o[i] * o[i]; }
            const float rstd = __builtin_amdgcn_rsqf(wave_sum(ss) * (1.f / 512.f) + EPS);
            float y[8];
#pragma unroll
            for (int i = 0; i < 8; ++i) y[i] = o[i] * rstd * gg[i] * siluf_(EL_(rw));
#undef EL_
            v4u w; w.x = pk2(y[0], y[1]); w.y = pk2(y[2], y[3]); w.z = pk2(y[4], y[5]); w.w = pk2(y[6], y[7]);
            *(v4u*)(Y + (size_t)r * DM + hh * 512 + 8 * t.lane) = w; }
    }
}
__device__ __forceinline__ void ph_final(ArgP A, const TC& t) {
    const bf16* H = (const bf16*)(A->ws + WS_H); const float* g = A->in[I_FING];
    for (int r = t.gw; r < MLAT; r += t.NGW) {
        v4u hw[4]; float ss = 0.f;
#pragma unroll
        for (int jj = 0; jj < 4; ++jj) hw[jj] = *(const v4u*)(H + (size_t)(NCTX + r) * DM + 8 * (t.lane + 64 * jj));
        float v[4][8];
#pragma unroll
        for (int jj = 0; jj < 4; ++jj) { const unsigned ww[4] = {hw[jj].x, hw[jj].y, hw[jj].z, hw[jj].w};
#pragma unroll
            for (int i = 0; i < 8; ++i) { v[jj][i] = (i & 1) ? __builtin_bit_cast(float, ww[i >> 1] & 0xffff0000u) : __builtin_bit_cast(float, ww[i >> 1] << 16); ss += v[jj][i] * v[jj][i]; } }
        const float rstd = __builtin_amdgcn_rsqf(wave_sum(ss) * (1.f / DM) + EPS);
#pragma unroll
        for (int jj = 0; jj < 4; ++jj) { const int c = 8 * (t.lane + 64 * jj); const f32x4 g0 = *(const f32x4*)(g + c), g1 = *(const f32x4*)(g + c + 4);
            *(f32x4*)(A->out + (size_t)r * DM + c) = (f32x4){v[jj][0] * rstd * g0.x, v[jj][1] * rstd * g0.y, v[jj][2] * rstd * g0.z, v[jj][3] * rstd * g0.w};
            *(f32x4*)(A->out + (size_t)r * DM + c + 4) = (f32x4){v[jj][4] * rstd * g1.x, v[jj][5] * rstd * g1.y, v[jj][6] * rstd * g1.z, v[jj][7] * rstd * g1.w}; }
    }
}

constexpr int PH_PER_LAYER = 7, N_PHASES = 3 + DEPTH * PH_PER_LAYER;
template <int N, int K, class Epi> __device__ __forceinline__ void run_gemm(LAS unsigned char* lds, const bf16* Aop, const bf16* Wt, int MR, const Epi& E) {
    pg8::Gemm g{Aop, Wt, MR, N, K, K}; pg8::StaticOrder S; S.init(MR, N, gridDim.x, (int)blockIdx.x, N == 2048 ? 4 : 8);
    pg8::gemm_phase<Epi, pg8::StaticOrder, true, true>(lds, g, S, E);
}

template <int K> __device__ __forceinline__ void ctx_splitk(LAS unsigned char* lds, const bf16* Aop, const bf16* Wt, float* slab) {
    const int G = gridDim.x, bid = blockIdx.x; const int vcu = (G % 8 == 0) ? (bid & 7) * (G >> 3) + (bid >> 3) : bid;
    const int ks = vcu & 7, un = vcu >> 3; constexpr int KC = K / 8;
    pg8::Gemm g{Aop + (size_t)ks * KC, Wt + (size_t)ks * KC, NCTX, DM, KC, K}; pg8::OneUnit S{un >> 3, un & 7, vcu < 256};
    pg8::EpiPartial E{slab + (size_t)ks * NCTX * DM};
    pg8::gemm_phase<pg8::EpiPartial, pg8::OneUnit, true, true>(lds, g, S, E);
}
__device__ __forceinline__ void ph_ctx_reduce(ArgP A, const TC& t, const float* gatev  , const float* ng, const float* scv  , float* rowss) {
    const float* slab = (const float*)(A->ws + WS_SLAB); bf16* H = (bf16*)(A->ws + WS_H); bf16* U = (bf16*)(A->ws + WS_U);
    for (int it = t.gw; it < NCTX * 4; it += t.NGW) { const int r = it >> 2, q = it & 3;
        float ss = 0.f;
#pragma unroll
        for (int jj = 0; jj < 2; ++jj) { const int c = q * 512 + 4 * (t.lane + 64 * jj);
            f32x4 sv[8];
#pragma unroll
            for (int ks = 0; ks < 8; ++ks) sv[ks] = *(const f32x4*)(slab + ((size_t)ks * NCTX + r) * DM + c);
            const f32x4 s = ((sv[0] + sv[1]) + (sv[2] + sv[3])) + ((sv[4] + sv[5]) + (sv[6] + sv[7]));
            const unsigned long long hw = *(const unsigned long long*)(H + (size_t)r * DM + c); const unsigned lo = (unsigned)hw, hi = (unsigned)(hw >> 32);
            const f32x4 h0 = {__builtin_bit_cast(float, lo << 16), __builtin_bit_cast(float, lo & 0xffff0000u), __builtin_bit_cast(float, hi << 16), __builtin_bit_cast(float, hi & 0xffff0000u)};
            const f32x4 gt4 = *(const f32x4*)(gatev + c), ng4 = *(const f32x4*)(ng + c), sc4 = *(const f32x4*)(scv + c);
            const f32x4 hn = h0 + gt4 * s;
            *(unsigned long long*)(H + (size_t)r * DM + c) = (unsigned long long)pk2(hn.x, hn.y) | ((unsigned long long)pk2(hn.z, hn.w) << 32); ss += (hn.x * hn.x + hn.y * hn.y) + (hn.z * hn.z + hn.w * hn.w);
            const f32x4 y = hn * (ng4 * (sc4 + 1.0f));
            *(unsigned long long*)(U + (size_t)r * DM + c) = (unsigned long long)pk2(y.x, y.y) | ((unsigned long long)pk2(y.z, y.w) << 32); }
        ss = wave_sum(ss);
        if (t.lane < 2) __hip_atomic_store(rowss + (size_t)(q + 4 * t.lane) * MTOT + r, t.lane == 0 ? ss : 0.f, __ATOMIC_RELAXED, __HIP_MEMORY_SCOPE_AGENT);
    }
}
__device__ __forceinline__ int slack_idle(int nwg) { const int G = gridDim.x, rounds = (nwg + G - 1) / G; return rounds * G - nwg; }
__device__ __forceinline__ void cvt_in_slack(ArgP A, int Lnext, int nwg, int it0, int it1, LAS unsigned char* lds) {
    int tid_ = threadIdx.x; asm volatile("" : "+v"(tid_)); const int wave = __builtin_amdgcn_readfirstlane(tid_ >> 6), lane = tid_ & 63;
    const int G = gridDim.x, idle = slack_idle(nwg), c0 = G - idle; LAS float* scr = (LAS float*)(lds + wave * 8704);
    if (idle == 0) cvt_layer(A, Lnext, it0, it1, (int)blockIdx.x * NWAVES + wave, G * NWAVES, lane, scr);
    else if ((int)blockIdx.x >= c0) cvt_layer(A, Lnext, it0, it1, ((int)blockIdx.x - c0) * NWAVES + wave, idle * NWAVES, lane, scr);
}
__global__ void __launch_bounds__(NTHR, 2) mega(Args args) {
    extern __shared__ __attribute__((aligned(16))) unsigned char lds_raw[];
    LAS unsigned char* lds = (LAS unsigned char*)lds_raw;
    volatile LAS unsigned* MISC = (volatile LAS unsigned*)(lds + MISC_OFF);
    for (int u = threadIdx.x; u < (LDS_BYTES - LDSCTL_OFF) / 4; u += NTHR) ((LAS unsigned*)(lds + LDSCTL_OFF))[u] = 0u;
    __syncthreads();
    const int lo = argp()->ph_lo, hi = argp()->ph_hi;
    const bool use_bar = (hi - lo) > 1;
    XcdBarrier bar; bar.bar = (unsigned*)(argp()->ws + WS_CTL) + CW_BAR; bar.x = 0; bar.st = nullptr;
    if (use_bar) bar = xcd_barrier_post((unsigned*)(argp()->ws + WS_CTL) + CW_BAR, MISC + 8);
#define IN(k) (lo <= (k) && (k) < hi)
#define SEAM(k) do { if (IN(k) && (k) + 1 < hi) xcd_barrier(bar); } while (0)
    if (IN(0)) { ph_setup(argp(), mk_tc(), lds); SEAM(0); }
    if (IN(1)) { ph_setup_b(argp(), mk_tc(), lds); SEAM(1); }
    for (int l = 0; l < DEPTH; ++l) {
        const int pb = 2 + l * PH_PER_LAYER, j = l >> 1; const bool even = (l & 1) == 0;
        if (IN(pb + 0)) {
            unsigned char* ws = argp()->ws; const float* bin = (const float*)(ws + WS_BIN) + (size_t)l * 5 * OD_INP;
            if (even) { pg8::EpiIn<0, true> E{(bf16*)(ws + WS_P), EV_IN, (const float*)(ws + WS_RSA), bin, OD_INP, (const float*)(ws + WS_ROPE), 0};
                        run_gemm<EV_IN, DM>(lds, (const bf16*)(ws + WS_U), (const bf16*)(ws + WS_WEVIN) + (size_t)j * EV_IN * DM, MTOT, E); }
            else      { pg8::EpiIn<0, false> E{(bf16*)(ws + WS_P), OD_INP, (const float*)(ws + WS_RSA), bin, OD_INP, nullptr, 0};
                        run_gemm<OD_INP, DM>(lds, (const bf16*)(ws + WS_U), (const bf16*)(ws + WS_WODIN) + (size_t)j * OD_INP * DM, MTOT, E); }
            if (l + 1 < DEPTH) {
                const int nwg_in = (MTOT / 256) * ((even ? EV_IN : OD_INP) / 256), nwg_up = (MTOT / 256) * (DFF / 256); const int ia = slack_idle(nwg_in), ib = slack_idle(nwg_up);
                const int tot = cvt_items_total(l + 1); const int n1 = (ia + ib) > 0 ? (int)((long)tot * ia / (ia + ib)) : tot / 2;
                cvt_in_slack(argp(), l + 1, nwg_in, 0, n1, lds); }
            SEAM(pb + 0);
        }
        if (even) {
            if (IN(pb + 1)) { ph_attn_fast(argp(), l, j, lds); ph_lru1(argp(), j, lds); SEAM(pb + 1); }
            if (IN(pb + 3)) { ph_lru_merge(argp(), lds); SEAM(pb + 3); }
        } else {
            if (IN(pb + 1)) { ph_gla_prep(argp(), j, lds); SEAM(pb + 1); }
            if (IN(pb + 2)) { ph_gla_seq(argp(), lds); SEAM(pb + 2); }
            if (IN(pb + 3)) { ph_od_c4(argp(), mk_tc(), j); SEAM(pb + 3); }
        }
        if (IN(pb + 4)) {
            unsigned char* ws = argp()->ws; const float* ml = (const float*)(ws + WS_MODS) + (size_t)l * 5 * NMODC;
            const bf16* Wt = (const bf16*)(ws + (even ? WS_WEVOUT : WS_WODOUT)) + (size_t)j * DM * DM;
            pg8::EpiResid E{(bf16*)(ws + WS_H), ml + 2 * DM, NCTX, (bf16*)(ws + WS_U), argp()->in[I_N2G] + l * DM, ml + 4 * DM, (float*)(ws + WS_RSB), (LAS float*)(lds + RED_OFF)};
            run_gemm<DM, DM>(lds, (const bf16*)(ws + WS_Y) + (size_t)NCTX * DM, Wt, MLAT, E);
            if (l < DEPTH - 1) { ctx_splitk<DM>(lds, (const bf16*)(ws + WS_Y), Wt, (float*)(ws + WS_SLAB)); xcd_barrier(bar);
                ph_ctx_reduce(argp(), mk_tc(), ml + 4 * NMODC + 2 * DM, argp()->in[I_N2G] + l * DM, ml + 4 * NMODC + 4 * DM, (float*)(ws + WS_RSB)); }
            SEAM(pb + 4);
        }
        if (IN(pb + 5)) {
            unsigned char* ws = argp()->ws;
            const int rb0 = (l == DEPTH - 1) ? NCTX : 0;
            pg8::EpiIn<1, false> E{(bf16*)(ws + WS_P), DFF, (const float*)(ws + WS_RSB), (const float*)(ws + WS_BUP) + (size_t)l * 5 * DFF, DFF, nullptr, rb0};
            run_gemm<DFF, DM>(lds, (const bf16*)(ws + WS_U) + (size_t)rb0 * DM, (const bf16*)(ws + WS_W1) + (size_t)l * DFF * DM, MTOT - rb0, E);
            if (l + 1 < DEPTH) {
                const int nwg_in = (MTOT / 256) * ((even ? EV_IN : OD_INP) / 256), nwg_up = (MTOT / 256) * (DFF / 256); const int ia = slack_idle(nwg_in), ib = slack_idle(nwg_up);
                const int tot = cvt_items_total(l + 1); const int n1 = (ia + ib) > 0 ? (int)((long)tot * ia / (ia + ib)) : tot / 2;
                cvt_in_slack(argp(), l + 1, nwg_up, n1, tot, lds); }
            SEAM(pb + 5);
        }
        if (IN(pb + 6)) {
            unsigned char* ws = argp()->ws; const float* ml = (const float*)(ws + WS_MODS) + (size_t)l * 5 * NMODC;
            const bool last = l == DEPTH - 1; const int ln = last ? l : l + 1;
            pg8::EpiResid E{(bf16*)(ws + WS_H), ml + 5 * DM, NCTX, last ? (bf16*)nullptr : (bf16*)(ws + WS_U), argp()->in[I_N1G] + ln * DM, (const float*)(ws + WS_MODS) + (size_t)ln * 5 * NMODC + 1 * DM, (float*)(ws + WS_RSA), (LAS float*)(lds + RED_OFF)};
            run_gemm<DM, DFF>(lds, (const bf16*)(ws + WS_P) + (size_t)NCTX * DFF, (const bf16*)(ws + WS_W2) + (size_t)l * DM * DFF, MLAT, E);
            if (!last) { ctx_splitk<DFF>(lds, (const bf16*)(ws + WS_P), (const bf16*)(ws + WS_W2) + (size_t)l * DM * DFF, (float*)(ws + WS_SLAB)); xcd_barrier(bar);
                ph_ctx_reduce(argp(), mk_tc(), ml + 4 * NMODC + 5 * DM, argp()->in[I_N1G] + ln * DM, (const float*)(ws + WS_MODS) + (size_t)ln * 5 * NMODC + 4 * NMODC + 1 * DM, (float*)(ws + WS_RSA));
                layer_biases(argp(), mk_tc(), l + 1, lds); }
            SEAM(pb + 6);
        }
    }
    if (IN(N_PHASES - 1)) ph_final(argp(), mk_tc());
#undef IN
#undef SEAM
}

extern "C" void kernel_launch(void* const* d_in, const int* in_sizes, int n_in, void* d_out, int out_size, void* d_ws, size_t ws_size, hipStream_t stream) {
    static int grid = 0;
    if (grid == 0) {
        if (n_in != 30 || ws_size < WS_END) { fprintf(stderr, "kernel_launch: bad n_in %d or ws %zu\n", n_in, ws_size); grid = -1; return; }
        int dev = 0, cus = 0;
        if (hipGetDevice(&dev) != hipSuccess || hipDeviceGetAttribute(&cus, hipDeviceAttributeMultiprocessorCount, dev) != hipSuccess) { grid = -1; return; }
        if (hipFuncSetAttribute((const void*)mega, hipFuncAttributeMaxDynamicSharedMemorySize, LDS_BYTES) != hipSuccess) { grid = -1; return; }
        (void)hipGetLastError();
        grid = cus;
    }
    if (grid < 0) return;
    (void)hipMemsetAsync((char*)d_ws + WS_CTL, 0, CTL_ZERO_BYTES, stream);
    Args a{};
    for (int i = 0; i < 30; ++i) a.in[i] = (const float*)d_in[i];
    a.out = (float*)d_out; a.ws = (unsigned char*)d_ws;
    a.ph_lo = 0; a.ph_hi = N_PHASES; hipLaunchKernelGGL(mega, dim3(grid), dim3(NTHR), LDS_BYTES, stream, a);
}
```

```cpp
#include <hip/hip_runtime.h>
#include <cstdio>
#include <cstdint>
#include <cmath>
#define ONE_LAUNCH 1
#define XL_DPP(v, ctrl) __builtin_bit_cast(float, __builtin_amdgcn_update_dpp(0, __builtin_bit_cast(int, (v)), (ctrl), 0xf, 0xf, true))
__device__ __forceinline__ float sum_row16(float v) { v += XL_DPP(v, 0xB1); v += XL_DPP(v, 0x4E); v += XL_DPP(v, 0x141); v += XL_DPP(v, 0x140); return v; }
__device__ __forceinline__ float max_row16(float v) { v = fmaxf(v, XL_DPP(v, 0xB1)); v = fmaxf(v, XL_DPP(v, 0x4E)); v = fmaxf(v, XL_DPP(v, 0x141)); v = fmaxf(v, XL_DPP(v, 0x140)); return v; }
__device__ __forceinline__ void xl_swap16(unsigned& a, unsigned& b) { asm volatile("s_nop 1\n\tv_permlane16_swap_b32 %0, %1" : "+v"(a), "+v"(b)); }
__device__ __forceinline__ unsigned xl_copy(unsigned a) { unsigned b = a; asm volatile("" : "+v"(b)); return b; }
__device__ __forceinline__ float sum_x16(float v) { unsigned a = __builtin_bit_cast(unsigned, v), b = a; xl_swap16(a, b); return __builtin_bit_cast(float, a) + __builtin_bit_cast(float, b); }
__device__ __forceinline__ float max_x16(float v) { unsigned a = __builtin_bit_cast(unsigned, v), b = a; xl_swap16(a, b); return fmaxf(__builtin_bit_cast(float, a), __builtin_bit_cast(float, b)); }
__device__ __forceinline__ void xl_swap32(unsigned& a, unsigned& b) { asm volatile("s_nop 1\n\tv_permlane32_swap_b32 %0, %1" : "+v"(a), "+v"(b)); }
__device__ __forceinline__ float sum_x32(float v) { unsigned a = __builtin_bit_cast(unsigned, v), b = a; xl_swap32(a, b); return __builtin_bit_cast(float, a) + __builtin_bit_cast(float, b); }
__device__ __forceinline__ float max_x32(float v) { unsigned a = __builtin_bit_cast(unsigned, v), b = a; xl_swap32(a, b); return fmaxf(__builtin_bit_cast(float, a), __builtin_bit_cast(float, b)); }
namespace pg8 {
#define PG8_LAS __attribute__((address_space(3)))
typedef unsigned short bf16_t;
typedef short bf16x8 __attribute__((ext_vector_type(8)));
typedef float f32x4 __attribute__((ext_vector_type(4)));
typedef unsigned u32x4 __attribute__((ext_vector_type(4)));
constexpr int BM = 256, BK = 64, HALF = 128, HTB = HALF * BK * 2  , STAGE_BYTES = 8 * HTB, NXCD = 8, WGM = 8;

__host__ __device__ __forceinline__ int lds_byte(int r, int c) { const int st = (r >> 4) * 2 + (c >> 5), rr = r & 15, cc = c & 31, ob = rr * 64 + cc * 2; return st * 1024 + (ob ^ (((ob >> 9) & 1) << 5)); }
__host__ __device__ __forceinline__ void stage_rc(int b, int& R, int& C) { const int st = b / 1024, sb = b % 1024, swz = sb ^ (((sb >> 9) & 1) << 5); R = (st >> 1) * 16 + swz / 64; C = (st & 1) * 32 + (swz % 64) / 2; }
__host__ __device__ __forceinline__ int perm32(int rho) { const int n = rho >> 4, i = rho & 15; return 8 * (i >> 2) + 4 * n + (i & 3); }

struct Unit { int pm, pn; };
struct Gemm { const bf16_t* A; const bf16_t* Bt; int M, N, K, LD; };

struct StaticOrder {
    int nM, nN, nwg, G, c, wgm;
    __host__ __device__ void init(int M, int N, int G_, int c_, int wgm_ = WGM) { nM = M / BM; nN = N / BM; nwg = nM * nN; G = G_; c = c_; wgm = wgm_; }
    __host__ __device__ bool next(int i, Unit& u) const {
        const long L = (long)i * G + c; if (L >= nwg) return false;
        int wgid = (int)L; { const int q = nwg / NXCD, r = nwg % NXCD, xcd = wgid % NXCD, off = wgid / NXCD; wgid = (xcd < r ? xcd * (q + 1) : r * (q + 1) + (xcd - r) * q) + off; }
        const int nig = wgm * nN, gid = wgid / nig, fm = gid * wgm, gsz = (nM - fm) < wgm ? (nM - fm) : wgm;
        u.pm = fm + ((wgid % nig) % gsz); u.pn = (wgid % nig) / gsz; return true;
    }
    __device__ __forceinline__ void a_ready(const Unit&) const {}
    __device__ __forceinline__ void done(const Unit&) const {}
};

__device__ __forceinline__ unsigned cvt_pk_bf16(float lo, float hi) { unsigned r; asm volatile("v_cvt_pk_bf16_f32 %0, %1, %2" : "=v"(r) : "v"(lo), "v"(hi)); return r; }
typedef float f32x2 __attribute__((ext_vector_type(2)));
template <int ACT, bool ROPE> struct EpiIn {
    static constexpr bool PERM = true, AFTER_DRAIN = false;
    bf16_t* O; int ldc; const float* rowss; const float* bias; int nb; const float* rope; int row_base;
    template <bool COLHALF> __device__ __forceinline__ void body(f32x4 (&acc)[2][2][4][2], const Unit& u, int wr, int wc, int fr_, int fq_) const {
        int fr = fr_, fq = fq_; asm volatile("" : "+v"(fr), "+v"(fq));
        const int prow = row_base + u.pm * BM;
        const int mr = prow < 1024 ? 4 : (prow - 1024) / 4096;
        const int row0 = prow + wr * 64 + fr; const int col0 = u.pn * BM + wc * 32 + 8 * fq;
        {   f32x4 bv[2][2];
#pragma unroll
            for (int bj = 0; bj < 2; ++bj) { bv[bj][0] = *(const f32x4*)(bias + (size_t)mr * nb + col0 + bj * HALF); bv[bj][1] = *(const f32x4*)(bias + (size_t)mr * nb + col0 + bj * HALF + 4); }
            float pq[8][2];
#pragma unroll
            for (int i = 0; i < 8; ++i) { const int row = row0 + (i >> 2) * HALF + (i & 3) * 16; pq[i][0] = rowss[(size_t)(2 * fq) * 17408 + row]; pq[i][1] = rowss[(size_t)(2 * fq + 1) * 17408 + row]; }
#pragma unroll
            for (int i = 0; i < 8; ++i) { float s = pq[i][0] + pq[i][1]; s = ::sum_x32(::sum_x16(s)); const float rs = __builtin_amdgcn_rsqf(s * (1.f / 2048.f) + 1e-6f);
#pragma unroll
                for (int bj = 0; bj < 2; ++bj) { acc[i >> 2][bj][i & 3][0] = acc[i >> 2][bj][i & 3][0] * rs + bv[bj][0]; acc[i >> 2][bj][i & 3][1] = acc[i >> 2][bj][i & 3][1] * rs + bv[bj][1]; } }
        }
        const bool ropeq = ROPE && (u.pn < 8); const bool dorope = ropeq && (prow >= 1024); const float qs = (ROPE && u.pn < 4) ? 0.125f * 1.4426950408889634f : 1.0f;
        f32x4 cc[COLHALF ? 4 : 2][2];
#pragma unroll
        for (int i = 0; i < (COLHALF ? 4 : 2); ++i) { cc[i][0] = (f32x4){1.f, 0.f, 1.f, 0.f}; cc[i][1] = (f32x4){1.f, 0.f, 1.f, 0.f}; }
        if (ROPE) { if (dorope) {
#pragma unroll
            for (int i = 0; i < (COLHALF ? 4 : 2); ++i) { const int tt = (row0 + (COLHALF ? i * 16 : i * HALF) - 1024) & 4095; const int pos = COLHALF ? (tt & 63) : (tt >> 6);
                cc[i][0] = *(const f32x4*)(rope + (pos * 16 + 4 * fq) * 2); cc[i][1] = *(const f32x4*)(rope + (pos * 16 + 4 * fq) * 2 + 4); } } }
#pragma unroll
        for (int ai = 0; ai < 2; ++ai)
#pragma unroll
            for (int m = 0; m < 4; ++m) { const int row = row0 + ai * HALF + m * 16; bf16_t* rowp = O + (size_t)row * ldc + col0;
                const f32x4 c0 = cc[COLHALF ? m : ai][0], c1 = cc[COLHALF ? m : ai][1];
#pragma unroll
                for (int bj = 0; bj < 2; ++bj) { f32x4 v0 = acc[ai][bj][m][0], v1 = acc[ai][bj][m][1];
                    if (ROPE) { if (ropeq) {
                        const f32x4 r0 = {(v0[0] * c0[0] - v0[1] * c0[1]) * qs, (v0[1] * c0[0] + v0[0] * c0[1]) * qs, (v0[2] * c0[2] - v0[3] * c0[3]) * qs, (v0[3] * c0[2] + v0[2] * c0[3]) * qs};
                        const f32x4 r1 = {(v1[0] * c1[0] - v1[1] * c1[1]) * qs, (v1[1] * c1[0] + v1[0] * c1[1]) * qs, (v1[2] * c1[2] - v1[3] * c1[3]) * qs, (v1[3] * c1[2] + v1[2] * c1[3]) * qs};
                        v0 = r0; v1 = r1; } }
                    if (ACT == 1) {
#pragma unroll
                        for (int e = 0; e < 4; ++e) { float a = v0[e] > 0.f ? v0[e] : 0.f; v0[e] = a * a; float b = v1[e] > 0.f ? v1[e] : 0.f; v1[e] = b * b; } }
                    u32x4 w; w.x = cvt_pk_bf16(v0[0], v0[1]); w.y = cvt_pk_bf16(v0[2], v0[3]); w.z = cvt_pk_bf16(v1[0], v1[1]); w.w = cvt_pk_bf16(v1[2], v1[3]);
                    *(u32x4*)(rowp + bj * HALF) = w; } }
    }
    __device__ __forceinline__ void operator()(f32x4 (&acc)[2][2][4][2], const Unit& u, int wr, int wc, int fr, int fq) const {
        if (ROPE && (wc & 1)) body<true>(acc, u, wr, wc, fr, fq); else body<false>(acc, u, wr, wc, fr, fq);
    }
};
struct EpiResid {
    static constexpr bool PERM = true, AFTER_DRAIN = false;
    bf16_t* H; const float* gatev; int row_base;
    bf16_t* U; const float* ng; const float* scv; float* rowss;
    PG8_LAS float* red;
    __device__ __forceinline__ void operator()(const f32x4 (&acc)[2][2][4][2], const Unit& u, int wr, int wc, int fr_, int fq_) const {
        int fr = fr_, fq = fq_; asm volatile("" : "+v"(fr), "+v"(fq));
        const int prow = row_base + u.pm * BM;
        const int mr = prow < 1024 ? 4 : (prow - 1024) / 4096;
        const float* gate = gatev + (size_t)mr * 12288;
        const int col0 = u.pn * BM + wc * 32 + 8 * fq;
        const size_t rowoff = (size_t)(prow + wr * 64 + fr) * 2048 + col0;
        float ss[8];
#pragma unroll
        for (int i = 0; i < 8; ++i) ss[i] = 0.f;
#pragma unroll
        for (int bj = 0; bj < 2; ++bj) { const int co = bj * HALF; const f32x4 g0 = *(const f32x4*)(gate + col0 + co), g1 = *(const f32x4*)(gate + col0 + co + 4);
            u32x4 hv[8];
#pragma unroll
            for (int ai = 0; ai < 2; ++ai)
#pragma unroll
                for (int m = 0; m < 4; ++m) hv[ai * 4 + m] = *(const u32x4*)(H + rowoff + (size_t)(ai * HALF + m * 16) * 2048 + co);
            f32x4 s0 = {0.f, 0.f, 0.f, 0.f}, s1 = s0;
            if (U) { s0 = *(const f32x4*)(ng + col0 + co) * (*(const f32x4*)(scv + (size_t)mr * 12288 + col0 + co) + 1.0f); s1 = *(const f32x4*)(ng + col0 + co + 4) * (*(const f32x4*)(scv + (size_t)mr * 12288 + col0 + co + 4) + 1.0f); }
#pragma unroll
            for (int ai = 0; ai < 2; ++ai)
#pragma unroll
                for (int m = 0; m < 4; ++m) { const u32x4 hw = hv[ai * 4 + m];
                    const f32x4 h0 = {__builtin_bit_cast(float, hw.x << 16), __builtin_bit_cast(float, hw.x & 0xffff0000u), __builtin_bit_cast(float, hw.y << 16), __builtin_bit_cast(float, hw.y & 0xffff0000u)};
                    const f32x4 h1 = {__builtin_bit_cast(float, hw.z << 16), __builtin_bit_cast(float, hw.z & 0xffff0000u), __builtin_bit_cast(float, hw.w << 16), __builtin_bit_cast(float, hw.w & 0xffff0000u)};
                    const f32x4 n0 = h0 + g0 * acc[ai][bj][m][0], n1 = h1 + g1 * acc[ai][bj][m][1];
                    u32x4 w; w.x = cvt_pk_bf16(n0[0], n0[1]); w.y = cvt_pk_bf16(n0[2], n0[3]); w.z = cvt_pk_bf16(n1[0], n1[1]); w.w = cvt_pk_bf16(n1[2], n1[3]);
                    *(u32x4*)(H + rowoff + (size_t)(ai * HALF + m * 16) * 2048 + co) = w;
                    if (U) { const f32x4 a0 = n0 * s0, a1 = n1 * s1; ss[ai * 4 + m] += ((n0[0] * n0[0] + n0[1] * n0[1]) + (n0[2] * n0[2] + n0[3] * n0[3])) + ((n1[0] * n1[0] + n1[1] * n1[1]) + (n1[2] * n1[2] + n1[3] * n1[3]));
                        u32x4 v; v.x = cvt_pk_bf16(a0[0], a0[1]); v.y = cvt_pk_bf16(a0[2], a0[3]); v.z = cvt_pk_bf16(a1[0], a1[1]); v.w = cvt_pk_bf16(a1[2], a1[3]);
                        *(u32x4*)(U + rowoff + (size_t)(ai * HALF + m * 16) * 2048 + co) = v; } }
        }
        if (U) {
#pragma unroll
            for (int i = 0; i < 8; ++i) { float s = ss[i]; s = ::sum_x32(::sum_x16(s));
                if (fq == 0) red[wc * 256 + (i >> 2) * HALF + wr * 64 + (i & 3) * 16 + fr] = s; }
            asm volatile("s_waitcnt lgkmcnt(0)" ::: "memory"); __builtin_amdgcn_s_barrier(); asm volatile("" ::: "memory");
            const int tl = (wr * 4 + wc) * 64 + fq * 16 + fr;
            if (tl < 256) rowss[(size_t)u.pn * 17408 + prow + tl] = (red[tl] + red[256 + tl]) + (red[512 + tl] + red[768 + tl]);
        }
    }
};
struct EpiPartial {
    static constexpr bool PERM = false, AFTER_DRAIN = false;
    float* slab;
    __device__ __forceinline__ void operator()(const f32x4 (&acc)[2][2][4][2], const Unit& u, int wr, int wc, int fr_, int fq_) const {
        int fr = fr_, fq = fq_; asm volatile("" : "+v"(fr), "+v"(fq));
        float* p = slab + (size_t)(u.pm * BM + wr * 64 + fr) * 2048 + u.pn * BM + wc * 32 + 4 * fq;
#pragma unroll
        for (int ai = 0; ai < 2; ++ai)
#pragma unroll
            for (int m = 0; m < 4; ++m)
#pragma unroll
                for (int bj = 0; bj < 2; ++bj)
#pragma unroll
                    for (int n = 0; n < 2; ++n) *(f32x4*)(p + (size_t)(ai * HALF + m * 16) * 2048 + bj * HALF + n * 16) = acc[ai][bj][m][n];
    }
};
struct OneUnit {
    int pm, pn; bool has;
    __device__ __forceinline__ bool next(int i, Unit& u) const { if (i > 0 || !has) return false; u.pm = pm; u.pn = pn; return true; }
    __device__ __forceinline__ void a_ready(const Unit&) const {}
    __device__ __forceinline__ void done(const Unit&) const {}
};
template <class Epi, class Sched, bool ALIGN_EPI = false, bool SP2 = false>
__device__ __forceinline__ void gemm_phase(PG8_LAS unsigned char* lds, const Gemm g, const Sched& S, const Epi& E) {
    int tid_ = threadIdx.x; asm volatile("" : "+v"(tid_)); const int tid = tid_, wid = __builtin_amdgcn_readfirstlane(tid >> 6), lane = tid & 63, wr = wid >> 2, wc = wid & 3, fr = lane & 15, fq = lane >> 4;
    const int K = g.LD, nt = g.K / BK;
    unsigned voffA[2], voffB[2];
#pragma unroll
    for (int i = 0; i < 2; ++i) { int R, C; stage_rc(tid * 16 + i * 8192, R, C); const int Rb = Epi::PERM ? ((R & ~31) + perm32(R & 31)) : R;
        voffA[i] = (unsigned)(R * K + C) * 2u; voffB[i] = (unsigned)(Rb * K + C) * 2u; }
    const size_t kstep = (size_t)(BK * 2);
    const size_t hstep = (size_t)HALF * K * 2;
    const size_t tstep = 2 * hstep;
    const unsigned ldsw = (unsigned)wid * 1024u;
    const int aoff = lds_byte(wr * 64 + fr, fq * 8), boff = lds_byte(wc * 32 + fr, fq * 8);
#define PG8_SA(b, h) (((b) * 2 + (h)) * HTB)
#define PG8_SB(b, h) ((4 + (b) * 2 + (h)) * HTB)
#define PG8_STAGE(bufoff, gbase, voff) do { _Pragma("unroll") for (int _i = 0; _i < 2; ++_i) \
        __builtin_amdgcn_global_load_lds((const unsigned*)((const char*)(gbase) + (voff)[_i]), (PG8_LAS unsigned*)(lds + (bufoff) + ldsw + _i * 8192), 16, 0, 0); } while (0)
#define PG8_LDA(dst, b, h) do { _Pragma("unroll") for (int m = 0; m < 4; ++m) _Pragma("unroll") for (int k = 0; k < 2; ++k) dst[m][k] = *(const PG8_LAS bf16x8*)(lds + PG8_SA(b, h) + aoff + m * 2048 + k * 1024); } while (0)
#define PG8_LDB(dst, b, h) do { _Pragma("unroll") for (int n = 0; n < 2; ++n) _Pragma("unroll") for (int k = 0; k < 2; ++k) dst[n][k] = *(const PG8_LAS bf16x8*)(lds + PG8_SB(b, h) + boff + n * 2048 + k * 1024); } while (0)
#define PG8_MMA(ai, bj, At, Bt) do { __builtin_amdgcn_s_setprio(1); _Pragma("unroll") for (int m = 0; m < 4; ++m) _Pragma("unroll") for (int n = 0; n < 2; ++n) _Pragma("unroll") for (int k = 0; k < 2; ++k) \
        acc[ai][bj][m][n] = __builtin_amdgcn_mfma_f32_16x16x32_bf16(Bt[n][k], At[m][k], acc[ai][bj][m][n], 0, 0, 0); __builtin_amdgcn_s_setprio(0); } while (0)
#define PG8_WAIT_V(n) asm volatile("s_waitcnt vmcnt(" #n ")" ::: "memory")
#define PG8_WAIT_L(n) asm volatile("s_waitcnt lgkmcnt(" #n ")" ::: "memory")
#define PG8_BAR __builtin_amdgcn_s_barrier()
#define PG8_SCHED __builtin_amdgcn_sched_barrier(0)
    Unit cur, nxt; int ui = 0;
    if (!S.next(0, cur)) return;
    f32x4 acc[2][2][4][2];
#pragma unroll
    for (int a = 0; a < 2; ++a)
#pragma unroll
        for (int b = 0; b < 2; ++b)
#pragma unroll
            for (int m = 0; m < 4; ++m)
#pragma unroll
                for (int n = 0; n < 2; ++n) acc[a][b][m][n] = (f32x4){0.f, 0.f, 0.f, 0.f};
    bf16x8 At[4][2], B0[2][2], B1[2][2];
    const char* cA = (const char*)g.A + (size_t)cur.pm * tstep; const char* cB = (const char*)g.Bt + (size_t)cur.pn * tstep;
    S.a_ready(cur);
    if constexpr (SP2) {
        PG8_STAGE(PG8_SB(0, 0), cB, voffB); PG8_STAGE(PG8_SB(0, 1), cB + hstep, voffB); PG8_STAGE(PG8_SA(0, 0), cA, voffA); PG8_STAGE(PG8_SA(0, 1), cA + hstep, voffA);
        if (wr == 1) PG8_BAR;
        PG8_WAIT_V(2); PG8_BAR;
        PG8_STAGE(PG8_SB(1, 0), cB + kstep, voffB); PG8_STAGE(PG8_SA(1, 0), cA + kstep, voffA); PG8_STAGE(PG8_SB(1, 1), cB + hstep + kstep, voffB);
        PG8_WAIT_V(6); PG8_BAR;
    } else {
        PG8_STAGE(PG8_SB(0, 0), cB, voffB); PG8_STAGE(PG8_SA(0, 0), cA, voffA); PG8_STAGE(PG8_SB(0, 1), cB + hstep, voffB); PG8_STAGE(PG8_SA(0, 1), cA + hstep, voffA);
        if (wr == 1) PG8_BAR;
        PG8_WAIT_V(4); PG8_BAR;
        PG8_STAGE(PG8_SB(1, 0), cB + kstep, voffB); PG8_STAGE(PG8_SA(1, 0), cA + kstep, voffA); PG8_STAGE(PG8_SB(1, 1), cB + hstep + kstep, voffB);
        PG8_WAIT_V(6); PG8_BAR;
    }
    for (;;) {
        const bool has_next = S.next(ui + 1, nxt);
        const char* nA = has_next ? (const char*)g.A + (size_t)nxt.pm * tstep : cA; const char* nB = has_next ? (const char*)g.Bt + (size_t)nxt.pn * tstep : cB;
        for (int t = 0; t < nt; t += 2) {
            const bool last = (t == nt - 2);
            const char* a1 = cA + (size_t)(t + 1) * kstep;
            const char* a2 = last ? nA : cA + (size_t)(t + 2) * kstep; const char* b2 = last ? nB : cB + (size_t)(t + 2) * kstep;
            const char* a3 = a2 + kstep; const char* b3 = b2 + kstep;
            if (last && has_next) S.a_ready(nxt);
            if constexpr (SP2) {
            PG8_LDB(B0, 0, 0); PG8_LDB(B1, 0, 1); PG8_SCHED; PG8_LDA(At, 0, 0); PG8_STAGE(PG8_SA(1, 1), a1 + hstep, voffA);
            PG8_WAIT_V(8); PG8_WAIT_L(0); PG8_BAR; PG8_MMA(0, 0, At, B0); PG8_MMA(0, 1, At, B1); PG8_BAR; PG8_SCHED;
            PG8_LDA(At, 0, 1); PG8_STAGE(PG8_SB(0, 0), b2, voffB); PG8_STAGE(PG8_SB(0, 1), b2 + hstep, voffB); PG8_STAGE(PG8_SA(0, 0), a2, voffA);
            PG8_WAIT_V(8); PG8_WAIT_L(0); PG8_BAR; PG8_MMA(1, 0, At, B0); PG8_MMA(1, 1, At, B1); PG8_BAR; PG8_SCHED;
            PG8_LDB(B0, 1, 0); PG8_LDB(B1, 1, 1); PG8_SCHED; PG8_LDA(At, 1, 0); PG8_STAGE(PG8_SA(0, 1), a2 + hstep, voffA);
            PG8_WAIT_V(8); PG8_WAIT_L(0); PG8_BAR; PG8_MMA(0, 0, At, B0); PG8_MMA(0, 1, At, B1); PG8_BAR; PG8_SCHED;
            PG8_LDA(At, 1, 1); PG8_STAGE(PG8_SB(1, 0), b3, voffB); PG8_STAGE(PG8_SB(1, 1), b3 + hstep, voffB); PG8_STAGE(PG8_SA(1, 0), a3, voffA);
            PG8_WAIT_V(8); PG8_WAIT_L(0); PG8_BAR; PG8_MMA(1, 0, At, B0); PG8_MMA(1, 1, At, B1); PG8_BAR; PG8_SCHED;
            } else {
            PG8_LDB(B0, 0, 0); PG8_SCHED; PG8_LDA(At, 0, 0); PG8_STAGE(PG8_SA(1, 1), a1 + hstep, voffA);
            PG8_WAIT_L(8); PG8_BAR; PG8_WAIT_L(0); PG8_MMA(0, 0, At, B0); PG8_BAR; PG8_SCHED;
            PG8_LDB(B1, 0, 1); PG8_STAGE(PG8_SB(0, 0), b2, voffB);
            PG8_BAR; PG8_WAIT_L(0); PG8_MMA(0, 1, At, B1); PG8_BAR;
            PG8_LDA(At, 0, 1); PG8_STAGE(PG8_SA(0, 0), a2, voffA);
            PG8_BAR; PG8_WAIT_L(0); PG8_MMA(1, 0, At, B0); PG8_BAR; PG8_SCHED;
            PG8_STAGE(PG8_SB(0, 1), b2 + hstep, voffB);
            PG8_WAIT_V(6); PG8_BAR; PG8_MMA(1, 1, At, B1); PG8_BAR;
            PG8_LDB(B0, 1, 0); PG8_SCHED; PG8_LDA(At, 1, 0); PG8_STAGE(PG8_SA(0, 1), a2 + hstep, voffA);
            PG8_WAIT_L(8); PG8_BAR; PG8_WAIT_L(0); PG8_MMA(0, 0, At, B0); PG8_BAR; PG8_SCHED;
            PG8_LDB(B1, 1, 1); PG8_STAGE(PG8_SB(1, 0), b3, voffB);
            PG8_BAR; PG8_WAIT_L(0); PG8_MMA(0, 1, At, B1); PG8_BAR;
            PG8_LDA(At, 1, 1); PG8_STAGE(PG8_SA(1, 0), a3, voffA);
            PG8_BAR; PG8_WAIT_L(0); PG8_MMA(1, 0, At, B0); PG8_BAR; PG8_SCHED;
            PG8_STAGE(PG8_SB(1, 1), b3 + hstep, voffB);
            PG8_WAIT_V(6); PG8_BAR; PG8_MMA(1, 1, At, B1); PG8_BAR;
            }
        }
        if constexpr (ALIGN_EPI) { if (wr == 0) PG8_BAR; }
        if constexpr (!Epi::AFTER_DRAIN) { E(acc, cur, wr, wc, fr, fq); S.done(cur); }
        if (!has_next) break;
#pragma unroll
        for (int a = 0; a < 2; ++a)
#pragma unroll
            for (int b = 0; b < 2; ++b)
#pragma unroll
                for (int m = 0; m < 4; ++m)
#pragma unroll
                    for (int n = 0; n < 2; ++n) acc[a][b][m][n] = (f32x4){0.f, 0.f, 0.f, 0.f};
        cur = nxt; cA = nA; cB = nB; ++ui;
        if constexpr (ALIGN_EPI) { if (wr == 1) PG8_BAR; }
    }
    PG8_WAIT_V(0);
    if constexpr (!ALIGN_EPI) { if (wr == 0) PG8_BAR; }
    PG8_BAR;
    if constexpr (Epi::AFTER_DRAIN) { E.fused(acc, cur, wr, wc, fr, fq, lds, wid, lane); S.done(cur); }
#undef PG8_SA
#undef PG8_SB
#undef PG8_STAGE
#undef PG8_LDA
#undef PG8_LDB
#undef PG8_MMA
#undef PG8_WAIT_V
#undef PG8_WAIT_L
#undef PG8_BAR
#undef PG8_SCHED
}
}
#define GAS __attribute__((address_space(1)))
#define LAS __attribute__((address_space(3)))
typedef unsigned short bf16;
typedef unsigned v4u __attribute__((ext_vector_type(4)));
typedef float f32x4 __attribute__((ext_vector_type(4)));
typedef short bf16x8 __attribute__((ext_vector_type(8)));
typedef GAS unsigned gu32;
typedef GAS unsigned long long gu64;
#define RLX_AGENT __ATOMIC_RELAXED, __HIP_MEMORY_SCOPE_AGENT
#define LDS_WAIT() asm volatile("s_waitcnt lgkmcnt(0)" ::: "memory")
#define VM_WAIT() asm volatile("s_waitcnt vmcnt(0)" ::: "memory")
__device__ __forceinline__ unsigned long long rt() { return __builtin_amdgcn_s_memrealtime(); }
typedef __bf16 xbf2_t __attribute__((ext_vector_type(2)));
typedef float xf2_t __attribute__((ext_vector_type(2)));
__device__ __forceinline__ unsigned pk2(float lo, float hi) { return __builtin_bit_cast(unsigned, __builtin_convertvector((xf2_t){lo, hi}, xbf2_t)); }
__device__ __forceinline__ unsigned f2bf(float f) { return (unsigned)__builtin_bit_cast(unsigned short, (__bf16)f); }
#define XB_TMO      128
#define XB_XCNT(j)  (256  + 64 * (j))
#define XB_XSUB(j)  (1280 + 64 * (j))
#define XB_XGEN(j)  (2304 + 64 * (j))
#define XB_TOP      3328
#define XB_TOPGEN   3392
#define XCD_BAR_WORDS 3456
#define XB_SPIN_CAP (1u << 18)

__device__ __forceinline__ unsigned xb_ld(unsigned* p)              { return __hip_atomic_load(p, __ATOMIC_RELAXED, __HIP_MEMORY_SCOPE_AGENT); }
__device__ __forceinline__ unsigned xb_add(unsigned* p, unsigned v) { return __hip_atomic_fetch_add(p, v, __ATOMIC_RELAXED, __HIP_MEMORY_SCOPE_AGENT); }
__device__ __forceinline__ unsigned xb_xcc_id() { return (unsigned)__builtin_amdgcn_s_getreg((3 << 11) | 20) & 0xFu; }
#define XB_SPIN(cond, bar) do { unsigned _sp = 0; while (cond) { __builtin_amdgcn_s_sleep(1); \
    if ((++_sp & 255u) == 0u) { if (xb_ld(&(bar)[XB_TMO])) break; if (_sp > XB_SPIN_CAP) { atomicAdd(&(bar)[XB_TMO], 1u); break; } } } } while (0)

struct XcdBarrier {
    unsigned* bar; unsigned x;
    volatile LAS unsigned* st;
};

__device__ __forceinline__ XcdBarrier xcd_barrier_post(unsigned* bar, volatile LAS unsigned* st) {
    XcdBarrier b; b.bar = bar; b.x = xb_xcc_id(); b.st = st;
    if (threadIdx.x == 0) (void)xb_add(&bar[XB_XCNT(b.x)], 1u);
    return b;
}
__device__ __forceinline__ void xcd_barrier_complete(unsigned* bar, unsigned x, unsigned& nloc, unsigned& nx) {
    const unsigned G = gridDim.x * gridDim.y * gridDim.z;
    unsigned sum, cnt, mine, sp = 0u;
    for (;;) {
        sum = 0u; cnt = 0u; mine = 0u;
#pragma unroll
        for (unsigned j = 0; j < 16; ++j) { const unsigned c = xb_ld(&bar[XB_XCNT(j)]); sum += c; cnt += (c > 0u) ? 1u : 0u; mine = (j == x) ? c : mine; }
        if (sum == G) break;
        __builtin_amdgcn_s_sleep(1);
        if ((++sp & 255u) == 0u) { if (xb_ld(&bar[XB_TMO])) break; if (sp > XB_SPIN_CAP) { atomicAdd(&bar[XB_TMO], 1u); break; } }
    }
    nloc = mine > 0u ? mine : 1u; nx = cnt > 0u ? cnt : 1u;
}

__device__ __forceinline__ void xcd_barrier(const XcdBarrier& b) {
    asm volatile("s_waitcnt vmcnt(0)" ::: "memory");
    __syncthreads();
    if (threadIdx.x == 0) {
        unsigned* bar = b.bar;
        __builtin_amdgcn_s_waitcnt(0);
        unsigned nloc = b.st[0], nx = b.st[1];
        if (nloc == 0u) { xcd_barrier_complete(bar, b.x, nloc, nx); b.st[0] = nloc; b.st[1] = nx; }
        const unsigned old = xb_add(&bar[XB_XSUB(b.x)], 1u);
        const unsigned gen = old / nloc;
        if (old + 1u == (gen + 1u) * nloc) {
            __builtin_amdgcn_fence(__ATOMIC_RELEASE, "agent");
            asm volatile("s_waitcnt vmcnt(0)" ::: "memory");
            const unsigned og = xb_add(&bar[XB_TOP], 1u);
            const unsigned tg = og / nx;
            if (og + 1u == (tg + 1u) * nx) xb_add(&bar[XB_TOPGEN], 1u);
            else XB_SPIN(xb_ld(&bar[XB_TOPGEN]) == tg, bar);
            __builtin_amdgcn_fence(__ATOMIC_ACQUIRE, "agent");
            xb_add(&bar[XB_XGEN(b.x)], 1u);
            asm volatile("s_waitcnt vmcnt(0)" ::: "memory");
        } else {
            XB_SPIN(xb_ld(&bar[XB_XGEN(b.x)]) == gen, bar);
            __builtin_amdgcn_fence(__ATOMIC_ACQUIRE, "agent");
            asm volatile("s_waitcnt vmcnt(0)" ::: "memory");
        }
    }
    __syncthreads();
}
template <bool ROPEPERM = false> __device__ __forceinline__ void p0_transpose_item(const float* W, int K, int N, bf16* WT, int row_off, LAS float* scr, int item, int lane) {
    const int nblk = N / 32, kb = item / nblk, nb = item % nblk, k0 = 64 * kb, n0 = 32 * nb;
    float wv[32];
#pragma unroll
    for (int i = 0; i < 32; ++i) wv[i] = W[(size_t)(k0 + 2 * i + (lane >> 5)) * N + n0 + (lane & 31)];
#pragma unroll
    for (int i = 0; i < 32; ++i) scr[(2 * i + (lane >> 5)) * 33 + (lane & 31)] = wv[i];
    LDS_WAIT(); asm volatile("" ::: "memory");
    const int c = lane & 7;
#pragma unroll
    for (int j = 0; j < 4; ++j) { const int n = (lane >> 3) + 8 * j; const LAS float* s = scr + (8 * c) * 33 + n; const int nd = (ROPEPERM && n0 < 2048) ? 2 * (n & 15) + (n >> 4) : n;
        v4u o; o.x = pk2(s[0 * 33], s[1 * 33]); o.y = pk2(s[2 * 33], s[3 * 33]); o.z = pk2(s[4 * 33], s[5 * 33]); o.w = pk2(s[6 * 33], s[7 * 33]);
        *(GAS v4u*)(WT + (size_t)(row_off + n0 + nd) * K + k0 + 8 * c) = o; }
    LDS_WAIT(); asm volatile("" ::: "memory");
}
namespace att {
using bf16x8 = __attribute__((ext_vector_type(8))) short;
using s16x4  = __attribute__((ext_vector_type(4))) short;
using f32x16 = __attribute__((ext_vector_type(16))) float;
using u32x4  = __attribute__((ext_vector_type(4))) unsigned;
constexpr int KVBLK = 64, LDP = 5120;
constexpr int SHM_V = KVBLK * 128 * 2, SHM_K = KVBLK * 128 * 2;
constexpr float THRN = 8.f;
#define ATT_KSWZ(row, colB) ((row) * 256 + ((colB) ^ (((row) & 7) << 4)))
#define ATT_SBAR() __builtin_amdgcn_sched_barrier(0)
__device__ __forceinline__ int crow(int r, int hi) { return (r & 3) + 8 * (r >> 2) + 4 * hi; }
__device__ __forceinline__ unsigned cvtpk(float lo, float hi) { unsigned r; asm volatile("v_cvt_pk_bf16_f32 %0, %1, %2" : "=v"(r) : "v"(lo), "v"(hi)); return r; }
constexpr float THR2 = 8.f * 1.4426950408889634f;
typedef float f32x2_t __attribute__((ext_vector_type(2)));
template <bool FIRST> __device__ __forceinline__ void partialSM(f32x16& p0, f32x16& p1, float& m_ref, float& alpha) {
  float pmax = p0[0];
#pragma unroll
  for (int r = 1; r < 16; ++r) pmax = fmaxf(pmax, p0[r]);
#pragma unroll
  for (int r = 0; r < 16; ++r) pmax = fmaxf(pmax, p1[r]);
  { auto rr = __builtin_amdgcn_permlane32_swap(__float_as_uint(pmax), __float_as_uint(pmax), false, false);
    pmax = fmaxf(__uint_as_float(rr[0]), __uint_as_float(rr[1])); }
  alpha = 1.f;
  if (FIRST) m_ref = pmax;
  else if (!__builtin_expect(__all(pmax - m_ref <= THR2), 1)) { const float mn = fmaxf(m_ref, pmax); alpha = __builtin_amdgcn_exp2f(m_ref - mn); m_ref = mn; }
  const f32x2_t nm = {-m_ref, -m_ref};
#pragma unroll
  for (int r = 0; r < 16; r += 2) { const f32x2_t a = (f32x2_t){p0[r], p0[r + 1]} + nm, b = (f32x2_t){p1[r], p1[r + 1]} + nm; p0[r] = a.x; p0[r + 1] = a.y; p1[r] = b.x; p1[r + 1] = b.y; }
#pragma unroll
  for (int r = 0; r < 16; ++r) p0[r] = __builtin_amdgcn_exp2f(p0[r]);
}
__device__ __forceinline__ void finishSM(f32x16& p0, f32x16& p1, float alpha, float& l_reg, bf16x8& pa0, bf16x8& pa1, bf16x8& pa2, bf16x8& pa3) {
#pragma unroll
  for (int r = 0; r < 16; ++r) p1[r] = __builtin_amdgcn_exp2f(p1[r]);
  float ps = 0;
#pragma unroll
  for (int r = 0; r < 16; ++r) ps += p0[r];
#pragma unroll
  for (int r = 0; r < 16; ++r) ps += p1[r];
  { auto rr = __builtin_amdgcn_permlane32_swap(__float_as_uint(ps), __float_as_uint(ps), false, false);
    ps = __uint_as_float(rr[0]) + __uint_as_float(rr[1]); }
  l_reg = l_reg * alpha + ps;
#define ATT_PK4(P, BASE, OUT) do { unsigned a0 = cvtpk(P[BASE + 0], P[BASE + 1]), a1 = cvtpk(P[BASE + 2], P[BASE + 3]);   \
    unsigned b0 = cvtpk(P[BASE + 4], P[BASE + 5]), b1 = cvtpk(P[BASE + 6], P[BASE + 7]);                              \
    auto r0 = __builtin_amdgcn_permlane32_swap(a0, b0, false, false); auto r1 = __builtin_amdgcn_permlane32_swap(a1, b1, false, false); \
    u32x4 w = {r0[0], r1[0], r0[1], r1[1]}; OUT = *reinterpret_cast<bf16x8*>(&w); } while (0)
  ATT_PK4(p0, 0, pa0); ATT_PK4(p0, 8, pa1); ATT_PK4(p1, 0, pa2); ATT_PK4(p1, 8, pa3);
#undef ATT_PK4
}
__device__ __forceinline__ void qkt(f32x16& p0, f32x16& p1, const LAS unsigned char* Ks, const bf16x8* qr, int r32, int hi, int mp) {
  p0 = f32x16{}; p1 = f32x16{};
#pragma unroll
  for (int d0 = 0; d0 < 4; ++d0) { const int cb = ((mp * 4 + d0) * 16 + hi * 8) * 2;
    const bf16x8 b0 = *(const LAS bf16x8*)(Ks + ATT_KSWZ(r32, cb));
    const bf16x8 b1 = *(const LAS bf16x8*)(Ks + ATT_KSWZ(32 + r32, cb));
    p0 = __builtin_amdgcn_mfma_f32_32x32x16_bf16(b0, qr[d0], p0, 0, 0, 0);
    p1 = __builtin_amdgcn_mfma_f32_32x32x16_bf16(b1, qr[d0], p1, 0, 0, 0); }
}
__device__ __forceinline__ int v_st(int k, int c) { const int kk = (k & ~0xC) | ((k & 4) << 1) | ((k & 8) >> 1); return ((kk >> 3) * 4 + (c >> 5)) * 512 + ((kk & 7) * 32 + (c & 31)) * 2; }
__device__ __forceinline__ int v_rd_base(int lane) { return ((lane & 3) << 3) | (((lane >> 2) & 3) << 6) | (((lane >> 4) & 1) << 5) | (((lane >> 5) & 1) << 8); }
constexpr int v_rd_off(int d0, int ks, int half) { return d0 * 512 + ks * 4096 + half * 2048; }
template <int OFF> __device__ __forceinline__ s16x4 tr_read(int vb) {
  s16x4 r; asm volatile("ds_read_b64_tr_b16 %0, %1 offset:%2" : "=&v"(r) : "v"(vb), "i"(OFF) : "memory"); return r;
}
template <int D0> __device__ __forceinline__ void pv_one(f32x16& od, int vb, bf16x8 pa0, bf16x8 pa1, bf16x8 pa2, bf16x8 pa3) {
  const s16x4 l0 = tr_read<v_rd_off(D0, 0, 0)>(vb), h0 = tr_read<v_rd_off(D0, 0, 1)>(vb), l1 = tr_read<v_rd_off(D0, 1, 0)>(vb), h1 = tr_read<v_rd_off(D0, 1, 1)>(vb);
  const s16x4 l2 = tr_read<v_rd_off(D0, 2, 0)>(vb), h2 = tr_read<v_rd_off(D0, 2, 1)>(vb), l3 = tr_read<v_rd_off(D0, 3, 0)>(vb), h3 = tr_read<v_rd_off(D0, 3, 1)>(vb);
  asm volatile("s_waitcnt lgkmcnt(0)" ::: "memory"); ATT_SBAR();
#define ATT_PK(L, H) (bf16x8){L[0], L[1], L[2], L[3], H[0], H[1], H[2], H[3]}
  od = __builtin_amdgcn_mfma_f32_32x32x16_bf16(pa0, ATT_PK(l0, h0), od, 0, 0, 0);
  od = __builtin_amdgcn_mfma_f32_32x32x16_bf16(pa1, ATT_PK(l1, h1), od, 0, 0, 0);
  od = __builtin_amdgcn_mfma_f32_32x32x16_bf16(pa2, ATT_PK(l2, h2), od, 0, 0, 0);
  od = __builtin_amdgcn_mfma_f32_32x32x16_bf16(pa3, ATT_PK(l3, h3), od, 0, 0, 0);
#undef ATT_PK
}
__device__ __forceinline__ void pv_d0(f32x16* o, int vb, bf16x8 pa0, bf16x8 pa1, bf16x8 pa2, bf16x8 pa3) {
  pv_one<0>(o[0], vb, pa0, pa1, pa2, pa3); pv_one<1>(o[1], vb, pa0, pa1, pa2, pa3); pv_one<2>(o[2], vb, pa0, pa1, pa2, pa3); pv_one<3>(o[3], vb, pa0, pa1, pa2, pa3);
}

#define ATT_PIN(x) asm volatile("" : "+v"(x))
__device__ __forceinline__ bf16x8 mk_pa(unsigned a, unsigned b, unsigned c, unsigned d) { u32x4 w = {a, b, c, d}; return *reinterpret_cast<bf16x8*>(&w); }
__device__ __forceinline__ void firstSM(f32x16& p0, f32x16& p1, float& m_ref) {
  float pmax = p0[0];
#pragma unroll
  for (int r = 1; r < 16; ++r) pmax = fmaxf(pmax, p0[r]);
#pragma unroll
  for (int r = 0; r < 16; ++r) pmax = fmaxf(pmax, p1[r]);
  { auto rr = __builtin_amdgcn_permlane32_swap(__float_as_uint(pmax), __float_as_uint(pmax), false, false);
    pmax = fmaxf(__uint_as_float(rr[0]), __uint_as_float(rr[1])); }
  m_ref = pmax;
#pragma unroll
  for (int r = 0; r < 16; ++r) { p0[r] = __builtin_amdgcn_exp2f(p0[r] - pmax); p1[r] = __builtin_amdgcn_exp2f(p1[r] - pmax); }
}
__device__ __forceinline__ void finishOnly(const f32x16& p0, const f32x16& p1, float alpha, float& l_reg, bf16x8& pa0, bf16x8& pa1, bf16x8& pa2, bf16x8& pa3) {
  float s0 = 0.f, s1 = 0.f;
#pragma unroll
  for (int r = 0; r < 16; r += 2) { s0 += p0[r]; s1 += p0[r + 1]; }
#pragma unroll
  for (int r = 0; r < 16; r += 2) { s0 += p1[r]; s1 += p1[r + 1]; }
  l_reg = l_reg * alpha + (s0 + s1);
  pa0 = mk_pa(cvtpk(p0[0], p0[1]), cvtpk(p0[2], p0[3]), cvtpk(p0[4], p0[5]), cvtpk(p0[6], p0[7]));
  pa1 = mk_pa(cvtpk(p0[8], p0[9]), cvtpk(p0[10], p0[11]), cvtpk(p0[12], p0[13]), cvtpk(p0[14], p0[15]));
  pa2 = mk_pa(cvtpk(p1[0], p1[1]), cvtpk(p1[2], p1[3]), cvtpk(p1[4], p1[5]), cvtpk(p1[6], p1[7]));
  pa3 = mk_pa(cvtpk(p1[8], p1[9]), cvtpk(p1[10], p1[11]), cvtpk(p1[12], p1[13]), cvtpk(p1[14], p1[15]));
}
__device__ __forceinline__ void phaseA(f32x16& S0, f32x16& S1, const LAS unsigned char* Ks, const bf16x8* qr, int r32, int hi, int mp,
                                       const f32x16& P0, const f32x16& P1, float alphaP, float& l_reg, bf16x8& pa0, bf16x8& pa1, bf16x8& pa2, bf16x8& pa3, float& m0,
                                       int vb, s16x4& vl0, s16x4& vh0, s16x4& vl1, s16x4& vh1, s16x4& vl2, s16x4& vh2, s16x4& vl3, s16x4& vh3) {
  const int cbb = (mp * 64 + hi * 8) * 2;
#define ATT_KF(row, d0) (*(const LAS bf16x8*)(Ks + ATT_KSWZ((row), cbb + (d0) * 32)))
  bf16x8 ka0 = ATT_KF(r32, 0), ka1 = ATT_KF(r32, 1), ka2 = ATT_KF(r32, 2), ka3 = ATT_KF(r32, 3), kb0, kb1, kb2, kb3;
  float s0 = 0.f, s1 = 0.f; unsigned c0, c1, c2, c3, c4, c5, c6, c7;
  S0 = f32x16{}; S1 = f32x16{};
#define ATT_FA(P, B, CA, CB) do { s0 += P[B]; s1 += P[B + 1]; s0 += P[B + 2]; s1 += P[B + 3]; CA = cvtpk(P[B], P[B + 1]); CB = cvtpk(P[B + 2], P[B + 3]); ATT_PIN(s0); ATT_PIN(s1); } while (0)
  ATT_SBAR();
  S0 = __builtin_amdgcn_mfma_f32_32x32x16_bf16(ka0, qr[0], S0, 0, 0, 0); ATT_FA(P0, 0, c0, c1); kb0 = ATT_KF(32 + r32, 0); kb1 = ATT_KF(32 + r32, 1); ATT_SBAR();
  S0 = __builtin_amdgcn_mfma_f32_32x32x16_bf16(ka1, qr[1], S0, 0, 0, 0); ATT_FA(P0, 4, c2, c3); kb2 = ATT_KF(32 + r32, 2); kb3 = ATT_KF(32 + r32, 3); ATT_SBAR();
  pa0 = mk_pa(c0, c1, c2, c3);
  S0 = __builtin_amdgcn_mfma_f32_32x32x16_bf16(ka2, qr[2], S0, 0, 0, 0); ATT_FA(P0, 8, c4, c5); ATT_SBAR();
  S0 = __builtin_amdgcn_mfma_f32_32x32x16_bf16(ka3, qr[3], S0, 0, 0, 0); ATT_FA(P0, 12, c6, c7); ATT_SBAR();
  pa1 = mk_pa(c4, c5, c6, c7);
  S1 = __builtin_amdgcn_mfma_f32_32x32x16_bf16(kb0, qr[0], S1, 0, 0, 0); ATT_FA(P1, 0, c0, c1); vl0 = tr_read<v_rd_off(0, 0, 0)>(vb); vh0 = tr_read<v_rd_off(0, 0, 1)>(vb); ATT_SBAR();
  float ma, mb;
  S1 = __builtin_amdgcn_mfma_f32_32x32x16_bf16(kb1, qr[1], S1, 0, 0, 0); ATT_FA(P1, 4, c2, c3);
  ma = fmaxf(fmaxf(S0[0], S0[1]), S0[2]); mb = fmaxf(fmaxf(S0[3], S0[4]), S0[5]); ATT_PIN(ma); ATT_PIN(mb); vl1 = tr_read<v_rd_off(0, 1, 0)>(vb); vh1 = tr_read<v_rd_off(0, 1, 1)>(vb); ATT_SBAR();
  pa2 = mk_pa(c0, c1, c2, c3);
  S1 = __builtin_amdgcn_mfma_f32_32x32x16_bf16(kb2, qr[2], S1, 0, 0, 0); ATT_FA(P1, 8, c4, c5);
  ma = fmaxf(fmaxf(ma, S0[6]), S0[7]); mb = fmaxf(fmaxf(mb, S0[8]), S0[9]); ma = fmaxf(fmaxf(ma, S0[10]), S0[11]); ATT_PIN(ma); ATT_PIN(mb); vl2 = tr_read<v_rd_off(0, 2, 0)>(vb); vh2 = tr_read<v_rd_off(0, 2, 1)>(vb); ATT_SBAR();
  S1 = __builtin_amdgcn_mfma_f32_32x32x16_bf16(kb3, qr[3], S1, 0, 0, 0); ATT_FA(P1, 12, c6, c7);
  mb = fmaxf(fmaxf(mb, S0[12]), S0[13]); ma = fmaxf(fmaxf(ma, S0[14]), S0[15]); ATT_PIN(ma); ATT_PIN(mb); vl3 = tr_read<v_rd_off(0, 3, 0)>(vb); vh3 = tr_read<v_rd_off(0, 3, 1)>(vb); ATT_SBAR();
  pa3 = mk_pa(c4, c5, c6, c7);
  m0 = fmaxf(ma, mb);
  l_reg = l_reg * alphaP + (s0 + s1);
#undef ATT_FA
#undef ATT_KF
}
__device__ __forceinline__ void decideSM(const f32x16& S1, float m0, float& m_ref, float& alpha) {
  float ma = fmaxf(fmaxf(m0, S1[0]), S1[1]), mb = fmaxf(fmaxf(S1[2], S1[3]), S1[4]);
  ma = fmaxf(fmaxf(ma, S1[5]), S1[6]); mb = fmaxf(fmaxf(mb, S1[7]), S1[8]); ma = fmaxf(fmaxf(ma, S1[9]), S1[10]); mb = fmaxf(fmaxf(mb, S1[11]), S1[12]);
  ma = fmaxf(fmaxf(ma, S1[13]), S1[14]); float pmax = fmaxf(fmaxf(ma, mb), S1[15]);
  alpha = 1.f;
  if (!__builtin_expect(__all(pmax - m_ref <= THR2), 1)) {
    auto rr = __builtin_amdgcn_permlane32_swap(__float_as_uint(pmax), __float_as_uint(pmax), false, false);
    pmax = fmaxf(__uint_as_float(rr[0]), __uint_as_float(rr[1]));
    const float mn = fmaxf(m_ref, pmax); alpha = __builtin_amdgcn_exp2f(m_ref - mn); m_ref = mn; }
}
#define ATT_PK(L, H) (bf16x8){L[0], L[1], L[2], L[3], H[0], H[1], H[2], H[3]}
#define ATT_EXP2(S, E) do { float x0_ = __builtin_amdgcn_exp2f(S[E] - m_ref), x1_ = __builtin_amdgcn_exp2f(S[E + 1] - m_ref); ATT_PIN(x0_); ATT_PIN(x1_); S[E] = x0_; S[E + 1] = x1_; } while (0)
#define ATT_PVG(OD, L0, H0, L1, H1, L2, H2, L3, H3, SX, E0, RDNEXT, D0N, NL0, NH0, NL1, NH1, NL2, NH2, NL3, NH3) do { \
    OD = __builtin_amdgcn_mfma_f32_32x32x16_bf16(pa0, ATT_PK(L0, H0), OD, 0, 0, 0); ATT_EXP2(SX, E0);     if (RDNEXT) { NL0 = tr_read<v_rd_off(D0N, 0, 0)>(vb); NH0 = tr_read<v_rd_off(D0N, 0, 1)>(vb); } ATT_SBAR(); \
    OD = __builtin_amdgcn_mfma_f32_32x32x16_bf16(pa1, ATT_PK(L1, H1), OD, 0, 0, 0); ATT_EXP2(SX, E0 + 2); if (RDNEXT) { NL1 = tr_read<v_rd_off(D0N, 1, 0)>(vb); NH1 = tr_read<v_rd_off(D0N, 1, 1)>(vb); } ATT_SBAR(); \
    OD = __builtin_amdgcn_mfma_f32_32x32x16_bf16(pa2, ATT_PK(L2, H2), OD, 0, 0, 0); ATT_EXP2(SX, E0 + 4); if (RDNEXT) { NL2 = tr_read<v_rd_off(D0N, 2, 0)>(vb); NH2 = tr_read<v_rd_off(D0N, 2, 1)>(vb); } ATT_SBAR(); \
    OD = __builtin_amdgcn_mfma_f32_32x32x16_bf16(pa3, ATT_PK(L3, H3), OD, 0, 0, 0); ATT_EXP2(SX, E0 + 6); if (RDNEXT) { NL3 = tr_read<v_rd_off(D0N, 3, 0)>(vb); NH3 = tr_read<v_rd_off(D0N, 3, 1)>(vb); } \
    asm volatile("s_waitcnt lgkmcnt(0)" ::: "memory"); ATT_SBAR(); } while (0)
__device__ __forceinline__ void phaseB(f32x16* o, int vb, bf16x8 pa0, bf16x8 pa1, bf16x8 pa2, bf16x8 pa3, f32x16& S0, f32x16& S1, float m_ref,
                                       s16x4 al0, s16x4 ah0, s16x4 al1, s16x4 ah1, s16x4 al2, s16x4 ah2, s16x4 al3, s16x4 ah3) {
  s16x4 bl0, bh0, bl1, bh1, bl2, bh2, bl3, bh3;
  asm volatile("s_waitcnt lgkmcnt(0)" ::: "memory"); ATT_SBAR();
  ATT_PVG(o[0], al0, ah0, al1, ah1, al2, ah2, al3, ah3, S0, 0, true, 1, bl0, bh0, bl1, bh1, bl2, bh2, bl3, bh3);
  ATT_PVG(o[1], bl0, bh0, bl1, bh1, bl2, bh2, bl3, bh3, S0, 8, true, 2, al0, ah0, al1, ah1, al2, ah2, al3, ah3);
  ATT_PVG(o[2], al0, ah0, al1, ah1, al2, ah2, al3, ah3, S1, 0, true, 3, bl0, bh0, bl1, bh1, bl2, bh2, bl3, bh3);
  ATT_PVG(o[3], bl0, bh0, bl1, bh1, bl2, bh2, bl3, bh3, S1, 8, false, 3, al0, ah0, al1, ah1, al2, ah2, al3, ah3);
}
__device__ __forceinline__ int tile_row(int b, int t) { return t < 4 ? b * 256 + 64 * t : 1024 + b * 4096 + 64 * (t - 4); }

__device__ __forceinline__ void att_glds(const void* gbase, unsigned voffB, unsigned lds_dst) { unsigned keep;
  asm volatile("s_mov_b32 %0, m0\n\ts_mov_b32 m0, %3\n\ts_nop 0\n\tglobal_load_lds_dwordx4 %1, %2\n\ts_mov_b32 m0, %0" : "=&s"(keep) : "v"(voffB), "s"(gbase), "s"(lds_dst) : "memory"); }
constexpr int SLOT_BYTES = SHM_K + SHM_V;
__device__ __forceinline__ void attn_unit(const unsigned short* __restrict__ P, unsigned short* __restrict__ Y, int b, int hh, int qrow0, int NT, float lam, float post, const float* __restrict__ sg, LAS unsigned char* lds) {
  int tid_ = threadIdx.x; asm volatile("" : "+v"(tid_)); const int tid = tid_, wid = __builtin_amdgcn_readfirstlane(tid >> 6), lane = tid & 63, r32 = lane & 31, hi = lane >> 5, mp = wid >> 2, wq = wid & 3;
  LAS float* wsf = (LAS float*)(lds + 3 * SLOT_BYTES) + wid * 64; LAS float* li_l = wsf; LAS float* al_l = wsf + 32;
  float m_reg = 0.f, l_reg = 0; f32x16 o[4] = {}; bf16x8 qr[4];
  const unsigned short* Qw = P + (size_t)(qrow0 + wq * 32 + r32) * LDP + hh * 128 + mp * 64 + hi * 8;
#pragma unroll
  for (int d0 = 0; d0 < 4; ++d0) qr[d0] = *(const bf16x8*)(Qw + d0 * 16);
  unsigned koff, voff;
  { const int u = wid * 64 + lane;
      { const int row = u >> 4, c16 = (u & 15) ^ (row & 7); koff = (unsigned)(row * LDP + 1024 + hh * 128 + c16 * 8) * 2u; }
      { const int sub = u >> 5, within = u & 31, kk = (sub >> 2) * 8 + (within >> 2), k = kk, c = (sub & 3) * 32 + (within & 3) * 8; voff = (unsigned)(k * LDP + 2048 + hh * 128 + c) * 2u; } }
  const unsigned koff2 = koff + 32u * LDP * 2u, voff2 = voff + 32u * LDP * 2u;
  const unsigned lds0 = (unsigned)(uintptr_t)lds;
#define ATT_DMA(t, slot_off) do { const unsigned short* tb_ = P + (size_t)tile_row(b, (t)) * LDP; const unsigned d_ = lds0 + (slot_off); \
    att_glds(tb_, koff, (unsigned)__builtin_amdgcn_readfirstlane(d_ + wid * 1024)); att_glds(tb_, koff2, (unsigned)__builtin_amdgcn_readfirstlane(d_ + (wid + 8) * 1024)); \
    att_glds(tb_, voff, (unsigned)__builtin_amdgcn_readfirstlane(d_ + SHM_K + wid * 1024)); att_glds(tb_, voff2, (unsigned)__builtin_amdgcn_readfirstlane(d_ + SHM_K + (wid + 8) * 1024)); } while (0)
#define ATT_RESC(a) do { if (__any((a) < 1.f)) { if (hi == 0) al_l[r32] = (a); asm volatile("s_waitcnt lgkmcnt(0)" ::: "memory"); \
    _Pragma("unroll") for (int d = 0; d < 4; ++d) _Pragma("unroll") for (int r = 0; r < 16; ++r) o[d][r] *= al_l[crow(r, hi)]; } } while (0)
#define ATT_WAITBAR(N) asm volatile("s_waitcnt vmcnt(" #N ") lgkmcnt(0)\n\ts_barrier" ::: "memory")
  const int vb0 = (int)lds0 + SHM_K + v_rd_base(lane);
  f32x16 pA0, pA1, pB0, pB1; float alA, alB; bf16x8 pa0, pa1, pa2, pa3;
  int s_cur = 0, s_nxt = SLOT_BYTES, s_nn = 2 * SLOT_BYTES;
#define ATT_ROT() do { const int t_ = s_cur; s_cur = s_nxt; s_nxt = s_nn; s_nn = t_; } while (0)
  ATT_DMA(0, 0); ATT_DMA(1, SLOT_BYTES);
  ATT_WAITBAR(4);
  if (2 < NT) ATT_DMA(2, 2 * SLOT_BYTES);
  qkt(pA0, pA1, lds + s_cur, qr, r32, hi, mp); firstSM(pA0, pA1, m_reg); alA = 1.f;
  if (2 < NT) ATT_WAITBAR(4); else ATT_WAITBAR(0);
  float m0; s16x4 vl0, vh0, vl1, vh1, vl2, vh2, vl3, vh3;
  for (int t = 0; t + 1 < NT; t += 2) {
    phaseA(pB0, pB1, lds + s_nxt, qr, r32, hi, mp, pA0, pA1, alA, l_reg, pa0, pa1, pa2, pa3, m0, vb0 + s_cur, vl0, vh0, vl1, vh1, vl2, vh2, vl3, vh3);
    decideSM(pB1, m0, m_reg, alB); ATT_SBAR();
    phaseB(o, vb0 + s_cur, pa0, pa1, pa2, pa3, pB0, pB1, m_reg, vl0, vh0, vl1, vh1, vl2, vh2, vl3, vh3);
    ATT_RESC(alB);
    ATT_WAITBAR(0);
    if (t + 3 < NT) ATT_DMA(t + 3, s_cur);
    ATT_ROT();
    if (t + 2 < NT) {
      phaseA(pA0, pA1, lds + s_nxt, qr, r32, hi, mp, pB0, pB1, alB, l_reg, pa0, pa1, pa2, pa3, m0, vb0 + s_cur, vl0, vh0, vl1, vh1, vl2, vh2, vl3, vh3);
      decideSM(pA1, m0, m_reg, alA); ATT_SBAR();
      phaseB(o, vb0 + s_cur, pa0, pa1, pa2, pa3, pA0, pA1, m_reg, vl0, vh0, vl1, vh1, vl2, vh2, vl3, vh3);
      ATT_RESC(alA);
      ATT_WAITBAR(0);
      if (t + 4 < NT) ATT_DMA(t + 4, s_cur);
      ATT_ROT();
    }
  }
  finishOnly(pB0, pB1, alB, l_reg, pa0, pa1, pa2, pa3); ATT_SBAR();
  pv_d0(o, vb0 + s_cur, pa0, pa1, pa2, pa3);
  { auto rr = __builtin_amdgcn_permlane32_swap(__float_as_uint(l_reg), __float_as_uint(l_reg), false, false); l_reg = __uint_as_float(rr[0]) + __uint_as_float(rr[1]); }
  if (hi == 0) li_l[r32] = l_reg; asm volatile("s_waitcnt lgkmcnt(0)" ::: "memory");
  float rli[16];
#pragma unroll
  for (int r = 0; r < 16; ++r) rli[r] = __builtin_amdgcn_rcpf(li_l[crow(r, hi)]);
  __syncthreads();
  LAS float* X = (LAS float*)lds;
  if (mp == 1) {
#pragma unroll
    for (int r = 0; r < 16; ++r)
#pragma unroll
      for (int d0 = 0; d0 < 4; ++d0) X[(wq * 32 + crow(r, hi)) * 128 + d0 * 32 + r32] = o[d0][r] * rli[r] * lam;
  }
  __syncthreads();
  if (mp == 0) {
    float ss[16];
#pragma unroll
    for (int r = 0; r < 16; ++r) { float s = 0.f;
#pragma unroll
      for (int d0 = 0; d0 < 4; ++d0) { const float v = o[d0][r] * rli[r] - X[(wq * 32 + crow(r, hi)) * 128 + d0 * 32 + r32]; o[d0][r] = v; s += v * v; }
      ss[r] = s; }
#pragma unroll
    for (int r = 0; r < 16; ++r) {
      ss[r] = ::sum_x16(::sum_row16(ss[r]));
      ss[r] = post * __builtin_amdgcn_rsqf(ss[r] * (1.f / 128.f) + 1e-6f); }
    float gg[4];
#pragma unroll
    for (int d0 = 0; d0 < 4; ++d0) gg[d0] = sg[d0 * 32 + r32];
    unsigned short* Yw = Y + (size_t)(qrow0 + wq * 32) * 2048 + hh * 128 + r32;
#pragma unroll
    for (int r = 0; r < 16; ++r)
#pragma unroll
      for (int d0 = 0; d0 < 4; ++d0) Yw[(size_t)crow(r, hi) * 2048 + d0 * 32] = (unsigned short)f2bf(o[d0][r] * ss[r] * gg[d0]);
  }
  __syncthreads();
#undef ATT_DMA
#undef ATT_WAITBAR
#undef ATT_ROT
#undef ATT_RESC
}
}
namespace gla {
using bf16x8 = __attribute__((ext_vector_type(8))) short;
using f32x4 = __attribute__((ext_vector_type(4))) float;
using u32x4 = __attribute__((ext_vector_type(4))) unsigned;
typedef float f32x2 __attribute__((ext_vector_type(2)));
constexpr int LDP = 6400, NCH = 68;
constexpr int QE_BYTES = 32768, KDT_BYTES = 32768 + 1024, ATT_BYTES = 8192, VT_BYTES = 65536;
constexpr size_t QEI_OFF = 0, KDI_OFF = QEI_OFF + (size_t)2 * 16 * NCH * QE_BYTES, ATT_OFF = KDI_OFF + (size_t)2 * 16 * NCH * KDT_BYTES, VT_OFF = ATT_OFF + (size_t)2 * 16 * NCH * ATT_BYTES,
                 IMG_END = VT_OFF + (size_t)16 * NCH * VT_BYTES;
__device__ __forceinline__ int chunk_row(int b, int c) { return c < 4 ? b * 256 + 64 * c : 1024 + b * 4096 + 64 * (c - 4); }
__device__ __forceinline__ unsigned cvtpk(float lo, float hi) { unsigned r; asm volatile("v_cvt_pk_bf16_f32 %0, %1, %2" : "=v"(r) : "v"(lo), "v"(hi)); return r; }
__device__ __forceinline__ float bf2f_(unsigned short v) { return __builtin_bit_cast(float, (unsigned)v << 16); }
__device__ __forceinline__ int qe_off(int t, int k) { const int ks = k >> 5, k5 = k & 31, g = (k5 & 15) >> 2, j = (k5 & 3) + ((k5 >> 4) << 2); const int ch = (4 * ks + g) ^ (t & 15); return t * 512 + ch * 16 + j * 2; }
__device__ __forceinline__ int r128_off(int r, int cidx) { return r * 128 + ((cidx ^ ((r >> 1) & 7)) << 4); }

__device__ __forceinline__ void prep_item(const unsigned short* __restrict__ P, unsigned char* __restrict__ img, const float* __restrict__ gw2, const float* __restrict__ gb, int c, int b, int hh, LAS unsigned char* lds) {
    int tid_ = threadIdx.x; asm volatile("" : "+v"(tid_)); const int tid = tid_, lane = tid & 63, wid = __builtin_amdgcn_readfirstlane(tid >> 6), g = lane >> 4, r16 = lane & 15;
    const int rb = chunk_row(b, c); const int bh = b * 4 + hh;
    LAS unsigned char* QEI = lds; LAS unsigned char* KEI = lds + 32768; LAS unsigned char* KDI = lds + 65536; LAS unsigned char* ATI = lds + 65536 + KDT_BYTES;
    LAS float* ZT = (LAS float*)(lds + 65536 + KDT_BYTES + ATT_BYTES); LAS float* SEG = ZT + 64 * 32;
    {
        { const int tb = tid & 7, vg = tid >> 3; u32x4 xr[8];
#pragma unroll
          for (int j = 0; j < 8; ++j) xr[j] = *(const u32x4*)(P + (size_t)(rb + 8 * tb + j) * LDP + 2048 + hh * 512 + 8 * vg);
#pragma unroll
          for (int q = 0; q < 8; ++q) { const int v = 8 * vg + q; unsigned ow[4];
#pragma unroll
              for (int w = 0; w < 4; ++w) { const unsigned a = xr[2 * w][q >> 1], bq = xr[2 * w + 1][q >> 1]; ow[w] = (q & 1) ? ((a >> 16) | (bq & 0xffff0000u)) : ((a & 0xffffu) | (bq << 16)); }
              *(LAS u32x4*)(lds + r128_off(v, tb)) = (u32x4){ow[0], ow[1], ow[2], ow[3]}; } }
        __syncthreads();
        unsigned char* dst = img + VT_OFF + (size_t)(bh * NCH + c) * VT_BYTES;
#pragma unroll
        for (int i = 0; i < 8; ++i) { const int e = tid + i * 512; *(u32x4*)(dst + (size_t)e * 16) = *(const LAS u32x4*)(lds + e * 16); }
        __syncthreads();
    }
    const int k = tid & 255, th = tid >> 8;
#pragma unroll
    for (int i = 0; i < 4; ++i) { const int e = tid + i * 512, t = e >> 5, c16 = e & 31; const size_t ro = (size_t)(rb + t) * LDP + hh * 256 + c16 * 8;
        *(LAS u32x4*)(QEI + t * 512 + c16 * 16) = *(const u32x4*)(P + ro); *(LAS u32x4*)(KEI + t * 512 + c16 * 16) = *(const u32x4*)(P + ro + 1024); }
    __syncthreads();
    float qreg[32], kreg[32];
#pragma unroll
    for (int i = 0; i < 32; ++i) { qreg[i] = bf2f_(*(const LAS unsigned short*)(QEI + (32 * th + i) * 512 + k * 2)) * 0.0625f; kreg[i] = bf2f_(*(const LAS unsigned short*)(KEI + (32 * th + i) * 512 + k * 2)); }
#pragma unroll
    for (int d = 0; d < 2; ++d) {
        LAS float* XG = (LAS float*)lds;
        if (d == 0) __syncthreads();
        { bf16x8 za[4];
#pragma unroll
          for (int tt = 0; tt < 4; ++tt) { za[tt] = (bf16x8){0, 0, 0, 0, 0, 0, 0, 0}; if (g < 2) za[tt] = *(const bf16x8*)(P + (size_t)(rb + 16 * tt + r16) * LDP + 6144 + d * 16 + 8 * g); }
#pragma unroll
          for (int j = 0; j < 2; ++j) { const int kc = 32 * wid + 16 * j + r16; float wv[8];
#pragma unroll
              for (int i = 0; i < 8; ++i) { wv[i] = 0.f; if (g < 2) wv[i] = gw2[(size_t)(d * 16 + 8 * g + i) * 1024 + hh * 256 + kc]; }
              unsigned hw[4], lw[4];
#pragma unroll
              for (int p = 0; p < 4; ++p) { hw[p] = pk2(wv[2 * p], wv[2 * p + 1]);
                  lw[p] = pk2(wv[2 * p] - __builtin_bit_cast(float, hw[p] << 16), wv[2 * p + 1] - __builtin_bit_cast(float, hw[p] & 0xffff0000u)); }
              const bf16x8 bh = __builtin_bit_cast(bf16x8, (u32x4){hw[0], hw[1], hw[2], hw[3]}), bl = __builtin_bit_cast(bf16x8, (u32x4){lw[0], lw[1], lw[2], lw[3]});
#pragma unroll
              for (int tt = 0; tt < 4; ++tt) { f32x4 ag = {0.f, 0.f, 0.f, 0.f};
                  ag = __builtin_amdgcn_mfma_f32_16x16x32_bf16(za[tt], bh, ag, 0, 0, 0); ag = __builtin_amdgcn_mfma_f32_16x16x32_bf16(za[tt], bl, ag, 0, 0, 0);
#pragma unroll
                  for (int rg = 0; rg < 4; ++rg) XG[(16 * tt + 4 * g + rg) * 256 + kc] = ag[rg]; } } }
        __syncthreads();
        const float bias = gb[d * 1024 + hh * 256 + k];
        float bc[32]; float run = 0.f;
#pragma unroll
        for (int i = 0; i < 32; ++i) { const int t = d == 0 ? 32 * th + i : 32 * th + 31 - i;
            const float x = XG[t * 256 + k] + bias;
            const float l2 = __builtin_amdgcn_logf(1.0f + __builtin_amdgcn_exp2f(fabsf(x) * -1.4426950408889634f));
            run += __builtin_fmaf(fminf(x, 0.f), 0.0625f * 1.4426950408889634f, l2 * -0.0625f); bc[i] = run; }
        SEG[th * 256 + k] = run;
        __syncthreads();
        const float s0 = SEG[k], s1 = SEG[256 + k]; const float bend = s0 + s1;
        const float pre = d == 0 ? (th == 1 ? s0 : 0.f) : (th == 0 ? s1 : 0.f);
        const float ebend = __builtin_amdgcn_exp2f(bend);
        unsigned kdp[16];
#pragma unroll
        for (int i = 0; i < 16; ++i) kdp[i] = 0u;
#pragma unroll
        for (int i = 0; i < 32; ++i) { const int t = d == 0 ? 32 * th + i : 32 * th + 31 - i; const float bcum = bc[i] + pre;
            const float qv = qreg[d == 0 ? i : 31 - i], kv = kreg[d == 0 ? i : 31 - i];
            const float qe = qv * __builtin_amdgcn_exp2f(bcum), ke = kv * __builtin_amdgcn_exp2f(-bcum), kd = ke * ebend;
            *(LAS unsigned short*)(QEI + qe_off(t, k)) = (unsigned short)f2bf(qe);
            *(LAS unsigned short*)(KEI + qe_off(t, k)) = (unsigned short)f2bf(ke);
            const int tl = t & 31;
            const unsigned hv = f2bf(kd);
            if (tl & 1) kdp[tl >> 1] = (kdp[tl >> 1] & 0xffffu) | (hv << 16); else kdp[tl >> 1] = (kdp[tl >> 1] & 0xffff0000u) | hv; }
#pragma unroll
        for (int cc = 0; cc < 4; ++cc) *(LAS u32x4*)(KDI + r128_off(k, 4 * th + cc)) = (u32x4){kdp[4 * cc], kdp[4 * cc + 1], kdp[4 * cc + 2], kdp[4 * cc + 3]};
        if (th == 0) *(LAS float*)(KDI + 32768 + 4 * k) = ebend;
        __syncthreads();
        { const int tt = wid >> 1; f32x4 acc[2] = {};
#pragma unroll
          for (int ks = 0; ks < 8; ++ks) { const int trow = 16 * tt + r16; const bf16x8 af = *(const LAS bf16x8*)(QEI + trow * 512 + (((4 * ks + g) ^ (trow & 15)) << 4));
#pragma unroll
            for (int mi = 0; mi < 2; ++mi) { const int mrow = 16 * (2 * (wid & 1) + mi) + r16; const bf16x8 bfr = *(const LAS bf16x8*)(KEI + mrow * 512 + (((4 * ks + g) ^ (mrow & 15)) << 4));
                acc[mi] = __builtin_amdgcn_mfma_f32_16x16x32_bf16(af, bfr, acc[mi], 0, 0, 0); } }
#pragma unroll
          for (int mi = 0; mi < 2; ++mi) { const int m = 16 * (2 * (wid & 1) + mi) + r16;
#pragma unroll
            for (int rg = 0; rg < 4; ++rg) { const int t = 16 * tt + 4 * g + rg; const bool keep = d == 0 ? (m <= t) : (m >= t);
                *(LAS unsigned short*)(ATI + r128_off(t, m >> 3) + (m & 7) * 2) = (unsigned short)f2bf(keep ? acc[mi][rg] : 0.f); } } }
        __syncthreads();
        { const size_t ii = (size_t)((d * 16 + bh) * NCH + c);
          unsigned char* dq = img + QEI_OFF + ii * QE_BYTES; unsigned char* dk = img + KDI_OFF + ii * KDT_BYTES; unsigned char* da = img + ATT_OFF + ii * ATT_BYTES;
#pragma unroll
          for (int i = 0; i < 4; ++i) { const int e = tid + i * 512; *(u32x4*)(dq + (size_t)e * 16) = *(const LAS u32x4*)(QEI + e * 16); }
          for (int e = tid; e < KDT_BYTES / 16; e += 512) *(u32x4*)(dk + (size_t)e * 16) = *(const LAS u32x4*)(KDI + e * 16);
          *(u32x4*)(da + (size_t)tid * 16) = *(const LAS u32x4*)(ATI + tid * 16); }
        __syncthreads();
    }
}

template <int DD> __device__ __forceinline__ void prep_half(const unsigned short* __restrict__ P, unsigned char* __restrict__ img, const float* __restrict__ gw2, const float* __restrict__ gb, int c, int b, int hh, LAS unsigned char* lds) {
    int tid_ = threadIdx.x; asm volatile("" : "+v"(tid_)); const int tid = tid_, lane = tid & 63, wid = __builtin_amdgcn_readfirstlane(tid >> 6), g = lane >> 4, r16 = lane & 15;
    const int rb = chunk_row(b, c); const int bh = b * 4 + hh;
    LAS unsigned char* QEI = lds; LAS unsigned char* KEI = lds + 32768; LAS unsigned char* KDI = lds + 65536; LAS unsigned char* ATI = lds + 65536 + KDT_BYTES;
    LAS float* ZT = (LAS float*)(lds + 65536 + KDT_BYTES + ATT_BYTES); LAS float* SEG = ZT + 64 * 32;
    __syncthreads();
    if (DD == 0) {
        { const int tb = tid & 7, vg = tid >> 3; u32x4 xr[8];
#pragma unroll
          for (int j = 0; j < 8; ++j) xr[j] = *(const u32x4*)(P + (size_t)(rb + 8 * tb + j) * LDP + 2048 + hh * 512 + 8 * vg);
#pragma unroll
          for (int q = 0; q < 8; ++q) { const int v = 8 * vg + q; unsigned ow[4];
#pragma unroll
              for (int w = 0; w < 4; ++w) { const unsigned a = xr[2 * w][q >> 1], bq = xr[2 * w + 1][q >> 1]; ow[w] = (q & 1) ? ((a >> 16) | (bq & 0xffff0000u)) : ((a & 0xffffu) | (bq << 16)); }
              *(LAS u32x4*)(lds + r128_off(v, tb)) = (u32x4){ow[0], ow[1], ow[2], ow[3]}; } }
        __syncthreads();
        unsigned char* dst = img + VT_OFF + (size_t)(bh * NCH + c) * VT_BYTES;
#pragma unroll
        for (int i = 0; i < 8; ++i) { const int e = tid + i * 512; *(u32x4*)(dst + (size_t)e * 16) = *(const LAS u32x4*)(lds + e * 16); }
        __syncthreads();
    }
    for (int e = tid; e < 64 * 32; e += 512) { const int t = e >> 5, i = e & 31; ZT[e] = bf2f_(P[(size_t)(rb + t) * LDP + 6144 + i]); }
    __syncthreads();
    const int k = tid & 255, th = tid >> 8;
#pragma unroll
    for (int i = 0; i < 4; ++i) { const int e = tid + i * 512, t = e >> 5, c16 = e & 31; const size_t ro = (size_t)(rb + t) * LDP + hh * 256 + c16 * 8;
        *(LAS u32x4*)(QEI + t * 512 + c16 * 16) = *(const u32x4*)(P + ro); *(LAS u32x4*)(KEI + t * 512 + c16 * 16) = *(const u32x4*)(P + ro + 1024); }
    __syncthreads();
    float qreg[32], kreg[32];
#pragma unroll
    for (int i = 0; i < 32; ++i) { qreg[i] = bf2f_(*(const LAS unsigned short*)(QEI + (32 * th + i) * 512 + k * 2)) * 0.0625f; kreg[i] = bf2f_(*(const LAS unsigned short*)(KEI + (32 * th + i) * 512 + k * 2)); }
    { constexpr int d = DD;
        f32x2 w2p[8];
#pragma unroll
        for (int i = 0; i < 8; ++i) w2p[i] = (f32x2){gw2[(size_t)(d * 16 + 2 * i) * 1024 + hh * 256 + k], gw2[(size_t)(d * 16 + 2 * i + 1) * 1024 + hh * 256 + k]};
        const float bias = gb[d * 1024 + hh * 256 + k];
        float bc[32]; float run = 0.f;
#pragma unroll
        for (int i = 0; i < 32; ++i) { const int t = d == 0 ? 32 * th + i : 32 * th + 31 - i;
            f32x2 acc = {bias, 0.f};
#pragma unroll
            for (int q4 = 0; q4 < 4; ++q4) { const f32x4 z4 = *(const LAS f32x4*)(ZT + t * 32 + d * 16 + 4 * q4);
                acc = __builtin_elementwise_fma((f32x2){z4[0], z4[1]}, w2p[2 * q4], acc); acc = __builtin_elementwise_fma((f32x2){z4[2], z4[3]}, w2p[2 * q4 + 1], acc); }
            const float x = acc.x + acc.y;
            const float l2 = __builtin_amdgcn_logf(1.0f + __builtin_amdgcn_exp2f(fabsf(x) * -1.4426950408889634f));
            run += __builtin_fmaf(fminf(x, 0.f), 0.0625f * 1.4426950408889634f, l2 * -0.0625f); bc[i] = run; }
        SEG[th * 256 + k] = run;
        __syncthreads();
        const float s0 = SEG[k], s1 = SEG[256 + k]; const float bend = s0 + s1;
        const float pre = d == 0 ? (th == 1 ? s0 : 0.f) : (th == 0 ? s1 : 0.f);
        const float ebend = __builtin_amdgcn_exp2f(bend);
        unsigned kdp[16];
#pragma unroll
        for (int i = 0; i < 16; ++i) kdp[i] = 0u;
#pragma unroll
        for (int i = 0; i < 32; ++i) { const int t = d == 0 ? 32 * th + i : 32 * th + 31 - i; const float bcum = bc[i] + pre;
            const float qv = qreg[d == 0 ? i : 31 - i], kv = kreg[d == 0 ? i : 31 - i];
            const float qe = qv * __builtin_amdgcn_exp2f(bcum), ke = kv * __builtin_amdgcn_exp2f(-bcum), kd = ke * ebend;
            *(LAS unsigned short*)(QEI + qe_off(t, k)) = (unsigned short)f2bf(qe);
            *(LAS unsigned short*)(KEI + qe_off(t, k)) = (unsigned short)f2bf(ke);
            const int tl = t & 31;
            const unsigned hv = f2bf(kd);
            if (tl & 1) kdp[tl >> 1] = (kdp[tl >> 1] & 0xffffu) | (hv << 16); else kdp[tl >> 1] = (kdp[tl >> 1] & 0xffff0000u) | hv; }
#pragma unroll
        for (int cc = 0; cc < 4; ++cc) *(LAS u32x4*)(KDI + r128_off(k, 4 * th + cc)) = (u32x4){kdp[4 * cc], kdp[4 * cc + 1], kdp[4 * cc + 2], kdp[4 * cc + 3]};
        if (th == 0) *(LAS float*)(KDI + 32768 + 4 * k) = ebend;
        __syncthreads();
        { const int tt = wid >> 1; f32x4 acc[2] = {};
#pragma unroll
          for (int ks = 0; ks < 8; ++ks) { const int trow = 16 * tt + r16; const bf16x8 af = *(const LAS bf16x8*)(QEI + trow * 512 + (((4 * ks + g) ^ (trow & 15)) << 4));
#pragma unroll
            for (int mi = 0; mi < 2; ++mi) { const int mrow = 16 * (2 * (wid & 1) + mi) + r16; const bf16x8 bfr = *(const LAS bf16x8*)(KEI + mrow * 512 + (((4 * ks + g) ^ (mrow & 15)) << 4));
                acc[mi] = __builtin_amdgcn_mfma_f32_16x16x32_bf16(af, bfr, acc[mi], 0, 0, 0); } }
#pragma unroll
          for (int mi = 0; mi < 2; ++mi) { const int m = 16 * (2 * (wid & 1) + mi) + r16;
#pragma unroll
            for (int rg = 0; rg < 4; ++rg) { const int t = 16 * tt + 4 * g + rg; const bool keep = d == 0 ? (m <= t) : (m >= t);
                *(LAS unsigned short*)(ATI + r128_off(t, m >> 3) + (m & 7) * 2) = (unsigned short)f2bf(keep ? acc[mi][rg] : 0.f); } } }
        __syncthreads();
        { const size_t ii = (size_t)((d * 16 + bh) * NCH + c);
          unsigned char* dq = img + QEI_OFF + ii * QE_BYTES; unsigned char* dk = img + KDI_OFF + ii * KDT_BYTES; unsigned char* da = img + ATT_OFF + ii * ATT_BYTES;
#pragma unroll
          for (int i = 0; i < 4; ++i) { const int e = tid + i * 512; *(u32x4*)(dq + (size_t)e * 16) = *(const LAS u32x4*)(QEI + e * 16); }
          for (int e = tid; e < KDT_BYTES / 16; e += 512) *(u32x4*)(dk + (size_t)e * 16) = *(const LAS u32x4*)(KDI + e * 16);
          *(u32x4*)(da + (size_t)tid * 16) = *(const LAS u32x4*)(ATI + tid * 16); }
        __syncthreads();
    }
}

__device__ __forceinline__ void gl_dma(const void* gbase, unsigned voffB, unsigned lds_dst) { unsigned keep;
  asm volatile("s_mov_b32 %0, m0\n\ts_mov_b32 m0, %3\n\ts_nop 0\n\tglobal_load_lds_dwordx4 %1, %2\n\ts_mov_b32 m0, %0" : "=&s"(keep) : "v"(voffB), "s"(gbase), "s"(lds_dst) : "memory"); }
__device__ __forceinline__ void oq_store(unsigned short* __restrict__ OQ, size_t elt0, unsigned so0, const f32x4 (&oa)[4], const f32x4 (&ob)[4]) {
    unsigned char* base = (unsigned char*)(OQ + elt0);
#pragma unroll
    for (int tt = 0; tt < 4; ++tt) { const f32x4 o = oa[tt] + ob[tt]; const unsigned p01 = cvtpk(o[0], o[1]), p23 = cvtpk(o[2], o[3]);
        unsigned f0 = so0 + (tt * 16 + 0) * 4096, f1 = so0 + (tt * 16 + 1) * 4096, f2 = so0 + (tt * 16 + 2) * 4096, f3 = so0 + (tt * 16 + 3) * 4096;
        asm volatile("" : "+v"(f0), "+v"(f1), "+v"(f2), "+v"(f3));
        *(unsigned short*)(base + f0) = (unsigned short)p01; *(unsigned short*)(base + f1) = (unsigned short)(p01 >> 16);
        *(unsigned short*)(base + f2) = (unsigned short)p23; *(unsigned short*)(base + f3) = (unsigned short)(p23 >> 16); }
}
constexpr int STAGE_BYTES = QE_BYTES + KDT_BYTES, SEQ_LDS = 2 * STAGE_BYTES + 16384;
__device__ __forceinline__ void seq_unit(const unsigned char* __restrict__ img, unsigned short* __restrict__ OQ  , int b, int hh, int d, int vs, LAS unsigned char* lds) {
    int tid_ = threadIdx.x; asm volatile("" : "+v"(tid_)); const int tid = tid_, lane = tid & 63, wid = __builtin_amdgcn_readfirstlane(tid >> 6), g = lane >> 4, r16 = lane & 15, kh = wid >> 2, vq = wid & 3;
    const int bh = b * 4 + hh;
    LAS float* XCH = (LAS float*)(lds + 2 * STAGE_BYTES);
    f32x4 S[8] = {}; f32x4 oprev[4] = {}; int rb_prev = 0;
    bf16x8 vfr[2], afr[4];
    const int vrow = vs * 64 + vq * 16 + r16;
    const unsigned vo0 = (unsigned)(wid * 1024 + lane * 16);
    const unsigned so0 = (unsigned)((4 * g * 2048 + vq * 16 + r16) * 2);
#define GLA_CSEQ(i) (d == 0 ? (i) : ((i) < 4 ? 3 - (i) : 71 - (i)))
#define GLA_ISSUE(ci, bufsel) do { const int c_ = (ci); const size_t ii_ = (size_t)((d * 16 + bh) * NCH + c_); \
        const unsigned char* sq_ = img + QEI_OFF + ii_ * QE_BYTES; const unsigned char* sk_ = img + KDI_OFF + ii_ * KDT_BYTES; LAS unsigned char* db_ = lds + (bufsel) * STAGE_BYTES; \
        const unsigned dl_ = (unsigned)(uintptr_t)db_ + wid * 1024; \
        _Pragma("unroll") for (int r_ = 0; r_ < 4; ++r_) { gl_dma(sq_ + r_ * 8192, vo0, (unsigned)__builtin_amdgcn_readfirstlane(dl_ + r_ * 8192)); gl_dma(sk_ + r_ * 8192, vo0, (unsigned)__builtin_amdgcn_readfirstlane(dl_ + 32768 + r_ * 8192)); } \
        if (wid == 0) gl_dma(sk_ + 32768, vo0, (unsigned)__builtin_amdgcn_readfirstlane(dl_ + 65536)); \
        const unsigned char* sv_ = img + VT_OFF + (size_t)(bh * NCH + c_) * VT_BYTES; \
        vfr[0] = *(const bf16x8*)(sv_ + r128_off(vrow, g)); vfr[1] = *(const bf16x8*)(sv_ + r128_off(vrow, 4 + g)); \
        const unsigned char* sa_ = img + ATT_OFF + ii_ * ATT_BYTES; \
        _Pragma("unroll") for (int tt = 0; tt < 4; ++tt) afr[tt] = *(const bf16x8*)(sa_ + r128_off(16 * tt + r16, 4 * kh + g)); } while (0)
    __syncthreads();
    GLA_ISSUE(GLA_CSEQ(0), 0);
    for (int i = 0; i < NCH; ++i) {
        const int c = GLA_CSEQ(i); const int rb = chunk_row(b, c);
        LAS unsigned char* QEI = lds + (i & 1) * STAGE_BYTES; LAS unsigned char* KDI = QEI + QE_BYTES; LAS float* EB = (LAS float*)(KDI + 32768);
        if (kh == 0 && i >= 2) asm volatile("s_waitcnt vmcnt(16) lgkmcnt(0)\n\ts_barrier" ::: "memory");
        else asm volatile("s_waitcnt vmcnt(0) lgkmcnt(0)\n\ts_barrier" ::: "memory");
        const bf16x8 vf0 = vfr[0], vf1 = vfr[1]; bf16x8 af[4];
#pragma unroll
        for (int tt = 0; tt < 4; ++tt) af[tt] = afr[tt];
        if (i + 1 < NCH) GLA_ISSUE(GLA_CSEQ(i + 1), (i + 1) & 1);
        f32x4 xin[4];
        if (i > 0 && kh == 0) {
#pragma unroll
            for (int tt = 0; tt < 4; ++tt) xin[tt] = *(const LAS f32x4*)(XCH + ((vq * 4 + tt) * 64 + lane) * 4); }
        asm volatile("s_waitcnt lgkmcnt(0)\n\ts_barrier" ::: "memory");
        bf16x8 qa[4][4];
#define GLA_QRD(tt) do { const int trow_ = 16 * (tt) + r16; _Pragma("unroll") for (int ks = 0; ks < 4; ++ks) qa[tt][ks] = *(const LAS bf16x8*)(QEI + trow_ * 512 + (((16 * kh + 4 * ks + g) ^ (trow_ & 15)) << 4)); } while (0)
#define GLA_QMF(tt) do { _Pragma("unroll") for (int ks = 0; ks < 4; ++ks) o[tt] = __builtin_amdgcn_mfma_f32_16x16x32_bf16(qa[tt][ks], sb[ks], o[tt], 0, 0, 0); \
            o[tt] = __builtin_amdgcn_mfma_f32_16x16x32_bf16(af[tt], kh == 0 ? vf0 : vf1, o[tt], 0, 0, 0); } while (0)
        GLA_QRD(0);
        if (i > 0 && kh == 0) oq_store(OQ, ((size_t)d * 17408 + rb_prev) * 2048 + hh * 512 + vs * 64, so0, oprev, xin);
        bf16x8 sb[4];
#pragma unroll
        for (int ks = 0; ks < 4; ++ks) { u32x4 w; w.x = cvtpk(S[2 * ks][0], S[2 * ks][1]); w.y = cvtpk(S[2 * ks][2], S[2 * ks][3]); w.z = cvtpk(S[2 * ks + 1][0], S[2 * ks + 1][1]); w.w = cvtpk(S[2 * ks + 1][2], S[2 * ks + 1][3]);
            sb[ks] = __builtin_bit_cast(bf16x8, w); }
        f32x4 o[4] = {};
        __builtin_amdgcn_sched_barrier(0);
        GLA_QRD(1);
        __builtin_amdgcn_sched_barrier(0);
        GLA_QMF(0); GLA_QRD(2);
        __builtin_amdgcn_sched_barrier(0);
        GLA_QMF(1); GLA_QRD(3);
        __builtin_amdgcn_sched_barrier(0);
        GLA_QMF(2);
        __builtin_amdgcn_sched_barrier(0);
        GLA_QMF(3);
        __builtin_amdgcn_sched_barrier(0);
#undef GLA_QRD
#undef GLA_QMF
        if (kh == 1) {
#pragma unroll
            for (int tt = 0; tt < 4; ++tt) *(LAS f32x4*)(XCH + ((vq * 4 + tt) * 64 + lane) * 4) = o[tt];
        } else {
#pragma unroll
            for (int tt = 0; tt < 4; ++tt) oprev[tt] = o[tt];
        }
        rb_prev = rb;
        f32x4 e4[8]; bf16x8 ka0[8], ka1[8];
#define GLA_SRD(kt) do { const int krow0_ = 128 * kh + 16 * (kt), kr_ = krow0_ + r16; e4[kt] = *(const LAS f32x4*)(EB + krow0_ + 4 * g); \
            ka0[kt] = *(const LAS bf16x8*)(KDI + r128_off(kr_, g)); ka1[kt] = *(const LAS bf16x8*)(KDI + r128_off(kr_, 4 + g)); } while (0)
#define GLA_SUP(k0) do { S[k0] = S[k0] * e4[k0]; S[(k0) + 1] = S[(k0) + 1] * e4[(k0) + 1]; \
            S[k0] = __builtin_amdgcn_mfma_f32_16x16x32_bf16(ka0[k0], vf0, S[k0], 0, 0, 0); S[(k0) + 1] = __builtin_amdgcn_mfma_f32_16x16x32_bf16(ka0[(k0) + 1], vf0, S[(k0) + 1], 0, 0, 0); \
            S[k0] = __builtin_amdgcn_mfma_f32_16x16x32_bf16(ka1[k0], vf1, S[k0], 0, 0, 0); S[(k0) + 1] = __builtin_amdgcn_mfma_f32_16x16x32_bf16(ka1[(k0) + 1], vf1, S[(k0) + 1], 0, 0, 0); } while (0)
        GLA_SRD(0); GLA_SRD(1); GLA_SRD(2); GLA_SRD(3);
        __builtin_amdgcn_sched_barrier(0);
        GLA_SUP(0); GLA_SRD(4); GLA_SRD(5);
        __builtin_amdgcn_sched_barrier(0);
        GLA_SUP(2); GLA_SRD(6); GLA_SRD(7);
        __builtin_amdgcn_sched_barrier(0);
        GLA_SUP(4);
        __builtin_amdgcn_sched_barrier(0);
        GLA_SUP(6);
#undef GLA_SRD
#undef GLA_SUP
    }
    __syncthreads();
    if (kh == 0) { f32x4 xl[4];
#pragma unroll
        for (int tt = 0; tt < 4; ++tt) xl[tt] = *(const LAS f32x4*)(XCH + ((vq * 4 + tt) * 64 + lane) * 4);
        oq_store(OQ, ((size_t)d * 17408 + rb_prev) * 2048 + hh * 512 + vs * 64, so0, oprev, xl); }
    __syncthreads();
#undef GLA_ISSUE
#undef GLA_CSEQ
}
}
namespace lru {
using bf16x8 = __attribute__((ext_vector_type(8))) short;
using f32x4 = __attribute__((ext_vector_type(4))) float;
using u32x4 = __attribute__((ext_vector_type(4))) unsigned;
constexpr int LDP = 5120, NCH = 68, MROWS = 17408;
constexpr size_t HL_OFF = 0, AC_OFF = (size_t)2 * MROWS * 1024 * 2, AGGA_OFF = (size_t)4 * MROWS * 1024 * 2, AGGH_OFF = AGGA_OFF + (size_t)2 * 4 * NCH * 1024 * 4, LRU_END = AGGH_OFF + (size_t)2 * 4 * NCH * 1024 * 4;
__device__ __forceinline__ int chunk_row(int b, int c) { return c < 4 ? b * 256 + 64 * c : 1024 + b * 4096 + 64 * (c - 4); }
__device__ __forceinline__ float bf2f_(unsigned short v) { return __builtin_bit_cast(float, (unsigned)v << 16); }
__device__ __forceinline__ float sigm(float x) { return __builtin_amdgcn_rcpf(1.f + __builtin_amdgcn_exp2f(x * -1.4426950408889634f)); }
#define LRU_CSEQ(d, i) ((d) == 0 ? (i) : ((i) < 4 ? 3 - (i) : 71 - (i)))
#define LRU_POS(d, c) ((d) == 0 ? (c) : ((c) < 4 ? 3 - (c) : 71 - (c)))

struct Wreg { bf16x8 w[2][2][4]; float ba[2], bx[2], sp[2]; };

__device__ __forceinline__ void load_w(Wreg& W, const unsigned short* __restrict__ WT  , const float* __restrict__ ba, const float* __restrict__ bx, const float* __restrict__ lam  ,
                                       int n, int wid, int lane) {
    const int d = wid >> 2, g = lane >> 4, r16 = lane & 15;
#pragma unroll
    for (int mat = 0; mat < 2; ++mat)
#pragma unroll
        for (int ct = 0; ct < 2; ++ct) { const int j = 16 * (2 * (wid & 3) + ct) + r16;
#pragma unroll
            for (int ks = 0; ks < 4; ++ks) W.w[mat][ct][ks] = *(const bf16x8*)(WT + ((size_t)(((d * 2 + mat) * 8 + n) * 128 + j)) * 128 + 32 * ks + 8 * g); }
#pragma unroll
    for (int ct = 0; ct < 2; ++ct) { const int ch = n * 128 + 16 * (2 * (wid & 3) + ct) + r16;
        W.ba[ct] = ba[d * 1024 + ch]; W.bx[ct] = bx[d * 1024 + ch]; W.sp[ct] = -8.0f * 1.4426950408889634f * log1pf(expf(-lam[d * 1024 + ch])); }
}

template <int d> __device__ __forceinline__ void lru_scan(const Wreg& W, const LAS unsigned char* XB, const LAS float* XF, LAS unsigned short* OUTB, int wid, int g, int r16, float (&cA)[2], float (&cH)[2]) {
#pragma unroll
    for (int ti = 0; ti < 4; ++ti) { const int tt = d == 0 ? ti : 3 - ti;
        f32x4 acc[2][2] = {};
#pragma unroll
        for (int ks = 0; ks < 4; ++ks) { const int trow = 16 * tt + r16; const bf16x8 af = *(const LAS bf16x8*)(XB + trow * 256 + (((4 * ks + g) ^ (trow & 15)) << 4));
#pragma unroll
            for (int mat = 0; mat < 2; ++mat)
#pragma unroll
                for (int ct = 0; ct < 2; ++ct) acc[mat][ct] = __builtin_amdgcn_mfma_f32_16x16x32_bf16(af, W.w[mat][ct][ks], acc[mat][ct], 0, 0, 0); }
#pragma unroll
        for (int ct = 0; ct < 2; ++ct) { const int chl = 16 * (2 * (wid & 3) + ct) + r16;
            float av[4], bv[4];
#pragma unroll
            for (int rg = 0; rg < 4; ++rg) { const int t = 16 * tt + 4 * g + rg; const float xc = XF[t * 128 + chl];
                const float r = sigm(acc[0][ct][rg] + W.ba[ct]), gi = sigm(acc[1][ct][rg] + W.bx[ct]);
                const float a = __builtin_amdgcn_exp2f(r * W.sp[ct]); av[rg] = a; bv[rg] = __builtin_amdgcn_sqrtf(__builtin_fmaf(-a, a, 1.0f)) * gi * xc; }
            float hl[4], al[4]; float h = 0.f, Ap = 1.f;
#pragma unroll
            for (int q = 0; q < 4; ++q) { const int rg = d == 0 ? q : 3 - q; h = av[rg] * h + bv[rg]; Ap *= av[rg]; hl[rg] = h; al[rg] = Ap; }
            float gA[4], gH[4];
            {
              unsigned pa[2] = {__builtin_bit_cast(unsigned, Ap), __builtin_bit_cast(unsigned, Ap)}, ph[2] = {__builtin_bit_cast(unsigned, h), __builtin_bit_cast(unsigned, h)}; ::xl_swap16(pa[0], pa[1]); ::xl_swap16(ph[0], ph[1]);
              unsigned a02[2] = {pa[0], pa[0]}, a13[2] = {pa[1], pa[1]}, h02[2] = {ph[0], ph[0]}, h13[2] = {ph[1], ph[1]};
              ::xl_swap32(a02[0], a02[1]); ::xl_swap32(a13[0], a13[1]); ::xl_swap32(h02[0], h02[1]); ::xl_swap32(h13[0], h13[1]);
              gA[0] = __builtin_bit_cast(float, a02[0]); gA[1] = __builtin_bit_cast(float, a13[0]); gA[2] = __builtin_bit_cast(float, a02[1]); gA[3] = __builtin_bit_cast(float, a13[1]);
              gH[0] = __builtin_bit_cast(float, h02[0]); gH[1] = __builtin_bit_cast(float, h13[0]); gH[2] = __builtin_bit_cast(float, h02[1]); gH[3] = __builtin_bit_cast(float, h13[1]); }
            float Ain = cA[ct], hin = cH[ct]; float Aall = cA[ct], hall = cH[ct];
#pragma unroll
            for (int q = 0; q < 4; ++q) { const int s = d == 0 ? q : 3 - q; const bool before = d == 0 ? (s < g) : (s > g);
                if (before) { hin = gA[s] * hin + gH[s]; Ain *= gA[s]; }
                hall = gA[s] * hall + gH[s]; Aall *= gA[s]; }
            cA[ct] = Aall; cH[ct] = hall;
#pragma unroll
            for (int rg = 0; rg < 4; ++rg) { const int ox = (d * 64 + 16 * tt + 4 * g + rg) * 128 + (chl ^ (g << 4));
                OUTB[ox] = (unsigned short)f2bf(hl[rg] + al[rg] * hin); OUTB[2 * 64 * 128 + ox] = (unsigned short)f2bf(al[rg] * Ain); }
        }
    }
}
__device__ __forceinline__ void lru1_item(const unsigned short* __restrict__ P, unsigned char* __restrict__ buf, const float* __restrict__ cw, const float* __restrict__ cb, const Wreg& W, int c, int b, int n, LAS unsigned char* lds) {
    int tid_ = threadIdx.x; asm volatile("" : "+v"(tid_)); const int tid = tid_, lane = tid & 63, wid = __builtin_amdgcn_readfirstlane(tid >> 6), g = lane >> 4, r16 = lane & 15, d = wid >> 2;
    const int rb = chunk_row(b, c); const int lo = c < 4 ? b * 256 : 1024 + b * 4096, hi = c < 4 ? lo + 256 : lo + 4096;
    LAS unsigned char* XB = lds;
    LAS float* XF = (LAS float*)(lds + 16384);
    LAS unsigned short* OUTB = (LAS unsigned short*)(lds + 49152);
    __syncthreads();
#pragma unroll
    for (int q = 0; q < 2; ++q) { const int e = tid + q * 512, t = e >> 4, c8 = (e & 15) * 8; const int ch0 = n * 128 + c8;
        float acc[8];
#pragma unroll
        for (int i = 0; i < 8; ++i) acc[i] = cb[ch0 + i];
#pragma unroll
        for (int jj = 0; jj < 4; ++jj) { const int rr = rb + t + jj - 2;
            if (rr >= lo && rr < hi) { const u32x4 w = *(const u32x4*)(P + (size_t)rr * LDP + 4096 + ch0); const unsigned ww[4] = {w.x, w.y, w.z, w.w};
#pragma unroll
                for (int i = 0; i < 8; ++i) { const float xv = (i & 1) ? __builtin_bit_cast(float, ww[i >> 1] & 0xffff0000u) : __builtin_bit_cast(float, ww[i >> 1] << 16); acc[i] += xv * cw[jj * 1024 + ch0 + i]; } } }
        u32x4 pk; pk.x = pk2(acc[0], acc[1]); pk.y = pk2(acc[2], acc[3]); pk.z = pk2(acc[4], acc[5]); pk.w = pk2(acc[6], acc[7]);
        *(LAS u32x4*)(XB + t * 256 + ((((c8 >> 3)) ^ (t & 15)) << 4)) = pk;
        *(LAS f32x4*)(XF + t * 128 + c8) = (f32x4){acc[0], acc[1], acc[2], acc[3]}; *(LAS f32x4*)(XF + t * 128 + c8 + 4) = (f32x4){acc[4], acc[5], acc[6], acc[7]}; }
    __syncthreads();
    float cA[2] = {1.f, 1.f}, cH[2] = {0.f, 0.f};
    if (d == 0) lru_scan<0>(W, XB, XF, OUTB, wid, g, r16, cA, cH); else lru_scan<1>(W, XB, XF, OUTB, wid, g, r16, cA, cH);
    __syncthreads();
#pragma unroll
    for (int q = 0; q < 4; ++q) { const int e = tid + q * 512; const int dd = (e >> 10) & 1, t = (e >> 4) & 63, c8 = (e & 15) * 8;
        const u32x4 w = *(const LAS u32x4*)(OUTB + ((2 + dd) * 64 + t) * 128 + (c8 ^ (((t >> 2) & 3) << 4)));
        *(u32x4*)((unsigned short*)(buf + AC_OFF) + (size_t)dd * MROWS * 1024 + (size_t)(rb + t) * 1024 + n * 128 + c8) = w; }
#pragma unroll
    for (int q = 0; q < 2; ++q) { const int e = tid + q * 512; const int t = (e >> 4) & 63, c8 = (e & 15) * 8;
        const int cs = c8 ^ (((t >> 2) & 3) << 4);
        const u32x4 w0 = *(const LAS u32x4*)(OUTB + (0 * 64 + t) * 128 + cs), w1 = *(const LAS u32x4*)(OUTB + (1 * 64 + t) * 128 + cs);
        const unsigned a[4] = {w0.x, w0.y, w0.z, w0.w}, bq[4] = {w1.x, w1.y, w1.z, w1.w}; unsigned o[4];
#pragma unroll
        for (int i = 0; i < 4; ++i) o[i] = pk2(__builtin_bit_cast(float, a[i] << 16) + __builtin_bit_cast(float, bq[i] << 16), __builtin_bit_cast(float, a[i] & 0xffff0000u) + __builtin_bit_cast(float, bq[i] & 0xffff0000u));
        *(u32x4*)((unsigned short*)(buf + HL_OFF) + (size_t)(rb + t) * 1024 + n * 128 + c8) = (u32x4){o[0], o[1], o[2], o[3]}; }
    if (g == 0) {
#pragma unroll
        for (int ct = 0; ct < 2; ++ct) { const int ch = n * 128 + 16 * (2 * (wid & 3) + ct) + r16; const size_t ix = ((size_t)(d * 4 + b) * NCH + c) * 1024 + ch;
            ((float*)(buf + AGGA_OFF))[ix] = cA[ct]; ((float*)(buf + AGGH_OFF))[ix] = cH[ct]; }
    }
}

__device__ __forceinline__ float gelu_t(float x) { const float u = 0.7978845608028654f * (x + 0.044715f * x * x * x); const float e = __expf(2.f * u); const float th = 1.f - 2.f * __builtin_amdgcn_rcpf(e + 1.f); return 0.5f * x * (1.f + th); }

__device__ __forceinline__ void merge_range(const unsigned short* __restrict__ P, const unsigned char* __restrict__ buf, unsigned short* __restrict__ Y, int c0, int len, int b, int cq, LAS unsigned char* lds) {
    int tid_ = threadIdx.x; asm volatile("" : "+v"(tid_)); const int tid = tid_;
    LAS float* CAR = (LAS float*)lds;
    __syncthreads();
    { const int d = tid >> 8, chl = tid & 255, ch = cq * 256 + chl;
      const float* GA = (const float*)(buf + AGGA_OFF) + (size_t)(d * 4 + b) * NCH * 1024 + ch; const float* GH = (const float*)(buf + AGGH_OFF) + (size_t)(d * 4 + b) * NCH * 1024 + ch;
      float h = 0.f;
      if (d == 0) {
#pragma unroll 16
          for (int i = 0; i < c0; ++i) h = GA[(size_t)i * 1024] * h + GH[(size_t)i * 1024];
          for (int k = 0; k < len; ++k) { CAR[(0 * 5 + k) * 256 + chl] = h; h = GA[(size_t)(c0 + k) * 1024] * h + GH[(size_t)(c0 + k) * 1024]; }
      } else {
          const int pos = LRU_POS(1, c0 + len - 1);
#pragma unroll 16
          for (int i = 0; i < pos; ++i) { const int cc = LRU_CSEQ(1, i); h = GA[(size_t)cc * 1024] * h + GH[(size_t)cc * 1024]; }
          for (int k = len - 1; k >= 0; --k) { CAR[(1 * 5 + k) * 256 + chl] = h; h = GA[(size_t)(c0 + k) * 1024] * h + GH[(size_t)(c0 + k) * 1024]; }
      } }
    __syncthreads();
    const unsigned short* HL0 = (const unsigned short*)(buf + HL_OFF);
    const unsigned short* AC0 = (const unsigned short*)(buf + AC_OFF); const unsigned short* AC1 = AC0 + (size_t)MROWS * 1024;
    for (int k = 0; k < len; ++k) { const int rb = chunk_row(b, c0 + k); const LAS float* C0 = CAR + (0 * 5 + k) * 256; const LAS float* C1 = CAR + (1 * 5 + k) * 256;
#pragma unroll
      for (int q = 0; q < 4; ++q) { const int e = tid + q * 512, t = e >> 5, c8 = (e & 31) * 8; const size_t ix = (size_t)(rb + t) * 1024 + cq * 256 + c8;
        const u32x4 h0 = *(const u32x4*)(HL0 + ix), a0 = *(const u32x4*)(AC0 + ix), a1 = *(const u32x4*)(AC1 + ix);
        const u32x4 gt = *(const u32x4*)(P + (size_t)(rb + t) * LDP + 3072 + cq * 256 + c8);
        const unsigned h0w[4] = {h0.x, h0.y, h0.z, h0.w}, a0w[4] = {a0.x, a0.y, a0.z, a0.w}, a1w[4] = {a1.x, a1.y, a1.z, a1.w}, gw[4] = {gt.x, gt.y, gt.z, gt.w};
        float y[8];
#pragma unroll
        for (int i = 0; i < 8; ++i) {
#define LRU_EL(W) ((i & 1) ? __builtin_bit_cast(float, W[i >> 1] & 0xffff0000u) : __builtin_bit_cast(float, W[i >> 1] << 16))
            const float hs = LRU_EL(h0w) + LRU_EL(a0w) * C0[c8 + i] + LRU_EL(a1w) * C1[c8 + i];
            y[i] = gelu_t(LRU_EL(gw)) * hs;
#undef LRU_EL
        }
        u32x4 o; o.x = pk2(y[0], y[1]); o.y = pk2(y[2], y[3]); o.z = pk2(y[4], y[5]); o.w = pk2(y[6], y[7]);
        *(u32x4*)(Y + (size_t)(rb + t) * 2048 + 1024 + cq * 256 + c8) = o; } }
}
}
constexpr int DM = 2048, NB = 4, SEQ = 4096, CTXL = 256, NCTX = NB * CTXL, MLAT = NB * SEQ, MTOT = NCTX + MLAT, DFF = 8192, DEPTH = 4;
constexpr int EV_IN = 5120, OD_IN = 6176, OD_INP = 6400, NMODC = 6 * DM;
constexpr float EPS = 1e-6f;
constexpr int NWAVES = 8, NTHR = 512;

constexpr size_t MiB = 1u << 20;
constexpr size_t WS_CTL = 0, CTL_ZERO_BYTES = 64 * 1024;
constexpr size_t WS_MODS = 1 * MiB, WS_ROPE = 2 * MiB;
constexpr size_t WS_WEVIN = 3 * MiB, WS_WEVOUT = 43 * MiB, WS_WODIN = 59 * MiB, WS_WODOUT = 109 * MiB, WS_W1 = 125 * MiB, WS_W2 = 253 * MiB;
constexpr size_t WS_H = 381 * MiB, WS_U = 517 * MiB, WS_Y = 585 * MiB, WS_P = 653 * MiB, WS_SCR = 925 * MiB, WS_OQ = 1197 * MiB, WS_WT = 1333 * MiB, WS_BIN = 1335 * MiB, WS_BUP = 1336 * MiB, WS_RSA = 1337 * MiB, WS_RSB = 1340 * MiB, WS_SLAB = 1343 * MiB, WS_END = 1407 * MiB;
constexpr int CW_BAR = 4096;

constexpr int RING_BYTES = 131072, LDSCTL_OFF = 153600, MISC_OFF = LDSCTL_OFF + 320, RED_OFF = LDSCTL_OFF + 1024, LDS_BYTES = RED_OFF + 4096;

struct Args { const float* in[30]; float* out; unsigned char* ws; int ph_lo, ph_hi; };
enum { I_X = 0, I_C, I_CTX, I_CCTX, I_ADAW, I_ADAB, I_N1G, I_N2G, I_W1, I_W2, I_EVWIN, I_EVWOUT, I_LQ1, I_LK1, I_LQ2, I_LK2, I_SUBG, I_CONVW, I_CONVB,
       I_WA, I_BA, I_WX, I_BX, I_LAM, I_ODWIN, I_ODWOUT, I_GW2, I_GB, I_ODNG, I_FING };

__device__ __forceinline__ float bf2f(bf16 v) { return __builtin_bit_cast(float, (unsigned)v << 16); }
__device__ __forceinline__ float wave_sum(float v) { return sum_x32(sum_x16(sum_row16(v))); }
__device__ __forceinline__ float wave_max(float v) { return max_x32(max_x16(max_row16(v))); }
__device__ __forceinline__ float sigmoidf_(float x) { return __builtin_amdgcn_rcpf(1.f + __builtin_amdgcn_exp2f(x * -1.4426950408889634f)); }
__device__ __forceinline__ float siluf_(float x) { return x * __builtin_amdgcn_rcpf(1.f + __builtin_amdgcn_exp2f(x * -1.4426950408889634f)); }
__device__ __forceinline__ float gelu_tanh(float x) { const float t = tanhf(0.7978845608028654f * (x + 0.044715f * x * x * x)); return 0.5f * x * (1.f + t); }
__device__ __forceinline__ int mod_row(int r) { return r < NCTX ? 4 : (r - NCTX) / SEQ; }

struct TC { int tid, lane, wave, gtid, NT, gw, NGW; };
typedef const __attribute__((address_space(4))) Args* ArgP;
__device__ __forceinline__ TC mk_tc() { int tid = threadIdx.x, bid = blockIdx.x, G = gridDim.x; asm volatile("" : "+v"(tid), "+s"(bid), "+s"(G)); TC t; t.tid = tid; t.lane = tid & 63; t.wave = __builtin_amdgcn_readfirstlane(tid >> 6);
    t.gtid = bid * NTHR + tid; t.NT = G * NTHR; t.gw = bid * NWAVES + t.wave; t.NGW = G * NWAVES; return t; }
__device__ __forceinline__ ArgP argp() { ArgP p = (ArgP)__builtin_amdgcn_kernarg_segment_ptr(); asm volatile("" : "+s"(p)); return p; }

__device__ __forceinline__ int cvt_items_win(int L) { return (L & 1) ? (DM / 64) * (OD_IN / 32) : (DM / 64) * (EV_IN / 32); }
constexpr int CVT_I_WOUT = (DM / 64) * (DM / 32), CVT_I_W1 = (DM / 64) * (DFF / 32), CVT_I_W2 = (DFF / 64) * (DM / 32);
__device__ __forceinline__ int cvt_items_total(int L) { return cvt_items_win(L) + CVT_I_WOUT + CVT_I_W1 + CVT_I_W2; }
__device__ __forceinline__ void cvt_layer(ArgP A, int L, int it0, int it1, int gw, int ngw, int lane, LAS float* scr) {
    unsigned char* ws = A->ws; const int j = L >> 1, n_in = cvt_items_win(L);
    for (int it = it0 + gw; it < it1; it += ngw) {
        int r = it;
        if (r < n_in) { if (L & 1) p0_transpose_item<false>(A->in[I_ODWIN] + (size_t)j * DM * OD_IN, DM, OD_IN, (bf16*)(ws + WS_WODIN) + (size_t)j * OD_INP * DM, 0, scr, r, lane);
                        else p0_transpose_item<true>(A->in[I_EVWIN] + (size_t)j * DM * EV_IN, DM, EV_IN, (bf16*)(ws + WS_WEVIN) + (size_t)j * EV_IN * DM, 0, scr, r, lane); continue; }
        r -= n_in;
        if (r < CVT_I_WOUT) { p0_transpose_item<false>(A->in[(L & 1) ? I_ODWOUT : I_EVWOUT] + (size_t)j * DM * DM, DM, DM, (bf16*)(ws + ((L & 1) ? WS_WODOUT : WS_WEVOUT)) + (size_t)j * DM * DM, 0, scr, r, lane); continue; }
        r -= CVT_I_WOUT;
        if (r < CVT_I_W1) { p0_transpose_item<false>(A->in[I_W1] + (size_t)L * DM * DFF, DM, DFF, (bf16*)(ws + WS_W1) + (size_t)L * DFF * DM, 0, scr, r, lane); continue; }
        r -= CVT_I_W1;
        p0_transpose_item<false>(A->in[I_W2] + (size_t)L * DFF * DM, DFF, DM, (bf16*)(ws + WS_W2) + (size_t)L * DM * DFF, 0, scr, r, lane);
    }
}
__device__ __forceinline__ void ph_setup(ArgP A, const TC& t, LAS unsigned char* lds) {
    unsigned char* ws = A->ws;
    LAS float* sil = (LAS float*)lds;
    for (int i = t.tid; i < 5 * DM; i += NTHR) { const int r = i / DM, k = i % DM; const float v = r < 4 ? A->in[I_C][r * DM + k] : A->in[I_CCTX][k]; sil[i] = siluf_(v); }
    __syncthreads();
    float* mods = (float*)(ws + WS_MODS);
    { LAS float* part = (LAS float*)(lds + 40960);
      const int cl = t.tid & 63, kq = t.tid >> 6;
      for (int it = blockIdx.x; it < DEPTH * NMODC / 64; it += gridDim.x) { const int l = it / (NMODC / 64), col = (it % (NMODC / 64)) * 64 + cl;
        const float* w = A->in[I_ADAW] + ((size_t)l * DM + kq * 256) * NMODC + col; const LAS float* sk = sil + kq * 256;
        float acc0 = 0.f, acc1 = 0.f, acc2 = 0.f, acc3 = 0.f, acc4 = 0.f;
#pragma unroll 16
        for (int k = 0; k < 256; ++k) { const float wv = w[(size_t)k * NMODC];
            acc0 += sk[k] * wv; acc1 += sk[DM + k] * wv; acc2 += sk[2 * DM + k] * wv; acc3 += sk[3 * DM + k] * wv; acc4 += sk[4 * DM + k] * wv; }
        LAS float* pp = part + (kq * 64 + cl) * 5; pp[0] = acc0; pp[1] = acc1; pp[2] = acc2; pp[3] = acc3; pp[4] = acc4;
        __syncthreads();
        if (t.tid < 320) { const int r = t.tid / 64, c2 = t.tid & 63; float s = 0.f;
#pragma unroll
            for (int q = 0; q < 8; ++q) s += part[(q * 64 + c2) * 5 + r];
            mods[(size_t)(l * 5 + r) * NMODC + (it % (NMODC / 64)) * 64 + c2] = s + A->in[I_ADAB][l * NMODC + (it % (NMODC / 64)) * 64 + c2]; }
        __syncthreads(); } }
    LAS float* scr = (LAS float*)(lds + 40960 + t.wave * 8704);
    cvt_layer(A, 0, 0, cvt_items_total(0), t.gw, t.NGW, t.lane, scr);
    for (int j = 0; j < 2; ++j) {
        GAS v4u* z = (GAS v4u*)((bf16*)(ws + WS_WODIN) + (size_t)j * OD_INP * DM + (size_t)OD_IN * DM);
        for (int i = t.gtid; i < (OD_INP - OD_IN) * DM / 8; i += t.NT) z[i] = (v4u){0u, 0u, 0u, 0u};
    }
    if (t.gtid < 64 * 16) { const int p = t.gtid / 16, f = t.gtid % 16;
        const float inv = powf(10000.0f, -(float)f / 16.0f); const float ang = (float)p * inv;
        const double ad = (double)ang; const double kk = rint(ad * 0.15915494309189535); const float rr = (float)(ad - kk * 6.283185307179586);
        float* rope = (float*)(ws + WS_ROPE); rope[2 * t.gtid] = cosf(rr); rope[2 * t.gtid + 1] = sinf(rr); }
    { bf16* WT = (bf16*)(ws + WS_WT);
      for (int idx = t.gtid; idx < 2 * 2 * 2 * 8 * 128 * 128; idx += t.NT) { const int i = idx & 127, jo = (idx >> 7) & 127, n = (idx >> 14) & 7, mat = (idx >> 17) & 1, d = (idx >> 18) & 1, jj = idx >> 19;
          const float* src = A->in[mat ? I_WX : I_WA] + ((size_t)((jj * 2 + d) * 8 + n) * 128 + i) * 128 + jo; WT[idx] = (bf16)f2bf(*src); } }
    { GAS unsigned long long* H = (GAS unsigned long long*)(ws + WS_H); const GAS f32x4* cx = (const GAS f32x4*)A->in[I_CTX]; const GAS f32x4* xx = (const GAS f32x4*)A->in[I_X];
      for (int i0 = t.gtid; i0 < MTOT * (DM / 4); i0 += 8 * t.NT) { f32x4 v[8];
#pragma unroll
          for (int q = 0; q < 8; ++q) { const int i = i0 + q * t.NT; v[q] = (f32x4){0.f, 0.f, 0.f, 0.f}; if (i < MTOT * (DM / 4)) v[q] = i < NCTX * (DM / 4) ? cx[i] : xx[i - NCTX * (DM / 4)]; }
#pragma unroll
          for (int q = 0; q < 8; ++q) { const int i = i0 + q * t.NT; if (i < MTOT * (DM / 4)) H[i] = (unsigned long long)pk2(v[q].x, v[q].y) | ((unsigned long long)pk2(v[q].z, v[q].w) << 32); } } }
}


__device__ __forceinline__ void bias_rows(const bf16* Wt, int N, const float* shiftv  , float* out  , int nb, const TC& t, LAS float* sh  ) {
    __syncthreads();
    for (int i = t.tid; i < 5 * DM / 4; i += NTHR) { const int r = i / (DM / 4), c4 = i % (DM / 4); *(LAS f32x4*)(sh + r * DM + 4 * c4) = *(const f32x4*)(shiftv + (size_t)r * NMODC + 4 * c4); }
    __syncthreads();
    for (int n = t.gw; n < N; n += t.NGW) {
        float acc[5] = {0.f, 0.f, 0.f, 0.f, 0.f};
#pragma unroll
        for (int i = 0; i < 4; ++i) { const int k0 = (i * 64 + t.lane) * 8; const v4u w = *(const v4u*)(Wt + (size_t)n * DM + k0); const unsigned ww[4] = {w.x, w.y, w.z, w.w};
#pragma unroll
            for (int r = 0; r < 5; ++r) { const f32x4 s0 = *(const LAS f32x4*)(sh + r * DM + k0), s1 = *(const LAS f32x4*)(sh + r * DM + k0 + 4);
                acc[r] += __builtin_bit_cast(float, ww[0] << 16) * s0.x + __builtin_bit_cast(float, ww[0] & 0xffff0000u) * s0.y + __builtin_bit_cast(float, ww[1] << 16) * s0.z + __builtin_bit_cast(float, ww[1] & 0xffff0000u) * s0.w
                        + __builtin_bit_cast(float, ww[2] << 16) * s1.x + __builtin_bit_cast(float, ww[2] & 0xffff0000u) * s1.y + __builtin_bit_cast(float, ww[3] << 16) * s1.z + __builtin_bit_cast(float, ww[3] & 0xffff0000u) * s1.w; } }
#pragma unroll
        for (int r = 0; r < 5; ++r) { const float s = wave_sum(acc[r]); if (t.lane == 0) __hip_atomic_store(out + (size_t)r * nb + n, s, __ATOMIC_RELAXED, __HIP_MEMORY_SCOPE_AGENT); }
    }
}
__device__ __forceinline__ void layer_biases(ArgP A, const TC& t, int l, LAS unsigned char* lds) {
    unsigned char* ws = A->ws; const float* ml = (const float*)(ws + WS_MODS) + (size_t)l * 5 * NMODC; LAS float* sh = (LAS float*)lds; const int j = l >> 1;
    if ((l & 1) == 0) bias_rows((const bf16*)(ws + WS_WEVIN) + (size_t)j * EV_IN * DM, EV_IN, ml, (float*)(ws + WS_BIN) + (size_t)l * 5 * OD_INP, OD_INP, t, sh);
    else bias_rows((const bf16*)(ws + WS_WODIN) + (size_t)j * OD_INP * DM, OD_INP, ml, (float*)(ws + WS_BIN) + (size_t)l * 5 * OD_INP, OD_INP, t, sh);
    bias_rows((const bf16*)(ws + WS_W1) + (size_t)l * DFF * DM, DFF, ml + 3 * DM, (float*)(ws + WS_BUP) + (size_t)l * 5 * DFF, DFF, t, sh);
}
__device__ __forceinline__ void ph_setup_b(ArgP A, const TC& t, LAS unsigned char* lds) {
    unsigned char* ws = A->ws; const float* mods = (const float*)(ws + WS_MODS); LAS float* sh = (LAS float*)lds;
    { const int l = 0; const int j = l >> 1; const float* ml = mods + (size_t)l * 5 * NMODC;
        if ((l & 1) == 0) bias_rows((const bf16*)(ws + WS_WEVIN) + (size_t)j * EV_IN * DM, EV_IN, ml, (float*)(ws + WS_BIN) + (size_t)l * 5 * OD_INP, OD_INP, t, sh);
        else bias_rows((const bf16*)(ws + WS_WODIN) + (size_t)j * OD_INP * DM, OD_INP, ml, (float*)(ws + WS_BIN) + (size_t)l * 5 * OD_INP, OD_INP, t, sh);
        bias_rows((const bf16*)(ws + WS_W1) + (size_t)l * DFF * DM, DFF, ml + 3 * DM, (float*)(ws + WS_BUP) + (size_t)l * 5 * DFF, DFF, t, sh); }
    const float* g = A->in[I_N1G]; const bf16* H = (const bf16*)(ws + WS_H); bf16* U = (bf16*)(ws + WS_U); float* rsa = (float*)(ws + WS_RSA);
    for (int r = t.gw; r < MTOT; r += t.NGW) {
        const float* sc = mods + (size_t)mod_row(r) * NMODC + DM; float ss = 0.f;
        v4u hwa[4]; f32x4 ga[4][2], sa[4][2];
#pragma unroll
        for (int jj = 0; jj < 4; ++jj) { const int c = 8 * (t.lane + 64 * jj); hwa[jj] = *(const v4u*)(H + (size_t)r * DM + c);
            ga[jj][0] = *(const f32x4*)(g + c); ga[jj][1] = *(const f32x4*)(g + c + 4); sa[jj][0] = *(const f32x4*)(sc + c); sa[jj][1] = *(const f32x4*)(sc + c + 4); }
#pragma unroll
        for (int jj = 0; jj < 4; ++jj) { const int c = 8 * (t.lane + 64 * jj); const v4u hw = hwa[jj]; const unsigned ww[4] = {hw.x, hw.y, hw.z, hw.w};
            float y[8];
#pragma unroll
            for (int i = 0; i < 8; ++i) { const float v = (i & 1) ? __builtin_bit_cast(float, ww[i >> 1] & 0xffff0000u) : __builtin_bit_cast(float, ww[i >> 1] << 16); ss += v * v; y[i] = v * (ga[jj][i >> 2][i & 3] * (sa[jj][i >> 2][i & 3] + 1.0f)); }
            v4u o; o.x = pk2(y[0], y[1]); o.y = pk2(y[2], y[3]); o.z = pk2(y[4], y[5]); o.w = pk2(y[6], y[7]); *(v4u*)(U + (size_t)r * DM + c) = o; }
        ss = wave_sum(ss); if (t.lane < 8) __hip_atomic_store(rsa + (size_t)t.lane * MTOT + r, t.lane == 0 ? ss : 0.f, __ATOMIC_RELAXED, __HIP_MEMORY_SCOPE_AGENT);
    }
}
__device__ __forceinline__ void ph_attn_fast(ArgP A, int l, int j, LAS unsigned char* lds) {
    const int lane = threadIdx.x & 63;
    const float lam_init = 0.8f - 0.6f * expf(-0.3f * (float)l);
    const float dq1 = wave_sum(A->in[I_LQ1][j * 64 + lane] * A->in[I_LK1][j * 64 + lane]);
    const float dq2 = wave_sum(A->in[I_LQ2][j * 64 + lane] * A->in[I_LK2][j * 64 + lane]);
    const float lam = expf(dq1) - expf(dq2) + lam_init;
    const bf16* P = (const bf16*)(A->ws + WS_P); bf16* Y = (bf16*)(A->ws + WS_Y); const float* sg = A->in[I_SUBG] + j * 128;
    const int G = gridDim.x, bid = blockIdx.x; const int vcu = (G % 8 == 0) ? (bid & 7) * (G >> 3) + (bid >> 3) : bid;
    constexpr int NBIG = NB * 8 * 32, NSMALL = NB * 8 * 2;
    for (int u0 = vcu; u0 < NBIG + G; u0 += G) {
        int u = u0; if (u0 >= NBIG) { const int v = u0 - NBIG - G / 2; if (v < 0 || v >= NSMALL) continue; u = NBIG + v; }
        int b, hh, qrow0, NT;
        if (u < NBIG) { b = u >> 8; hh = (u >> 5) & 7; qrow0 = NCTX + b * SEQ + (u & 31) * 128; NT = 68; }
        else { const int v = u - NBIG; b = v >> 4; hh = (v >> 1) & 7; qrow0 = b * CTXL + (v & 1) * 128; NT = 4; }
        att::attn_unit(P, Y, b, hh, qrow0, NT, lam, 1.f - lam_init, sg, lds);
    }
}

__device__ __forceinline__ void ph_lru1(ArgP A, int j, LAS unsigned char* lds) {
    const bf16* P = (const bf16*)(A->ws + WS_P); unsigned char* buf = A->ws + WS_SCR;
    const bf16* WT = (const bf16*)(A->ws + WS_WT) + (size_t)j * 2 * 2 * 8 * 128 * 128;
    const float* cw = A->in[I_CONVW] + (size_t)j * 4 * 1024; const float* cb = A->in[I_CONVB] + (size_t)j * 1024;
    const float* ba = A->in[I_BA] + (size_t)j * 2 * 1024; const float* bx = A->in[I_BX] + (size_t)j * 2 * 1024; const float* lam = A->in[I_LAM] + (size_t)j * 2 * 1024;
    const int G = gridDim.x, bid = blockIdx.x; const int vcu = (G % 8 == 0) ? (bid & 7) * (G >> 3) + (bid >> 3) : bid;
    int tid_ = threadIdx.x; asm volatile("" : "+v"(tid_)); const int wid = __builtin_amdgcn_readfirstlane(tid_ >> 6), lane = tid_ & 63;
    lru::Wreg W; int ncur = -1;
    for (int it = vcu; it < lru::NCH * 4 * 8; it += G) { const int n = it & 7, cb_ = it >> 3; const int c = cb_ % lru::NCH, b = cb_ / lru::NCH;
        if (n != ncur) { lru::load_w(W, WT, ba, bx, lam, n, wid, lane); ncur = n; }
        lru::lru1_item(P, buf, cw, cb, W, c, b, n, lds); }
}
__device__ __forceinline__ void ph_lru_merge(ArgP A, LAS unsigned char* lds) {
    const bf16* P = (const bf16*)(A->ws + WS_P); const unsigned char* buf = A->ws + WS_SCR; bf16* Y = (bf16*)(A->ws + WS_Y);
    for (int u = blockIdx.x; u < 256; u += gridDim.x) { const int ri = u & 15, bq = u >> 4;
        int c0, len; if (ri == 0) { c0 = 0; len = 4; } else { const int i = ri - 1; c0 = 4 + (i < 4 ? 5 * i : 20 + 4 * (i - 4)); len = i < 4 ? 5 : 4; }
        lru::merge_range(P, buf, Y, c0, len, bq >> 2, bq & 3, lds); }
}
__device__ __forceinline__ void ph_gla_prep(ArgP A, int j, LAS unsigned char* lds) {
    const bf16* P = (const bf16*)(A->ws + WS_P); unsigned char* img = A->ws + WS_SCR;
    const float* gw2 = A->in[I_GW2] + (size_t)j * 2 * 16 * 1024; const float* gb = A->in[I_GB] + (size_t)j * 2 * 1024;
    const int G = gridDim.x, NIT = gla::NCH * 16, NFULL = (NIT / G) * G;
    for (int it = blockIdx.x; it < NFULL; it += G) { const int c = it % gla::NCH, bh = it / gla::NCH; gla::prep_item(P, img, gw2, gb, c, bh >> 2, bh & 3, lds); }
    { const int hb = blockIdx.x; if (hb < 2 * (NIT - NFULL)) { const int it = NFULL + (hb >> 1), c = it % gla::NCH, bh = it / gla::NCH;
        if (hb & 1) gla::prep_half<1>(P, img, gw2, gb, c, bh >> 2, bh & 3, lds); else gla::prep_half<0>(P, img, gw2, gb, c, bh >> 2, bh & 3, lds); } }
}
__device__ __forceinline__ void ph_gla_seq(ArgP A, LAS unsigned char* lds) {
    const unsigned char* img = A->ws + WS_SCR; bf16* OQ = (bf16*)(A->ws + WS_OQ);
    const int G = gridDim.x, bid = blockIdx.x; const int vcu = (G % 8 == 0) ? (bid & 7) * (G >> 3) + (bid >> 3) : bid;
    for (int u = vcu; u < 256; u += G) { const int vs = u & 7, d = (u >> 3) & 1, bh = u >> 4; gla::seq_unit(img, OQ, bh >> 2, bh & 3, d, vs, lds); }
}
__device__ __forceinline__ void ph_od_c4(ArgP A, const TC& t, int j) {
    const bf16* P = (const bf16*)(A->ws + WS_P); const bf16* OQ = (const bf16*)(A->ws + WS_OQ); bf16* Y = (bf16*)(A->ws + WS_Y);
    const float* ng = A->in[I_ODNG] + j * 512;
    f32x4 g0 = *(const f32x4*)(ng + 8 * t.lane), g1 = *(const f32x4*)(ng + 8 * t.lane + 4);
    const float gg[8] = {g0.x, g0.y, g0.z, g0.w, g1.x, g1.y, g1.z, g1.w};
    for (int r = t.gw; r < MTOT; r += t.NGW) {
        v4u oa[4], ob[4], rg[4];
#pragma unroll
        for (int hh = 0; hh < 4; ++hh) { const size_t ix = (size_t)r * DM + hh * 512 + 8 * t.lane;
            oa[hh] = *(const v4u*)(OQ + ix); ob[hh] = *(const v4u*)(OQ + (size_t)MTOT * DM + ix); rg[hh] = *(const v4u*)(P + (size_t)r * OD_INP + 4096 + hh * 512 + 8 * t.lane); }
#pragma unroll
        for (int hh = 0; hh < 4; ++hh) {
            const unsigned aw[4] = {oa[hh].x, oa[hh].y, oa[hh].z, oa[hh].w}, bw[4] = {ob[hh].x, ob[hh].y, ob[hh].z, ob[hh].w}, rw[4] = {rg[hh].x, rg[hh].y, rg[hh].z, rg[hh].w};
            float o[8]; float ss = 0.f;
#pragma unroll
            for (int i = 0; i < 8; ++i) {
#define EL_(W) ((i & 1) ? __builtin_bit_cast(float, W[i >> 1] & 0xffff0000u) : __builtin_bit_cast(float, W[i >> 1] << 16))
                o[i] = EL_(aw) + EL_(bw); ss += o[i] * o[i]; }
            const float rstd = __builtin_amdgcn_rsqf(wave_sum(ss) * (1.f / 512.f) + EPS);
            float y[8];
#pragma unroll
            for (int i = 0; i < 8; ++i) y[i] = o[i] * rstd * gg[i] * siluf_(EL_(rw));
#undef EL_
            v4u w; w.x = pk2(y[0], y[1]); w.y = pk2(y[2], y[3]); w.z = pk2(y[4], y[5]); w.w = pk2(y[6], y[7]);
            *(v4u*)(Y + (size_t)r * DM + hh * 512 + 8 * t.lane) = w; }
    }
}
__device__ __forceinline__ void ph_final(ArgP A, const TC& t) {
    const bf16* H = (const bf16*)(A->ws + WS_H); const float* g = A->in[I_FING];
    f32x4 gv[4][2];
#pragma unroll
    for (int jj = 0; jj < 4; ++jj) { const int c = 8 * (t.lane + 64 * jj); gv[jj][0] = *(const f32x4*)(g + c); gv[jj][1] = *(const f32x4*)(g + c + 4); }
    for (int r = t.gw; r < MLAT; r += t.NGW) {
        v4u hw[4]; float ss = 0.f;
#pragma unroll
        for (int jj = 0; jj < 4; ++jj) hw[jj] = *(const v4u*)(H + (size_t)(NCTX + r) * DM + 8 * (t.lane + 64 * jj));
        float v[4][8];
#pragma unroll
        for (int jj = 0; jj < 4; ++jj) { const unsigned ww[4] = {hw[jj].x, hw[jj].y, hw[jj].z, hw[jj].w};
#pragma unroll
            for (int i = 0; i < 8; ++i) { v[jj][i] = (i & 1) ? __builtin_bit_cast(float, ww[i >> 1] & 0xffff0000u) : __builtin_bit_cast(float, ww[i >> 1] << 16); ss += v[jj][i] * v[jj][i]; } }
        const float rstd = __builtin_amdgcn_rsqf(wave_sum(ss) * (1.f / DM) + EPS);
#pragma unroll
        for (int jj = 0; jj < 4; ++jj) { const int c = 8 * (t.lane + 64 * jj); const f32x4 g0 = gv[jj][0], g1 = gv[jj][1];
            *(f32x4*)(A->out + (size_t)r * DM + c) = (f32x4){v[jj][0] * rstd * g0.x, v[jj][1] * rstd * g0.y, v[jj][2] * rstd * g0.z, v[jj][3] * rstd * g0.w};
            *(f32x4*)(A->out + (size_t)r * DM + c + 4) = (f32x4){v[jj][4] * rstd * g1.x, v[jj][5] * rstd * g1.y, v[jj][6] * rstd * g1.z, v[jj][7] * rstd * g1.w}; }
    }
}

constexpr int PH_PER_LAYER = 7, N_PHASES = 3 + DEPTH * PH_PER_LAYER;
template <int N, int K, class Epi> __device__ __forceinline__ void run_gemm(LAS unsigned char* lds, const bf16* Aop, const bf16* Wt, int MR, const Epi& E) {
    pg8::Gemm g{Aop, Wt, MR, N, K, K}; pg8::StaticOrder S; S.init(MR, N, gridDim.x, (int)blockIdx.x, N == 2048 ? 4 : 8);
    pg8::gemm_phase<Epi, pg8::StaticOrder, true, true>(lds, g, S, E);
}

template <int K> __device__ __forceinline__ void ctx_splitk(LAS unsigned char* lds, const bf16* Aop, const bf16* Wt, float* slab) {
    const int G = gridDim.x, bid = blockIdx.x; const int vcu = (G % 8 == 0) ? (bid & 7) * (G >> 3) + (bid >> 3) : bid;
    const int ks = vcu & 7, un = vcu >> 3; constexpr int KC = K / 8;
    pg8::Gemm g{Aop + (size_t)ks * KC, Wt + (size_t)ks * KC, NCTX, DM, KC, K}; pg8::OneUnit S{un >> 3, un & 7, vcu < 256};
    pg8::EpiPartial E{slab + (size_t)ks * NCTX * DM};
    pg8::gemm_phase<pg8::EpiPartial, pg8::OneUnit, true, true>(lds, g, S, E);
}
__device__ __forceinline__ void ph_ctx_reduce(ArgP A, const TC& t, const float* gatev  , const float* ng, const float* scv  , float* rowss) {
    const float* slab = (const float*)(A->ws + WS_SLAB); bf16* H = (bf16*)(A->ws + WS_H); bf16* U = (bf16*)(A->ws + WS_U);
    for (int it = t.gw; it < NCTX * 4; it += t.NGW) { const int r = it >> 2, q = it & 3;
        float ss = 0.f;
#pragma unroll
        for (int jj = 0; jj < 2; ++jj) { const int c = q * 512 + 4 * (t.lane + 64 * jj);
            f32x4 sv[8];
#pragma unroll
            for (int ks = 0; ks < 8; ++ks) sv[ks] = *(const f32x4*)(slab + ((size_t)ks * NCTX + r) * DM + c);
            const f32x4 s = ((sv[0] + sv[1]) + (sv[2] + sv[3])) + ((sv[4] + sv[5]) + (sv[6] + sv[7]));
            const unsigned long long hw = *(const unsigned long long*)(H + (size_t)r * DM + c); const unsigned lo = (unsigned)hw, hi = (unsigned)(hw >> 32);
            const f32x4 h0 = {__builtin_bit_cast(float, lo << 16), __builtin_bit_cast(float, lo & 0xffff0000u), __builtin_bit_cast(float, hi << 16), __builtin_bit_cast(float, hi & 0xffff0000u)};
            const f32x4 gt4 = *(const f32x4*)(gatev + c), ng4 = *(const f32x4*)(ng + c), sc4 = *(const f32x4*)(scv + c);
            const f32x4 hn = h0 + gt4 * s;
            *(unsigned long long*)(H + (size_t)r * DM + c) = (unsigned long long)pk2(hn.x, hn.y) | ((unsigned long long)pk2(hn.z, hn.w) << 32); ss += (hn.x * hn.x + hn.y * hn.y) + (hn.z * hn.z + hn.w * hn.w);
            const f32x4 y = hn * (ng4 * (sc4 + 1.0f));
            *(unsigned long long*)(U + (size_t)r * DM + c) = (unsigned long long)pk2(y.x, y.y) | ((unsigned long long)pk2(y.z, y.w) << 32); }
        ss = wave_sum(ss);
        if (t.lane < 2) __hip_atomic_store(rowss + (size_t)(q + 4 * t.lane) * MTOT + r, t.lane == 0 ? ss : 0.f, __ATOMIC_RELAXED, __HIP_MEMORY_SCOPE_AGENT);
    }
}
__device__ __forceinline__ int slack_idle(int nwg) { const int G = gridDim.x, rounds = (nwg + G - 1) / G; return rounds * G - nwg; }
__device__ __forceinline__ void cvt_in_slack(ArgP A, int Lnext, int nwg, int it0, int it1, LAS unsigned char* lds) {
    int tid_ = threadIdx.x; asm volatile("" : "+v"(tid_)); const int wave = __builtin_amdgcn_readfirstlane(tid_ >> 6), lane = tid_ & 63;
    const int G = gridDim.x, idle = slack_idle(nwg), c0 = G - idle; LAS float* scr = (LAS float*)(lds + wave * 8704);
    if (idle == 0) cvt_layer(A, Lnext, it0, it1, (int)blockIdx.x * NWAVES + wave, G * NWAVES, lane, scr);
    else if ((int)blockIdx.x >= c0) cvt_layer(A, Lnext, it0, it1, ((int)blockIdx.x - c0) * NWAVES + wave, idle * NWAVES, lane, scr);
}
__global__ void __launch_bounds__(NTHR, 2) mega(Args args) {
    extern __shared__ __attribute__((aligned(16))) unsigned char lds_raw[];
    LAS unsigned char* lds = (LAS unsigned char*)lds_raw;
    volatile LAS unsigned* MISC = (volatile LAS unsigned*)(lds + MISC_OFF);
    for (int u = threadIdx.x; u < (LDS_BYTES - LDSCTL_OFF) / 4; u += NTHR) ((LAS unsigned*)(lds + LDSCTL_OFF))[u] = 0u;
    __syncthreads();
    const int lo = argp()->ph_lo, hi = argp()->ph_hi;
    const bool use_bar = (hi - lo) > 1;
    XcdBarrier bar; bar.bar = (unsigned*)(argp()->ws + WS_CTL) + CW_BAR; bar.x = 0; bar.st = nullptr;
    if (use_bar) bar = xcd_barrier_post((unsigned*)(argp()->ws + WS_CTL) + CW_BAR, MISC + 8);
#define IN(k) (lo <= (k) && (k) < hi)
#define SEAM(k) do { if (IN(k) && (k) + 1 < hi) xcd_barrier(bar); } while (0)
    if (IN(0)) { ph_setup(argp(), mk_tc(), lds); SEAM(0); }
    if (IN(1)) { ph_setup_b(argp(), mk_tc(), lds); SEAM(1); }
    for (int l = 0; l < DEPTH; ++l) {
        const int pb = 2 + l * PH_PER_LAYER, j = l >> 1; const bool even = (l & 1) == 0;
        if (IN(pb + 0)) {
            unsigned char* ws = argp()->ws; const float* bin = (const float*)(ws + WS_BIN) + (size_t)l * 5 * OD_INP;
            if (even) { pg8::EpiIn<0, true> E{(bf16*)(ws + WS_P), EV_IN, (const float*)(ws + WS_RSA), bin, OD_INP, (const float*)(ws + WS_ROPE), 0};
                        run_gemm<EV_IN, DM>(lds, (const bf16*)(ws + WS_U), (const bf16*)(ws + WS_WEVIN) + (size_t)j * EV_IN * DM, MTOT, E); }
            else      { pg8::EpiIn<0, false> E{(bf16*)(ws + WS_P), OD_INP, (const float*)(ws + WS_RSA), bin, OD_INP, nullptr, 0};
                        run_gemm<OD_INP, DM>(lds, (const bf16*)(ws + WS_U), (const bf16*)(ws + WS_WODIN) + (size_t)j * OD_INP * DM, MTOT, E); }
            if (l + 1 < DEPTH) {
                const int nwg_in = (MTOT / 256) * ((even ? EV_IN : OD_INP) / 256), nwg_up = (MTOT / 256) * (DFF / 256); const int ia = slack_idle(nwg_in), ib = slack_idle(nwg_up);
                const int tot = cvt_items_total(l + 1); const int n1 = (ia + ib) > 0 ? (int)((long)tot * ia / (ia + ib)) : tot / 2;
                cvt_in_slack(argp(), l + 1, nwg_in, 0, n1, lds); }
            SEAM(pb + 0);
        }
        if (even) {
            if (IN(pb + 1)) { ph_attn_fast(argp(), l, j, lds); ph_lru1(argp(), j, lds); SEAM(pb + 1); }
            if (IN(pb + 3)) { ph_lru_merge(argp(), lds); SEAM(pb + 3); }
        } else {
            if (IN(pb + 1)) { ph_gla_prep(argp(), j, lds); SEAM(pb + 1); }
            if (IN(pb + 2)) { ph_gla_seq(argp(), lds); SEAM(pb + 2); }
            if (IN(pb + 3)) { ph_od_c4(argp(), mk_tc(), j); SEAM(pb + 3); }
        }
        if (IN(pb + 4)) {
            unsigned char* ws = argp()->ws; const float* ml = (const float*)(ws + WS_MODS) + (size_t)l * 5 * NMODC;
            const bf16* Wt = (const bf16*)(ws + (even ? WS_WEVOUT : WS_WODOUT)) + (size_t)j * DM * DM;
            pg8::EpiResid E{(bf16*)(ws + WS_H), ml + 2 * DM, NCTX, (bf16*)(ws + WS_U), argp()->in[I_N2G] + l * DM, ml + 4 * DM, (float*)(ws + WS_RSB), (LAS float*)(lds + RED_OFF)};
            run_gemm<DM, DM>(lds, (const bf16*)(ws + WS_Y) + (size_t)NCTX * DM, Wt, MLAT, E);
            if (l < DEPTH - 1) { ctx_splitk<DM>(lds, (const bf16*)(ws + WS_Y), Wt, (float*)(ws + WS_SLAB)); xcd_barrier(bar);
                ph_ctx_reduce(argp(), mk_tc(), ml + 4 * NMODC + 2 * DM, argp()->in[I_N2G] + l * DM, ml + 4 * NMODC + 4 * DM, (float*)(ws + WS_RSB)); }
            SEAM(pb + 4);
        }
        if (IN(pb + 5)) {
            unsigned char* ws = argp()->ws;
            const int rb0 = (l == DEPTH - 1) ? NCTX : 0;
            pg8::EpiIn<1, false> E{(bf16*)(ws + WS_P), DFF, (const float*)(ws + WS_RSB), (const float*)(ws + WS_BUP) + (size_t)l * 5 * DFF, DFF, nullptr, rb0};
            run_gemm<DFF, DM>(lds, (const bf16*)(ws + WS_U) + (size_t)rb0 * DM, (const bf16*)(ws + WS_W1) + (size_t)l * DFF * DM, MTOT - rb0, E);
            if (l + 1 < DEPTH) {
                const int nwg_in = (MTOT / 256) * ((even ? EV_IN : OD_INP) / 256), nwg_up = (MTOT / 256) * (DFF / 256); const int ia = slack_idle(nwg_in), ib = slack_idle(nwg_up);
                const int tot = cvt_items_total(l + 1); const int n1 = (ia + ib) > 0 ? (int)((long)tot * ia / (ia + ib)) : tot / 2;
                cvt_in_slack(argp(), l + 1, nwg_up, n1, tot, lds); }
            SEAM(pb + 5);
        }
        if (IN(pb + 6)) {
            unsigned char* ws = argp()->ws; const float* ml = (const float*)(ws + WS_MODS) + (size_t)l * 5 * NMODC;
            const bool last = l == DEPTH - 1; const int ln = last ? l : l + 1;
            pg8::EpiResid E{(bf16*)(ws + WS_H), ml + 5 * DM, NCTX, last ? (bf16*)nullptr : (bf16*)(ws + WS_U), argp()->in[I_N1G] + ln * DM, (const float*)(ws + WS_MODS) + (size_t)ln * 5 * NMODC + 1 * DM, (float*)(ws + WS_RSA), (LAS float*)(lds + RED_OFF)};
            run_gemm<DM, DFF>(lds, (const bf16*)(ws + WS_P) + (size_t)NCTX * DFF, (const bf16*)(ws + WS_W2) + (size_t)l * DM * DFF, MLAT, E);
            if (!last) { ctx_splitk<DFF>(lds, (const bf16*)(ws + WS_P), (const bf16*)(ws + WS_W2) + (size_t)l * DM * DFF, (float*)(ws + WS_SLAB)); xcd_barrier(bar);
                ph_ctx_reduce(argp(), mk_tc(), ml + 4 * NMODC + 5 * DM, argp()->in[I_N1G] + ln * DM, (const float*)(ws + WS_MODS) + (size_t)ln * 5 * NMODC + 4 * NMODC + 1 * DM, (float*)(ws + WS_RSA));
                layer_biases(argp(), mk_tc(), l + 1, lds); }
            SEAM(pb + 6);
        }
    }
    if (IN(N_PHASES - 1)) ph_final(argp(), mk_tc());
#undef IN
#undef SEAM
}

extern "C" void kernel_launch(void* const* d_in, const int* in_sizes, int n_in, void* d_out, int out_size, void* d_ws, size_t ws_size, hipStream_t stream) {
    static int grid = 0;
    if (grid == 0) {
        if (n_in != 30 || ws_size < WS_END) { fprintf(stderr, "kernel_launch: bad n_in %d or ws %zu\n", n_in, ws_size); grid = -1; return; }
        int dev = 0, cus = 0;
        if (hipGetDevice(&dev) != hipSuccess || hipDeviceGetAttribute(&cus, hipDeviceAttributeMultiprocessorCount, dev) != hipSuccess) { grid = -1; return; }
        if (hipFuncSetAttribute((const void*)mega, hipFuncAttributeMaxDynamicSharedMemorySize, LDS_BYTES) != hipSuccess) { grid = -1; return; }
        (void)hipGetLastError();
        grid = cus;
    }
    if (grid < 0) return;
    (void)hipMemsetAsync((char*)d_ws + WS_CTL, 0, CTL_ZERO_BYTES, stream);
    Args a{};
    for (int i = 0; i < 30; ++i) a.in[i] = (const float*)d_in[i];
    a.out = (float*)d_out; a.ws = (unsigned char*)d_ws;
    a.ph_lo = 0; a.ph_hi = N_PHASES; hipLaunchKernelGGL(mega, dim3(grid), dim3(NTHR), LDS_BYTES, stream, a);
}
```

```cpp
#include <hip/hip_runtime.h>
#include <cstdio>
#include <cstdint>
#include <cmath>
#define ONE_LAUNCH 1
#define XL_DPP(v, ctrl) __builtin_bit_cast(float, __builtin_amdgcn_update_dpp(0, __builtin_bit_cast(int, (v)), (ctrl), 0xf, 0xf, true))
__device__ __forceinline__ float sum_row16(float v) { v += XL_DPP(v, 0xB1); v += XL_DPP(v, 0x4E); v += XL_DPP(v, 0x141); v += XL_DPP(v, 0x140); return v; }
__device__ __forceinline__ float max_row16(float v) { v = fmaxf(v, XL_DPP(v, 0xB1)); v = fmaxf(v, XL_DPP(v, 0x4E)); v = fmaxf(v, XL_DPP(v, 0x141)); v = fmaxf(v, XL_DPP(v, 0x140)); return v; }
__device__ __forceinline__ void xl_swap16(unsigned& a, unsigned& b) { asm volatile("s_nop 1\n\tv_permlane16_swap_b32 %0, %1" : "+v"(a), "+v"(b)); }
__device__ __forceinline__ unsigned xl_copy(unsigned a) { unsigned b = a; asm volatile("" : "+v"(b)); return b; }
__device__ __forceinline__ float sum_x16(float v) { unsigned a = __builtin_bit_cast(unsigned, v), b = a; xl_swap16(a, b); return __builtin_bit_cast(float, a) + __builtin_bit_cast(float, b); }
__device__ __forceinline__ float max_x16(float v) { unsigned a = __builtin_bit_cast(unsigned, v), b = a; xl_swap16(a, b); return fmaxf(__builtin_bit_cast(float, a), __builtin_bit_cast(float, b)); }
__device__ __forceinline__ void xl_swap32(unsigned& a, unsigned& b) { asm volatile("s_nop 1\n\tv_permlane32_swap_b32 %0, %1" : "+v"(a), "+v"(b)); }
__device__ __forceinline__ float sum_x32(float v) { unsigned a = __builtin_bit_cast(unsigned, v), b = a; xl_swap32(a, b); return __builtin_bit_cast(float, a) + __builtin_bit_cast(float, b); }
__device__ __forceinline__ float max_x32(float v) { unsigned a = __builtin_bit_cast(unsigned, v), b = a; xl_swap32(a, b); return fmaxf(__builtin_bit_cast(float, a), __builtin_bit_cast(float, b)); }
namespace pg8 {
#define PG8_LAS __attribute__((address_space(3)))
typedef unsigned short bf16_t;
typedef short bf16x8 __attribute__((ext_vector_type(8)));
typedef float f32x4 __attribute__((ext_vector_type(4)));
typedef unsigned u32x4 __attribute__((ext_vector_type(4)));
constexpr int BM = 256, BK = 64, HALF = 128, HTB = HALF * BK * 2  , STAGE_BYTES = 8 * HTB, NXCD = 8, WGM = 8;

__host__ __device__ __forceinline__ int lds_byte(int r, int c) { const int st = (r >> 4) * 2 + (c >> 5), rr = r & 15, cc = c & 31, ob = rr * 64 + cc * 2; return st * 1024 + (ob ^ (((ob >> 9) & 1) << 5)); }
__host__ __device__ __forceinline__ void stage_rc(int b, int& R, int& C) { const int st = b / 1024, sb = b % 1024, swz = sb ^ (((sb >> 9) & 1) << 5); R = (st >> 1) * 16 + swz / 64; C = (st & 1) * 32 + (swz % 64) / 2; }
__host__ __device__ __forceinline__ int perm32(int rho) { const int n = rho >> 4, i = rho & 15; return 8 * (i >> 2) + 4 * n + (i & 3); }

struct Unit { int pm, pn; };
struct Gemm { const bf16_t* A; const bf16_t* Bt; int M, N, K, LD; };

struct StaticOrder {
    int nM, nN, nwg, G, c, wgm;
    __host__ __device__ void init(int M, int N, int G_, int c_, int wgm_ = WGM) { nM = M / BM; nN = N / BM; nwg = nM * nN; G = G_; c = c_; wgm = wgm_; }
    __host__ __device__ bool next(int i, Unit& u) const {
        const long L = (long)i * G + c; if (L >= nwg) return false;
        int wgid = (int)L; { const int q = nwg / NXCD, r = nwg % NXCD, xcd = wgid % NXCD, off = wgid / NXCD; wgid = (xcd < r ? xcd * (q + 1) : r * (q + 1) + (xcd - r) * q) + off; }
        const int nig = wgm * nN, gid = wgid / nig, fm = gid * wgm, gsz = (nM - fm) < wgm ? (nM - fm) : wgm;
        u.pm = fm + ((wgid % nig) % gsz); u.pn = (wgid % nig) / gsz; return true;
    }
    __device__ __forceinline__ void a_ready(const Unit&) const {}
    __device__ __forceinline__ void done(const Unit&) const {}
};

__device__ __forceinline__ unsigned cvt_pk_bf16(float lo, float hi) { unsigned r; asm volatile("v_cvt_pk_bf16_f32 %0, %1, %2" : "=v"(r) : "v"(lo), "v"(hi)); return r; }
typedef float f32x2 __attribute__((ext_vector_type(2)));
template <int ACT, bool ROPE> struct EpiIn {
    static constexpr bool PERM = true, AFTER_DRAIN = false;
    bf16_t* O; int ldc; const float* rowss; const float* bias; int nb; const float* rope; int row_base;
    template <bool COLHALF> __device__ __forceinline__ void body(f32x4 (&acc)[2][2][4][2], const Unit& u, int wr, int wc, int fr_, int fq_) const {
        int fr = fr_, fq = fq_; asm volatile("" : "+v"(fr), "+v"(fq));
        const int prow = row_base + u.pm * BM;
        const int mr = prow < 1024 ? 4 : (prow - 1024) / 4096;
        const int row0 = prow + wr * 64 + fr; const int col0 = u.pn * BM + wc * 32 + 8 * fq;
        {   f32x4 bv[2][2];
#pragma unroll
            for (int bj = 0; bj < 2; ++bj) { bv[bj][0] = *(const f32x4*)(bias + (size_t)mr * nb + col0 + bj * HALF); bv[bj][1] = *(const f32x4*)(bias + (size_t)mr * nb + col0 + bj * HALF + 4); }
            float pq[8][2];
#pragma unroll
            for (int i = 0; i < 8; ++i) { const int row = row0 + (i >> 2) * HALF + (i & 3) * 16; pq[i][0] = rowss[(size_t)(2 * fq) * 17408 + row]; pq[i][1] = rowss[(size_t)(2 * fq + 1) * 17408 + row]; }
#pragma unroll
            for (int i = 0; i < 8; ++i) { float s = pq[i][0] + pq[i][1]; s = ::sum_x32(::sum_x16(s)); const float rs = __builtin_amdgcn_rsqf(s * (1.f / 2048.f) + 1e-6f);
#pragma unroll
                for (int bj = 0; bj < 2; ++bj) { acc[i >> 2][bj][i & 3][0] = acc[i >> 2][bj][i & 3][0] * rs + bv[bj][0]; acc[i >> 2][bj][i & 3][1] = acc[i >> 2][bj][i & 3][1] * rs + bv[bj][1]; } }
        }
        const bool ropeq = ROPE && (u.pn < 8); const bool dorope = ropeq && (prow >= 1024); const float qs = (ROPE && u.pn < 4) ? 0.125f * 1.4426950408889634f : 1.0f;
        f32x4 cc[COLHALF ? 4 : 2][2];
#pragma unroll
        for (int i = 0; i < (COLHALF ? 4 : 2); ++i) { cc[i][0] = (f32x4){1.f, 0.f, 1.f, 0.f}; cc[i][1] = (f32x4){1.f, 0.f, 1.f, 0.f}; }
        if (ROPE) { if (dorope) {
#pragma unroll
            for (int i = 0; i < (COLHALF ? 4 : 2); ++i) { const int tt = (row0 + (COLHALF ? i * 16 : i * HALF) - 1024) & 4095; const int pos = COLHALF ? (tt & 63) : (tt >> 6);
                cc[i][0] = *(const f32x4*)(rope + (pos * 16 + 4 * fq) * 2); cc[i][1] = *(const f32x4*)(rope + (pos * 16 + 4 * fq) * 2 + 4); } } }
#pragma unroll
        for (int ai = 0; ai < 2; ++ai)
#pragma unroll
            for (int m = 0; m < 4; ++m) { const int row = row0 + ai * HALF + m * 16; bf16_t* rowp = O + (size_t)row * ldc + col0;
                const f32x4 c0 = cc[COLHALF ? m : ai][0], c1 = cc[COLHALF ? m : ai][1];
#pragma unroll
                for (int bj = 0; bj < 2; ++bj) { f32x4 v0 = acc[ai][bj][m][0], v1 = acc[ai][bj][m][1];
                    if (ROPE) { if (ropeq) {
                        const f32x4 r0 = {(v0[0] * c0[0] - v0[1] * c0[1]) * qs, (v0[1] * c0[0] + v0[0] * c0[1]) * qs, (v0[2] * c0[2] - v0[3] * c0[3]) * qs, (v0[3] * c0[2] + v0[2] * c0[3]) * qs};
                        const f32x4 r1 = {(v1[0] * c1[0] - v1[1] * c1[1]) * qs, (v1[1] * c1[0] + v1[0] * c1[1]) * qs, (v1[2] * c1[2] - v1[3] * c1[3]) * qs, (v1[3] * c1[2] + v1[2] * c1[3]) * qs};
                        v0 = r0; v1 = r1; } }
                    if (ACT == 1) {
#pragma unroll
                        for (int e = 0; e < 4; ++e) { float a = v0[e] > 0.f ? v0[e] : 0.f; v0[e] = a * a; float b = v1[e] > 0.f ? v1[e] : 0.f; v1[e] = b * b; } }
                    u32x4 w; w.x = cvt_pk_bf16(v0[0], v0[1]); w.y = cvt_pk_bf16(v0[2], v0[3]); w.z = cvt_pk_bf16(v1[0], v1[1]); w.w = cvt_pk_bf16(v1[2], v1[3]);
                    *(u32x4*)(rowp + bj * HALF) = w; } }
    }
    __device__ __forceinline__ void operator()(f32x4 (&acc)[2][2][4][2], const Unit& u, int wr, int wc, int fr, int fq) const {
        if (ROPE && (wc & 1)) body<true>(acc, u, wr, wc, fr, fq); else body<false>(acc, u, wr, wc, fr, fq);
    }
};
struct EpiResid {
    static constexpr bool PERM = true, AFTER_DRAIN = false;
    bf16_t* H; const float* gatev; int row_base;
    bf16_t* U; const float* ng; const float* scv; float* rowss;
    PG8_LAS float* red;
    __device__ __forceinline__ void operator()(const f32x4 (&acc)[2][2][4][2], const Unit& u, int wr, int wc, int fr_, int fq_) const {
        int fr = fr_, fq = fq_; asm volatile("" : "+v"(fr), "+v"(fq));
        const int prow = row_base + u.pm * BM;
        const int mr = prow < 1024 ? 4 : (prow - 1024) / 4096;
        const float* gate = gatev + (size_t)mr * 12288;
        const int col0 = u.pn * BM + wc * 32 + 8 * fq;
        const size_t rowoff = (size_t)(prow + wr * 64 + fr) * 2048 + col0;
        float ss[8];
#pragma unroll
        for (int i = 0; i < 8; ++i) ss[i] = 0.f;
#pragma unroll
        for (int bj = 0; bj < 2; ++bj) { const int co = bj * HALF; const f32x4 g0 = *(const f32x4*)(gate + col0 + co), g1 = *(const f32x4*)(gate + col0 + co + 4);
            u32x4 hv[8];
#pragma unroll
            for (int ai = 0; ai < 2; ++ai)
#pragma unroll
                for (int m = 0; m < 4; ++m) hv[ai * 4 + m] = *(const u32x4*)(H + rowoff + (size_t)(ai * HALF + m * 16) * 2048 + co);
            f32x4 s0 = {0.f, 0.f, 0.f, 0.f}, s1 = s0;
            if (U) { s0 = *(const f32x4*)(ng + col0 + co) * (*(const f32x4*)(scv + (size_t)mr * 12288 + col0 + co) + 1.0f); s1 = *(const f32x4*)(ng + col0 + co + 4) * (*(const f32x4*)(scv + (size_t)mr * 12288 + col0 + co + 4) + 1.0f); }
#pragma unroll
            for (int ai = 0; ai < 2; ++ai)
#pragma unroll
                for (int m = 0; m < 4; ++m) { const u32x4 hw = hv[ai * 4 + m];
                    const f32x4 h0 = {__builtin_bit_cast(float, hw.x << 16), __builtin_bit_cast(float, hw.x & 0xffff0000u), __builtin_bit_cast(float, hw.y << 16), __builtin_bit_cast(float, hw.y & 0xffff0000u)};
                    const f32x4 h1 = {__builtin_bit_cast(float, hw.z << 16), __builtin_bit_cast(float, hw.z & 0xffff0000u), __builtin_bit_cast(float, hw.w << 16), __builtin_bit_cast(float, hw.w & 0xffff0000u)};
                    const f32x4 n0 = h0 + g0 * acc[ai][bj][m][0], n1 = h1 + g1 * acc[ai][bj][m][1];
                    u32x4 w; w.x = cvt_pk_bf16(n0[0], n0[1]); w.y = cvt_pk_bf16(n0[2], n0[3]); w.z = cvt_pk_bf16(n1[0], n1[1]); w.w = cvt_pk_bf16(n1[2], n1[3]);
                    *(u32x4*)(H + rowoff + (size_t)(ai * HALF + m * 16) * 2048 + co) = w;
                    if (U) { const f32x4 a0 = n0 * s0, a1 = n1 * s1; ss[ai * 4 + m] += ((n0[0] * n0[0] + n0[1] * n0[1]) + (n0[2] * n0[2] + n0[3] * n0[3])) + ((n1[0] * n1[0] + n1[1] * n1[1]) + (n1[2] * n1[2] + n1[3] * n1[3]));
                        u32x4 v; v.x = cvt_pk_bf16(a0[0], a0[1]); v.y = cvt_pk_bf16(a0[2], a0[3]); v.z = cvt_pk_bf16(a1[0], a1[1]); v.w = cvt_pk_bf16(a1[2], a1[3]);
                        *(u32x4*)(U + rowoff + (size_t)(ai * HALF + m * 16) * 2048 + co) = v; } }
        }
        if (U) {
#pragma unroll
            for (int i = 0; i < 8; ++i) { float s = ss[i]; s = ::sum_x32(::sum_x16(s));
                if (fq == 0) red[wc * 256 + (i >> 2) * HALF + wr * 64 + (i & 3) * 16 + fr] = s; }
            asm volatile("s_waitcnt lgkmcnt(0)" ::: "memory"); __builtin_amdgcn_s_barrier(); asm volatile("" ::: "memory");
            const int tl = (wr * 4 + wc) * 64 + fq * 16 + fr;
            if (tl < 256) rowss[(size_t)u.pn * 17408 + prow + tl] = (red[tl] + red[256 + tl]) + (red[512 + tl] + red[768 + tl]);
        }
    }
};
struct EpiPartial {
    static constexpr bool PERM = false, AFTER_DRAIN = false;
    float* slab;
    __device__ __forceinline__ void operator()(const f32x4 (&acc)[2][2][4][2], const Unit& u, int wr, int wc, int fr_, int fq_) const {
        int fr = fr_, fq = fq_; asm volatile("" : "+v"(fr), "+v"(fq));
        float* p = slab + (size_t)(u.pm * BM + wr * 64 + fr) * 2048 + u.pn * BM + wc * 32 + 4 * fq;
#pragma unroll
        for (int ai = 0; ai < 2; ++ai)
#pragma unroll
            for (int m = 0; m < 4; ++m)
#pragma unroll
                for (int bj = 0; bj < 2; ++bj)
#pragma unroll
                    for (int n = 0; n < 2; ++n) *(f32x4*)(p + (size_t)(ai * HALF + m * 16) * 2048 + bj * HALF + n * 16) = acc[ai][bj][m][n];
    }
};
struct OneUnit {
    int pm, pn; bool has;
    __device__ __forceinline__ bool next(int i, Unit& u) const { if (i > 0 || !has) return false; u.pm = pm; u.pn = pn; return true; }
    __device__ __forceinline__ void a_ready(const Unit&) const {}
    __device__ __forceinline__ void done(const Unit&) const {}
};
template <class Epi, class Sched, bool ALIGN_EPI = false, bool SP2 = false>
__device__ __forceinline__ void gemm_phase(PG8_LAS unsigned char* lds, const Gemm g, const Sched& S, const Epi& E) {
    int tid_ = threadIdx.x; asm volatile("" : "+v"(tid_)); const int tid = tid_, wid = __builtin_amdgcn_readfirstlane(tid >> 6), lane = tid & 63, wr = wid >> 2, wc = wid & 3, fr = lane & 15, fq = lane >> 4;
    const int K = g.LD, nt = g.K / BK;
    unsigned voffA[2], voffB[2];
#pragma unroll
    for (int i = 0; i < 2; ++i) { int R, C; stage_rc(tid * 16 + i * 8192, R, C); const int Rb = Epi::PERM ? ((R & ~31) + perm32(R & 31)) : R;
        voffA[i] = (unsigned)(R * K + C) * 2u; voffB[i] = (unsigned)(Rb * K + C) * 2u; }
    const size_t kstep = (size_t)(BK * 2);
    const size_t hstep = (size_t)HALF * K * 2;
    const size_t tstep = 2 * hstep;
    const unsigned ldsw = (unsigned)wid * 1024u;
    const int aoff = lds_byte(wr * 64 + fr, fq * 8), boff = lds_byte(wc * 32 + fr, fq * 8);
#define PG8_SA(b, h) (((b) * 2 + (h)) * HTB)
#define PG8_SB(b, h) ((4 + (b) * 2 + (h)) * HTB)
#define PG8_STAGE(bufoff, gbase, voff) do { _Pragma("unroll") for (int _i = 0; _i < 2; ++_i) \
        __builtin_amdgcn_global_load_lds((const unsigned*)((const char*)(gbase) + (voff)[_i]), (PG8_LAS unsigned*)(lds + (bufoff) + ldsw + _i * 8192), 16, 0, 0); } while (0)
#define PG8_LDA(dst, b, h) do { _Pragma("unroll") for (int m = 0; m < 4; ++m) _Pragma("unroll") for (int k = 0; k < 2; ++k) dst[m][k] = *(const PG8_LAS bf16x8*)(lds + PG8_SA(b, h) + aoff + m * 2048 + k * 1024); } while (0)
#define PG8_LDB(dst, b, h) do { _Pragma("unroll") for (int n = 0; n < 2; ++n) _Pragma("unroll") for (int k = 0; k < 2; ++k) dst[n][k] = *(const PG8_LAS bf16x8*)(lds + PG8_SB(b, h) + boff + n * 2048 + k * 1024); } while (0)
#define PG8_MMA(ai, bj, At, Bt) do { __builtin_amdgcn_s_setprio(1); _Pragma("unroll") for (int m = 0; m < 4; ++m) _Pragma("unroll") for (int n = 0; n < 2; ++n) _Pragma("unroll") for (int k = 0; k < 2; ++k) \
        acc[ai][bj][m][n] = __builtin_amdgcn_mfma_f32_16x16x32_bf16(Bt[n][k], At[m][k], acc[ai][bj][m][n], 0, 0, 0); __builtin_amdgcn_s_setprio(0); } while (0)
#define PG8_WAIT_V(n) asm volatile("s_waitcnt vmcnt(" #n ")" ::: "memory")
#define PG8_WAIT_L(n) asm volatile("s_waitcnt lgkmcnt(" #n ")" ::: "memory")
#define PG8_BAR __builtin_amdgcn_s_barrier()
#define PG8_SCHED __builtin_amdgcn_sched_barrier(0)
    Unit cur, nxt; int ui = 0;
    if (!S.next(0, cur)) return;
    f32x4 acc[2][2][4][2];
#pragma unroll
    for (int a = 0; a < 2; ++a)
#pragma unroll
        for (int b = 0; b < 2; ++b)
#pragma unroll
            for (int m = 0; m < 4; ++m)
#pragma unroll
                for (int n = 0; n < 2; ++n) acc[a][b][m][n] = (f32x4){0.f, 0.f, 0.f, 0.f};
    bf16x8 At[4][2], B0[2][2], B1[2][2];
    const char* cA = (const char*)g.A + (size_t)cur.pm * tstep; const char* cB = (const char*)g.Bt + (size_t)cur.pn * tstep;
    S.a_ready(cur);
    if constexpr (SP2) {
        PG8_STAGE(PG8_SB(0, 0), cB, voffB); PG8_STAGE(PG8_SB(0, 1), cB + hstep, voffB); PG8_STAGE(PG8_SA(0, 0), cA, voffA); PG8_STAGE(PG8_SA(0, 1), cA + hstep, voffA);
        if (wr == 1) PG8_BAR;
        PG8_WAIT_V(2); PG8_BAR;
        PG8_STAGE(PG8_SB(1, 0), cB + kstep, voffB); PG8_STAGE(PG8_SA(1, 0), cA + kstep, voffA); PG8_STAGE(PG8_SB(1, 1), cB + hstep + kstep, voffB);
        PG8_WAIT_V(6); PG8_BAR;
    } else {
        PG8_STAGE(PG8_SB(0, 0), cB, voffB); PG8_STAGE(PG8_SA(0, 0), cA, voffA); PG8_STAGE(PG8_SB(0, 1), cB + hstep, voffB); PG8_STAGE(PG8_SA(0, 1), cA + hstep, voffA);
        if (wr == 1) PG8_BAR;
        PG8_WAIT_V(4); PG8_BAR;
        PG8_STAGE(PG8_SB(1, 0), cB + kstep, voffB); PG8_STAGE(PG8_SA(1, 0), cA + kstep, voffA); PG8_STAGE(PG8_SB(1, 1), cB + hstep + kstep, voffB);
        PG8_WAIT_V(6); PG8_BAR;
    }
    for (;;) {
        const bool has_next = S.next(ui + 1, nxt);
        const char* nA = has_next ? (const char*)g.A + (size_t)nxt.pm * tstep : cA; const char* nB = has_next ? (const char*)g.Bt + (size_t)nxt.pn * tstep : cB;
        for (int t = 0; t < nt; t += 2) {
            const bool last = (t == nt - 2);
            const char* a1 = cA + (size_t)(t + 1) * kstep;
            const char* a2 = last ? nA : cA + (size_t)(t + 2) * kstep; const char* b2 = last ? nB : cB + (size_t)(t + 2) * kstep;
            const char* a3 = a2 + kstep; const char* b3 = b2 + kstep;
            if (last && has_next) S.a_ready(nxt);
            if constexpr (SP2) {
            PG8_LDB(B0, 0, 0); PG8_LDB(B1, 0, 1); PG8_SCHED; PG8_LDA(At, 0, 0); PG8_STAGE(PG8_SA(1, 1), a1 + hstep, voffA);
            PG8_WAIT_V(8); PG8_WAIT_L(0); PG8_BAR; PG8_MMA(0, 0, At, B0); PG8_MMA(0, 1, At, B1); PG8_BAR; PG8_SCHED;
            PG8_LDA(At, 0, 1); PG8_STAGE(PG8_SB(0, 0), b2, voffB); PG8_STAGE(PG8_SB(0, 1), b2 + hstep, voffB); PG8_STAGE(PG8_SA(0, 0), a2, voffA);
            PG8_WAIT_V(8); PG8_WAIT_L(0); PG8_BAR; PG8_MMA(1, 0, At, B0); PG8_MMA(1, 1, At, B1); PG8_BAR; PG8_SCHED;
            PG8_LDB(B0, 1, 0); PG8_LDB(B1, 1, 1); PG8_SCHED; PG8_LDA(At, 1, 0); PG8_STAGE(PG8_SA(0, 1), a2 + hstep, voffA);
            PG8_WAIT_V(8); PG8_WAIT_L(0); PG8_BAR; PG8_MMA(0, 0, At, B0); PG8_MMA(0, 1, At, B1); PG8_BAR; PG8_SCHED;
            PG8_LDA(At, 1, 1); PG8_STAGE(PG8_SB(1, 0), b3, voffB); PG8_STAGE(PG8_SB(1, 1), b3 + hstep, voffB); PG8_STAGE(PG8_SA(1, 0), a3, voffA);
            PG8_WAIT_V(8); PG8_WAIT_L(0); PG8_BAR; PG8_MMA(1, 0, At, B0); PG8_MMA(1, 1, At, B1); PG8_BAR; PG8_SCHED;
            } else {
            PG8_LDB(B0, 0, 0); PG8_SCHED; PG8_LDA(At, 0, 0); PG8_STAGE(PG8_SA(1, 1), a1 + hstep, voffA);
            PG8_WAIT_L(8); PG8_BAR; PG8_WAIT_L(0); PG8_MMA(0, 0, At, B0); PG8_BAR; PG8_SCHED;
            PG8_LDB(B1, 0, 1); PG8_STAGE(PG8_SB(0, 0), b2, voffB);
            PG8_BAR; PG8_WAIT_L(0); PG8_MMA(0, 1, At, B1); PG8_BAR;
            PG8_LDA(At, 0, 1); PG8_STAGE(PG8_SA(0, 0), a2, voffA);
            PG8_BAR; PG8_WAIT_L(0); PG8_MMA(1, 0, At, B0); PG8_BAR; PG8_SCHED;
            PG8_STAGE(PG8_SB(0, 1), b2 + hstep, voffB);
            PG8_WAIT_V(6); PG8_BAR; PG8_MMA(1, 1, At, B1); PG8_BAR;
            PG8_LDB(B0, 1, 0); PG8_SCHED; PG8_LDA(At, 1, 0); PG8_STAGE(PG8_SA(0, 1), a2 + hstep, voffA);
            PG8_WAIT_L(8); PG8_BAR; PG8_WAIT_L(0); PG8_MMA(0, 0, At, B0); PG8_BAR; PG8_SCHED;
            PG8_LDB(B1, 1, 1); PG8_STAGE(PG8_SB(1, 0), b3, voffB);
            PG8_BAR; PG8_WAIT_L(0); PG8_MMA(0, 1, At, B1); PG8_BAR;
            PG8_LDA(At, 1, 1); PG8_STAGE(PG8_SA(1, 0), a3, voffA);
            PG8_BAR; PG8_WAIT_L(0); PG8_MMA(1, 0, At, B0); PG8_BAR; PG8_SCHED;
            PG8_STAGE(PG8_SB(1, 1), b3 + hstep, voffB);
            PG8_WAIT_V(6); PG8_BAR; PG8_MMA(1, 1, At, B1); PG8_BAR;
            }
        }
        if constexpr (ALIGN_EPI) { if (wr == 0) PG8_BAR; }
        if constexpr (!Epi::AFTER_DRAIN) { E(acc, cur, wr, wc, fr, fq); S.done(cur); }
        if (!has_next) break;
#pragma unroll
        for (int a = 0; a < 2; ++a)
#pragma unroll
            for (int b = 0; b < 2; ++b)
#pragma unroll
                for (int m = 0; m < 4; ++m)
#pragma unroll
                    for (int n = 0; n < 2; ++n) acc[a][b][m][n] = (f32x4){0.f, 0.f, 0.f, 0.f};
        cur = nxt; cA = nA; cB = nB; ++ui;
        if constexpr (ALIGN_EPI) { if (wr == 1) PG8_BAR; }
    }
    PG8_WAIT_V(0);
    if constexpr (!ALIGN_EPI) { if (wr == 0) PG8_BAR; }
    PG8_BAR;
    if constexpr (Epi::AFTER_DRAIN) { E.fused(acc, cur, wr, wc, fr, fq, lds, wid, lane); S.done(cur); }
#undef PG8_SA
#undef PG8_SB
#undef PG8_STAGE
#undef PG8_LDA
#undef PG8_LDB
#undef PG8_MMA
#undef PG8_WAIT_V
#undef PG8_WAIT_L
#undef PG8_BAR
#undef PG8_SCHED
}
}
#define GAS __attribute__((address_space(1)))
#define LAS __attribute__((address_space(3)))
typedef unsigned short bf16;
typedef unsigned v4u __attribute__((ext_vector_type(4)));
typedef float f32x4 __attribute__((ext_vector_type(4)));
typedef short bf16x8 __attribute__((ext_vector_type(8)));
typedef GAS unsigned gu32;
typedef GAS unsigned long long gu64;
#define RLX_AGENT __ATOMIC_RELAXED, __HIP_MEMORY_SCOPE_AGENT
#define LDS_WAIT() asm volatile("s_waitcnt lgkmcnt(0)" ::: "memory")
#define VM_WAIT() asm volatile("s_waitcnt vmcnt(0)" ::: "memory")
__device__ __forceinline__ unsigned long long rt() { return __builtin_amdgcn_s_memrealtime(); }
typedef __bf16 xbf2_t __attribute__((ext_vector_type(2)));
typedef float xf2_t __attribute__((ext_vector_type(2)));
__device__ __forceinline__ unsigned pk2(float lo, float hi) { return __builtin_bit_cast(unsigned, __builtin_convertvector((xf2_t){lo, hi}, xbf2_t)); }
__device__ __forceinline__ unsigned f2bf(float f) { return (unsigned)__builtin_bit_cast(unsigned short, (__bf16)f); }
#define XB_TMO      128
#define XB_XCNT(j)  (256  + 64 * (j))
#define XB_XSUB(j)  (1280 + 64 * (j))
#define XB_XGEN(j)  (2304 + 64 * (j))
#define XB_TOP      3328
#define XB_TOPGEN   3392
#define XCD_BAR_WORDS 3456
#define XB_SPIN_CAP (1u << 18)

__device__ __forceinline__ unsigned xb_ld(unsigned* p)              { return __hip_atomic_load(p, __ATOMIC_RELAXED, __HIP_MEMORY_SCOPE_AGENT); }
__device__ __forceinline__ unsigned xb_add(unsigned* p, unsigned v) { return __hip_atomic_fetch_add(p, v, __ATOMIC_RELAXED, __HIP_MEMORY_SCOPE_AGENT); }
__device__ __forceinline__ unsigned xb_xcc_id() { return (unsigned)__builtin_amdgcn_s_getreg((3 << 11) | 20) & 0xFu; }
#define XB_SPIN(cond, bar) do { unsigned _sp = 0; while (cond) { __builtin_amdgcn_s_sleep(1); \
    if ((++_sp & 255u) == 0u) { if (xb_ld(&(bar)[XB_TMO])) break; if (_sp > XB_SPIN_CAP) { atomicAdd(&(bar)[XB_TMO], 1u); break; } } } } while (0)

struct XcdBarrier {
    unsigned* bar; unsigned x;
    volatile LAS unsigned* st;
};

__device__ __forceinline__ XcdBarrier xcd_barrier_post(unsigned* bar, volatile LAS unsigned* st) {
    XcdBarrier b; b.bar = bar; b.x = xb_xcc_id(); b.st = st;
    if (threadIdx.x == 0) (void)xb_add(&bar[XB_XCNT(b.x)], 1u);
    return b;
}
__device__ __forceinline__ void xcd_barrier_complete(unsigned* bar, unsigned x, unsigned& nloc, unsigned& nx) {
    const unsigned G = gridDim.x * gridDim.y * gridDim.z;
    unsigned sum, cnt, mine, sp = 0u;
    for (;;) {
        sum = 0u; cnt = 0u; mine = 0u;
#pragma unroll
        for (unsigned j = 0; j < 16; ++j) { const unsigned c = xb_ld(&bar[XB_XCNT(j)]); sum += c; cnt += (c > 0u) ? 1u : 0u; mine = (j == x) ? c : mine; }
        if (sum == G) break;
        __builtin_amdgcn_s_sleep(1);
        if ((++sp & 255u) == 0u) { if (xb_ld(&bar[XB_TMO])) break; if (sp > XB_SPIN_CAP) { atomicAdd(&bar[XB_TMO], 1u); break; } }
    }
    nloc = mine > 0u ? mine : 1u; nx = cnt > 0u ? cnt : 1u;
}

__device__ __forceinline__ void xcd_barrier(const XcdBarrier& b) {
    asm volatile("s_waitcnt vmcnt(0)" ::: "memory");
    __syncthreads();
    if (threadIdx.x == 0) {
        unsigned* bar = b.bar;
        __builtin_amdgcn_s_waitcnt(0);
        unsigned nloc = b.st[0], nx = b.st[1];
        if (nloc == 0u) { xcd_barrier_complete(bar, b.x, nloc, nx); b.st[0] = nloc; b.st[1] = nx; }
        const unsigned old = xb_add(&bar[XB_XSUB(b.x)], 1u);
        const unsigned gen = old / nloc;
        if (old + 1u == (gen + 1u) * nloc) {
            __builtin_amdgcn_fence(__ATOMIC_RELEASE, "agent");
            asm volatile("s_waitcnt vmcnt(0)" ::: "memory");
            const unsigned og = xb_add(&bar[XB_TOP], 1u);
            const unsigned tg = og / nx;
            if (og + 1u == (tg + 1u) * nx) xb_add(&bar[XB_TOPGEN], 1u);
            else XB_SPIN(xb_ld(&bar[XB_TOPGEN]) == tg, bar);
            __builtin_amdgcn_fence(__ATOMIC_ACQUIRE, "agent");
            xb_add(&bar[XB_XGEN(b.x)], 1u);
            asm volatile("s_waitcnt vmcnt(0)" ::: "memory");
        } else {
            XB_SPIN(xb_ld(&bar[XB_XGEN(b.x)]) == gen, bar);
            __builtin_amdgcn_fence(__ATOMIC_ACQUIRE, "agent");
            asm volatile("s_waitcnt vmcnt(0)" ::: "memory");
        }
    }
    __syncthreads();
}
template <bool ROPEPERM = false> __device__ __forceinline__ void p0_transpose_item(const float* W, int K, int N, bf16* WT, int row_off, LAS float* scr, int item, int lane) {
    const int nblk = N / 32, kb = item / nblk, nb = item % nblk, k0 = 64 * kb, n0 = 32 * nb;
    float wv[32];
#pragma unroll
    for (int i = 0; i < 32; ++i) wv[i] = W[(size_t)(k0 + 2 * i + (lane >> 5)) * N + n0 + (lane & 31)];
#pragma unroll
    for (int i = 0; i < 32; ++i) scr[(2 * i + (lane >> 5)) * 33 + (lane & 31)] = wv[i];
    LDS_WAIT(); asm volatile("" ::: "memory");
    const int c = lane & 7;
#pragma unroll
    for (int j = 0; j < 4; ++j) { const int n = (lane >> 3) + 8 * j; const LAS float* s = scr + (8 * c) * 33 + n; const int nd = (ROPEPERM && n0 < 2048) ? 2 * (n & 15) + (n >> 4) : n;
        v4u o; o.x = pk2(s[0 * 33], s[1 * 33]); o.y = pk2(s[2 * 33], s[3 * 33]); o.z = pk2(s[4 * 33], s[5 * 33]); o.w = pk2(s[6 * 33], s[7 * 33]);
        *(GAS v4u*)(WT + (size_t)(row_off + n0 + nd) * K + k0 + 8 * c) = o; }
    LDS_WAIT(); asm volatile("" ::: "memory");
}
namespace att {
using bf16x8 = __attribute__((ext_vector_type(8))) short;
using s16x4  = __attribute__((ext_vector_type(4))) short;
using f32x16 = __attribute__((ext_vector_type(16))) float;
using u32x4  = __attribute__((ext_vector_type(4))) unsigned;
constexpr int KVBLK = 64, LDP = 5120;
constexpr int SHM_V = KVBLK * 128 * 2, SHM_K = KVBLK * 128 * 2;
constexpr float THRN = 8.f;
#define ATT_KSWZ(row, colB) ((row) * 256 + ((colB) ^ (((row) & 7) << 4)))
#define ATT_SBAR() __builtin_amdgcn_sched_barrier(0)
__device__ __forceinline__ int crow(int r, int hi) { return (r & 3) + 8 * (r >> 2) + 4 * hi; }
__device__ __forceinline__ unsigned cvtpk(float lo, float hi) { unsigned r; asm volatile("v_cvt_pk_bf16_f32 %0, %1, %2" : "=v"(r) : "v"(lo), "v"(hi)); return r; }
constexpr float THR2 = 8.f * 1.4426950408889634f;
typedef float f32x2_t __attribute__((ext_vector_type(2)));
template <bool FIRST> __device__ __forceinline__ void partialSM(f32x16& p0, f32x16& p1, float& m_ref, float& alpha) {
  float pmax = p0[0];
#pragma unroll
  for (int r = 1; r < 16; ++r) pmax = fmaxf(pmax, p0[r]);
#pragma unroll
  for (int r = 0; r < 16; ++r) pmax = fmaxf(pmax, p1[r]);
  { auto rr = __builtin_amdgcn_permlane32_swap(__float_as_uint(pmax), __float_as_uint(pmax), false, false);
    pmax = fmaxf(__uint_as_float(rr[0]), __uint_as_float(rr[1])); }
  alpha = 1.f;
  if (FIRST) m_ref = pmax;
  else if (!__builtin_expect(__all(pmax - m_ref <= THR2), 1)) { const float mn = fmaxf(m_ref, pmax); alpha = __builtin_amdgcn_exp2f(m_ref - mn); m_ref = mn; }
  const f32x2_t nm = {-m_ref, -m_ref};
#pragma unroll
  for (int r = 0; r < 16; r += 2) { const f32x2_t a = (f32x2_t){p0[r], p0[r + 1]} + nm, b = (f32x2_t){p1[r], p1[r + 1]} + nm; p0[r] = a.x; p0[r + 1] = a.y; p1[r] = b.x; p1[r + 1] = b.y; }
#pragma unroll
  for (int r = 0; r < 16; ++r) p0[r] = __builtin_amdgcn_exp2f(p0[r]);
}
__device__ __forceinline__ void finishSM(f32x16& p0, f32x16& p1, float alpha, float& l_reg, bf16x8& pa0, bf16x8& pa1, bf16x8& pa2, bf16x8& pa3) {
#pragma unroll
  for (int r = 0; r < 16; ++r) p1[r] = __builtin_amdgcn_exp2f(p1[r]);
  float ps = 0;
#pragma unroll
  for (int r = 0; r < 16; ++r) ps += p0[r];
#pragma unroll
  for (int r = 0; r < 16; ++r) ps += p1[r];
  { auto rr = __builtin_amdgcn_permlane32_swap(__float_as_uint(ps), __float_as_uint(ps), false, false);
    ps = __uint_as_float(rr[0]) + __uint_as_float(rr[1]); }
  l_reg = l_reg * alpha + ps;
#define ATT_PK4(P, BASE, OUT) do { unsigned a0 = cvtpk(P[BASE + 0], P[BASE + 1]), a1 = cvtpk(P[BASE + 2], P[BASE + 3]);   \
    unsigned b0 = cvtpk(P[BASE + 4], P[BASE + 5]), b1 = cvtpk(P[BASE + 6], P[BASE + 7]);                              \
    auto r0 = __builtin_amdgcn_permlane32_swap(a0, b0, false, false); auto r1 = __builtin_amdgcn_permlane32_swap(a1, b1, false, false); \
    u32x4 w = {r0[0], r1[0], r0[1], r1[1]}; OUT = *reinterpret_cast<bf16x8*>(&w); } while (0)
  ATT_PK4(p0, 0, pa0); ATT_PK4(p0, 8, pa1); ATT_PK4(p1, 0, pa2); ATT_PK4(p1, 8, pa3);
#undef ATT_PK4
}
__device__ __forceinline__ void qkt(f32x16& p0, f32x16& p1, const LAS unsigned char* Ks, const bf16x8* qr, int r32, int hi, int mp) {
  p0 = f32x16{}; p1 = f32x16{};
#pragma unroll
  for (int d0 = 0; d0 < 4; ++d0) { const int cb = ((mp * 4 + d0) * 16 + hi * 8) * 2;
    const bf16x8 b0 = *(const LAS bf16x8*)(Ks + ATT_KSWZ(r32, cb));
    const bf16x8 b1 = *(const LAS bf16x8*)(Ks + ATT_KSWZ(32 + r32, cb));
    p0 = __builtin_amdgcn_mfma_f32_32x32x16_bf16(b0, qr[d0], p0, 0, 0, 0);
    p1 = __builtin_amdgcn_mfma_f32_32x32x16_bf16(b1, qr[d0], p1, 0, 0, 0); }
}
__device__ __forceinline__ int v_st(int k, int c) { const int kk = (k & ~0xC) | ((k & 4) << 1) | ((k & 8) >> 1); return ((kk >> 3) * 4 + (c >> 5)) * 512 + ((kk & 7) * 32 + (c & 31)) * 2; }
__device__ __forceinline__ int v_rd_base(int lane) { return ((lane & 3) << 3) | (((lane >> 2) & 3) << 6) | (((lane >> 4) & 1) << 5) | (((lane >> 5) & 1) << 8); }
constexpr int v_rd_off(int d0, int ks, int half) { return d0 * 512 + ks * 4096 + half * 2048; }
template <int OFF> __device__ __forceinline__ s16x4 tr_read(int vb) {
  s16x4 r; asm volatile("ds_read_b64_tr_b16 %0, %1 offset:%2" : "=&v"(r) : "v"(vb), "i"(OFF) : "memory"); return r;
}
template <int D0> __device__ __forceinline__ void pv_one(f32x16& od, int vb, bf16x8 pa0, bf16x8 pa1, bf16x8 pa2, bf16x8 pa3) {
  const s16x4 l0 = tr_read<v_rd_off(D0, 0, 0)>(vb), h0 = tr_read<v_rd_off(D0, 0, 1)>(vb), l1 = tr_read<v_rd_off(D0, 1, 0)>(vb), h1 = tr_read<v_rd_off(D0, 1, 1)>(vb);
  const s16x4 l2 = tr_read<v_rd_off(D0, 2, 0)>(vb), h2 = tr_read<v_rd_off(D0, 2, 1)>(vb), l3 = tr_read<v_rd_off(D0, 3, 0)>(vb), h3 = tr_read<v_rd_off(D0, 3, 1)>(vb);
  asm volatile("s_waitcnt lgkmcnt(0)" ::: "memory"); ATT_SBAR();
#define ATT_PK(L, H) (bf16x8){L[0], L[1], L[2], L[3], H[0], H[1], H[2], H[3]}
  od = __builtin_amdgcn_mfma_f32_32x32x16_bf16(pa0, ATT_PK(l0, h0), od, 0, 0, 0);
  od = __builtin_amdgcn_mfma_f32_32x32x16_bf16(pa1, ATT_PK(l1, h1), od, 0, 0, 0);
  od = __builtin_amdgcn_mfma_f32_32x32x16_bf16(pa2, ATT_PK(l2, h2), od, 0, 0, 0);
  od = __builtin_amdgcn_mfma_f32_32x32x16_bf16(pa3, ATT_PK(l3, h3), od, 0, 0, 0);
#undef ATT_PK
}
__device__ __forceinline__ void pv_d0(f32x16* o, int vb, bf16x8 pa0, bf16x8 pa1, bf16x8 pa2, bf16x8 pa3) {
  pv_one<0>(o[0], vb, pa0, pa1, pa2, pa3); pv_one<1>(o[1], vb, pa0, pa1, pa2, pa3); pv_one<2>(o[2], vb, pa0, pa1, pa2, pa3); pv_one<3>(o[3], vb, pa0, pa1, pa2, pa3);
}

#define ATT_PIN(x) asm volatile("" : "+v"(x))
__device__ __forceinline__ bf16x8 mk_pa(unsigned a, unsigned b, unsigned c, unsigned d) { u32x4 w = {a, b, c, d}; return *reinterpret_cast<bf16x8*>(&w); }
__device__ __forceinline__ void firstSM(f32x16& p0, f32x16& p1, float& m_ref) {
  float pmax = p0[0];
#pragma unroll
  for (int r = 1; r < 16; ++r) pmax = fmaxf(pmax, p0[r]);
#pragma unroll
  for (int r = 0; r < 16; ++r) pmax = fmaxf(pmax, p1[r]);
  { auto rr = __builtin_amdgcn_permlane32_swap(__float_as_uint(pmax), __float_as_uint(pmax), false, false);
    pmax = fmaxf(__uint_as_float(rr[0]), __uint_as_float(rr[1])); }
  m_ref = pmax;
#pragma unroll
  for (int r = 0; r < 16; ++r) { p0[r] = __builtin_amdgcn_exp2f(p0[r] - pmax); p1[r] = __builtin_amdgcn_exp2f(p1[r] - pmax); }
}
__device__ __forceinline__ void finishOnly(const f32x16& p0, const f32x16& p1, float alpha, float& l_reg, bf16x8& pa0, bf16x8& pa1, bf16x8& pa2, bf16x8& pa3) {
  float s0 = 0.f, s1 = 0.f;
#pragma unroll
  for (int r = 0; r < 16; r += 2) { s0 += p0[r]; s1 += p0[r + 1]; }
#pragma unroll
  for (int r = 0; r < 16; r += 2) { s0 += p1[r]; s1 += p1[r + 1]; }
  l_reg = l_reg * alpha + (s0 + s1);
  pa0 = mk_pa(cvtpk(p0[0], p0[1]), cvtpk(p0[2], p0[3]), cvtpk(p0[4], p0[5]), cvtpk(p0[6], p0[7]));
  pa1 = mk_pa(cvtpk(p0[8], p0[9]), cvtpk(p0[10], p0[11]), cvtpk(p0[12], p0[13]), cvtpk(p0[14], p0[15]));
  pa2 = mk_pa(cvtpk(p1[0], p1[1]), cvtpk(p1[2], p1[3]), cvtpk(p1[4], p1[5]), cvtpk(p1[6], p1[7]));
  pa3 = mk_pa(cvtpk(p1[8], p1[9]), cvtpk(p1[10], p1[11]), cvtpk(p1[12], p1[13]), cvtpk(p1[14], p1[15]));
}
__device__ __forceinline__ void phaseA(f32x16& S0, f32x16& S1, const LAS unsigned char* Ks, const bf16x8* qr, int r32, int hi, int mp,
                                       const f32x16& P0, const f32x16& P1, float alphaP, float& l_reg, bf16x8& pa0, bf16x8& pa1, bf16x8& pa2, bf16x8& pa3, float& m0,
                                       int vb, s16x4& vl0, s16x4& vh0, s16x4& vl1, s16x4& vh1, s16x4& vl2, s16x4& vh2, s16x4& vl3, s16x4& vh3) {
  const int cbb = (mp * 64 + hi * 8) * 2;
#define ATT_KF(row, d0) (*(const LAS bf16x8*)(Ks + ATT_KSWZ((row), cbb + (d0) * 32)))
  bf16x8 ka0 = ATT_KF(r32, 0), ka1 = ATT_KF(r32, 1), ka2 = ATT_KF(r32, 2), ka3 = ATT_KF(r32, 3), kb0, kb1, kb2, kb3;
  float s0 = 0.f, s1 = 0.f; unsigned c0, c1, c2, c3, c4, c5, c6, c7;
  S0 = f32x16{}; S1 = f32x16{};
#define ATT_FA(P, B, CA, CB) do { s0 += P[B]; s1 += P[B + 1]; s0 += P[B + 2]; s1 += P[B + 3]; CA = cvtpk(P[B], P[B + 1]); CB = cvtpk(P[B + 2], P[B + 3]); ATT_PIN(s0); ATT_PIN(s1); } while (0)
  ATT_SBAR();
  S0 = __builtin_amdgcn_mfma_f32_32x32x16_bf16(ka0, qr[0], S0, 0, 0, 0); ATT_FA(P0, 0, c0, c1); kb0 = ATT_KF(32 + r32, 0); kb1 = ATT_KF(32 + r32, 1); ATT_SBAR();
  S0 = __builtin_amdgcn_mfma_f32_32x32x16_bf16(ka1, qr[1], S0, 0, 0, 0); ATT_FA(P0, 4, c2, c3); kb2 = ATT_KF(32 + r32, 2); kb3 = ATT_KF(32 + r32, 3); ATT_SBAR();
  pa0 = mk_pa(c0, c1, c2, c3);
  S0 = __builtin_amdgcn_mfma_f32_32x32x16_bf16(ka2, qr[2], S0, 0, 0, 0); ATT_FA(P0, 8, c4, c5); ATT_SBAR();
  S0 = __builtin_amdgcn_mfma_f32_32x32x16_bf16(ka3, qr[3], S0, 0, 0, 0); ATT_FA(P0, 12, c6, c7); ATT_SBAR();
  pa1 = mk_pa(c4, c5, c6, c7);
  S1 = __builtin_amdgcn_mfma_f32_32x32x16_bf16(kb0, qr[0], S1, 0, 0, 0); ATT_FA(P1, 0, c0, c1); vl0 = tr_read<v_rd_off(0, 0, 0)>(vb); vh0 = tr_read<v_rd_off(0, 0, 1)>(vb); ATT_SBAR();
  float ma, mb;
  S1 = __builtin_amdgcn_mfma_f32_32x32x16_bf16(kb1, qr[1], S1, 0, 0, 0); ATT_FA(P1, 4, c2, c3);
  ma = fmaxf(fmaxf(S0[0], S0[1]), S0[2]); mb = fmaxf(fmaxf(S0[3], S0[4]), S0[5]); ATT_PIN(ma); ATT_PIN(mb); vl1 = tr_read<v_rd_off(0, 1, 0)>(vb); vh1 = tr_read<v_rd_off(0, 1, 1)>(vb); ATT_SBAR();
  pa2 = mk_pa(c0, c1, c2, c3);
  S1 = __builtin_amdgcn_mfma_f32_32x32x16_bf16(kb2, qr[2], S1, 0, 0, 0); ATT_FA(P1, 8, c4, c5);
  ma = fmaxf(fmaxf(ma, S0[6]), S0[7]); mb = fmaxf(fmaxf(mb, S0[8]), S0[9]); ma = fmaxf(fmaxf(ma, S0[10]), S0[11]); ATT_PIN(ma); ATT_PIN(mb); vl2 = tr_read<v_rd_off(0, 2, 0)>(vb); vh2 = tr_read<v_rd_off(0, 2, 1)>(vb); ATT_SBAR();
  S1 = __builtin_amdgcn_mfma_f32_32x32x16_bf16(kb3, qr[3], S1, 0, 0, 0); ATT_FA(P1, 12, c6, c7);
  mb = fmaxf(fmaxf(mb, S0[12]), S0[13]); ma = fmaxf(fmaxf(ma, S0[14]), S0[15]); ATT_PIN(ma); ATT_PIN(mb); vl3 = tr_read<v_rd_off(0, 3, 0)>(vb); vh3 = tr_read<v_rd_off(0, 3, 1)>(vb); ATT_SBAR();
  pa3 = mk_pa(c4, c5, c6, c7);
  m0 = fmaxf(ma, mb);
  l_reg = l_reg * alphaP + (s0 + s1);
#undef ATT_FA
#undef ATT_KF
}
__device__ __forceinline__ void decideSM(const f32x16& S1, float m0, float& m_ref, float& alpha) {
  float ma = fmaxf(fmaxf(m0, S1[0]), S1[1]), mb = fmaxf(fmaxf(S1[2], S1[3]), S1[4]);
  ma = fmaxf(fmaxf(ma, S1[5]), S1[6]); mb = fmaxf(fmaxf(mb, S1[7]), S1[8]); ma = fmaxf(fmaxf(ma, S1[9]), S1[10]); mb = fmaxf(fmaxf(mb, S1[11]), S1[12]);
  ma = fmaxf(fmaxf(ma, S1[13]), S1[14]); float pmax = fmaxf(fmaxf(ma, mb), S1[15]);
  alpha = 1.f;
  if (!__builtin_expect(__all(pmax - m_ref <= THR2), 1)) {
    auto rr = __builtin_amdgcn_permlane32_swap(__float_as_uint(pmax), __float_as_uint(pmax), false, false);
    pmax = fmaxf(__uint_as_float(rr[0]), __uint_as_float(rr[1]));
    const float mn = fmaxf(m_ref, pmax); alpha = __builtin_amdgcn_exp2f(m_ref - mn); m_ref = mn; }
}
#define ATT_PK(L, H) (bf16x8){L[0], L[1], L[2], L[3], H[0], H[1], H[2], H[3]}
#define ATT_EXP2(S, E) do { float x0_ = __builtin_amdgcn_exp2f(S[E] - m_ref), x1_ = __builtin_amdgcn_exp2f(S[E + 1] - m_ref); ATT_PIN(x0_); ATT_PIN(x1_); S[E] = x0_; S[E + 1] = x1_; } while (0)
#define ATT_PVG(OD, L0, H0, L1, H1, L2, H2, L3, H3, SX, E0, RDNEXT, D0N, NL0, NH0, NL1, NH1, NL2, NH2, NL3, NH3) do { \
    OD = __builtin_amdgcn_mfma_f32_32x32x16_bf16(pa0, ATT_PK(L0, H0), OD, 0, 0, 0); ATT_EXP2(SX, E0);     if (RDNEXT) { NL0 = tr_read<v_rd_off(D0N, 0, 0)>(vb); NH0 = tr_read<v_rd_off(D0N, 0, 1)>(vb); } ATT_SBAR(); \
    OD = __builtin_amdgcn_mfma_f32_32x32x16_bf16(pa1, ATT_PK(L1, H1), OD, 0, 0, 0); ATT_EXP2(SX, E0 + 2); if (RDNEXT) { NL1 = tr_read<v_rd_off(D0N, 1, 0)>(vb); NH1 = tr_read<v_rd_off(D0N, 1, 1)>(vb); } ATT_SBAR(); \
    OD = __builtin_amdgcn_mfma_f32_32x32x16_bf16(pa2, ATT_PK(L2, H2), OD, 0, 0, 0); ATT_EXP2(SX, E0 + 4); if (RDNEXT) { NL2 = tr_read<v_rd_off(D0N, 2, 0)>(vb); NH2 = tr_read<v_rd_off(D0N, 2, 1)>(vb); } ATT_SBAR(); \
    OD = __builtin_amdgcn_mfma_f32_32x32x16_bf16(pa3, ATT_PK(L3, H3), OD, 0, 0, 0); ATT_EXP2(SX, E0 + 6); if (RDNEXT) { NL3 = tr_read<v_rd_off(D0N, 3, 0)>(vb); NH3 = tr_read<v_rd_off(D0N, 3, 1)>(vb); } \
    asm volatile("s_waitcnt lgkmcnt(0)" ::: "memory"); ATT_SBAR(); } while (0)
__device__ __forceinline__ void phaseB(f32x16* o, int vb, bf16x8 pa0, bf16x8 pa1, bf16x8 pa2, bf16x8 pa3, f32x16& S0, f32x16& S1, float m_ref,
                                       s16x4 al0, s16x4 ah0, s16x4 al1, s16x4 ah1, s16x4 al2, s16x4 ah2, s16x4 al3, s16x4 ah3) {
  s16x4 bl0, bh0, bl1, bh1, bl2, bh2, bl3, bh3;
  asm volatile("s_waitcnt lgkmcnt(0)" ::: "memory"); ATT_SBAR();
  ATT_PVG(o[0], al0, ah0, al1, ah1, al2, ah2, al3, ah3, S0, 0, true, 1, bl0, bh0, bl1, bh1, bl2, bh2, bl3, bh3);
  ATT_PVG(o[1], bl0, bh0, bl1, bh1, bl2, bh2, bl3, bh3, S0, 8, true, 2, al0, ah0, al1, ah1, al2, ah2, al3, ah3);
  ATT_PVG(o[2], al0, ah0, al1, ah1, al2, ah2, al3, ah3, S1, 0, true, 3, bl0, bh0, bl1, bh1, bl2, bh2, bl3, bh3);
  ATT_PVG(o[3], bl0, bh0, bl1, bh1, bl2, bh2, bl3, bh3, S1, 8, false, 3, al0, ah0, al1, ah1, al2, ah2, al3, ah3);
}
__device__ __forceinline__ int tile_row(int b, int t) { return t < 4 ? b * 256 + 64 * t : 1024 + b * 4096 + 64 * (t - 4); }

__device__ __forceinline__ void att_glds(const void* gbase, unsigned voffB, unsigned lds_dst) { unsigned keep;
  asm volatile("s_mov_b32 %0, m0\n\ts_mov_b32 m0, %3\n\ts_nop 0\n\tglobal_load_lds_dwordx4 %1, %2\n\ts_mov_b32 m0, %0" : "=&s"(keep) : "v"(voffB), "s"(gbase), "s"(lds_dst) : "memory"); }
constexpr int SLOT_BYTES = SHM_K + SHM_V;
__device__ __forceinline__ void attn_unit(const unsigned short* __restrict__ P, unsigned short* __restrict__ Y, int b, int hh, int qrow0, int NT, float lam, float post, const float* __restrict__ sg, LAS unsigned char* lds) {
  int tid_ = threadIdx.x; asm volatile("" : "+v"(tid_)); const int tid = tid_, wid = __builtin_amdgcn_readfirstlane(tid >> 6), lane = tid & 63, r32 = lane & 31, hi = lane >> 5, mp = wid >> 2, wq = wid & 3;
  LAS float* wsf = (LAS float*)(lds + 3 * SLOT_BYTES) + wid * 64; LAS float* li_l = wsf; LAS float* al_l = wsf + 32;
  float m_reg = 0.f, l_reg = 0; f32x16 o[4] = {}; bf16x8 qr[4];
  const unsigned short* Qw = P + (size_t)(qrow0 + wq * 32 + r32) * LDP + hh * 128 + mp * 64 + hi * 8;
#pragma unroll
  for (int d0 = 0; d0 < 4; ++d0) qr[d0] = *(const bf16x8*)(Qw + d0 * 16);
  unsigned koff, voff;
  { const int u = wid * 64 + lane;
      { const int row = u >> 4, c16 = (u & 15) ^ (row & 7); koff = (unsigned)(row * LDP + 1024 + hh * 128 + c16 * 8) * 2u; }
      { const int sub = u >> 5, within = u & 31, kk = (sub >> 2) * 8 + (within >> 2), k = kk, c = (sub & 3) * 32 + (within & 3) * 8; voff = (unsigned)(k * LDP + 2048 + hh * 128 + c) * 2u; } }
  const unsigned koff2 = koff + 32u * LDP * 2u, voff2 = voff + 32u * LDP * 2u;
  const unsigned lds0 = (unsigned)(uintptr_t)lds;
#define ATT_DMA(t, slot_off) do { const unsigned short* tb_ = P + (size_t)tile_row(b, (t)) * LDP; const unsigned d_ = lds0 + (slot_off); \
    att_glds(tb_, koff, (unsigned)__builtin_amdgcn_readfirstlane(d_ + wid * 1024)); att_glds(tb_, koff2, (unsigned)__builtin_amdgcn_readfirstlane(d_ + (wid + 8) * 1024)); \
    att_glds(tb_, voff, (unsigned)__builtin_amdgcn_readfirstlane(d_ + SHM_K + wid * 1024)); att_glds(tb_, voff2, (unsigned)__builtin_amdgcn_readfirstlane(d_ + SHM_K + (wid + 8) * 1024)); } while (0)
#define ATT_RESC(a) do { if (__any((a) < 1.f)) { if (hi == 0) al_l[r32] = (a); asm volatile("s_waitcnt lgkmcnt(0)" ::: "memory"); \
    _Pragma("unroll") for (int d = 0; d < 4; ++d) _Pragma("unroll") for (int r = 0; r < 16; ++r) o[d][r] *= al_l[crow(r, hi)]; } } while (0)
#define ATT_WAITBAR(N) asm volatile("s_waitcnt vmcnt(" #N ") lgkmcnt(0)\n\ts_barrier" ::: "memory")
  const int vb0 = (int)lds0 + SHM_K + v_rd_base(lane);
  f32x16 pA0, pA1, pB0, pB1; float alA, alB; bf16x8 pa0, pa1, pa2, pa3;
  int s_cur = 0, s_nxt = SLOT_BYTES, s_nn = 2 * SLOT_BYTES;
#define ATT_ROT() do { const int t_ = s_cur; s_cur = s_nxt; s_nxt = s_nn; s_nn = t_; } while (0)
  ATT_DMA(0, 0); ATT_DMA(1, SLOT_BYTES);
  ATT_WAITBAR(4);
  if (2 < NT) ATT_DMA(2, 2 * SLOT_BYTES);
  qkt(pA0, pA1, lds + s_cur, qr, r32, hi, mp); firstSM(pA0, pA1, m_reg); alA = 1.f;
  if (2 < NT) ATT_WAITBAR(4); else ATT_WAITBAR(0);
  float m0; s16x4 vl0, vh0, vl1, vh1, vl2, vh2, vl3, vh3;
  for (int t = 0; t + 1 < NT; t += 2) {
    phaseA(pB0, pB1, lds + s_nxt, qr, r32, hi, mp, pA0, pA1, alA, l_reg, pa0, pa1, pa2, pa3, m0, vb0 + s_cur, vl0, vh0, vl1, vh1, vl2, vh2, vl3, vh3);
    decideSM(pB1, m0, m_reg, alB); ATT_SBAR();
    phaseB(o, vb0 + s_cur, pa0, pa1, pa2, pa3, pB0, pB1, m_reg, vl0, vh0, vl1, vh1, vl2, vh2, vl3, vh3);
    ATT_RESC(alB);
    ATT_WAITBAR(0);
    if (t + 3 < NT) ATT_DMA(t + 3, s_cur);
    ATT_ROT();
    if (t + 2 < NT) {
      phaseA(pA0, pA1, lds + s_nxt, qr, r32, hi, mp, pB0, pB1, alB, l_reg, pa0, pa1, pa2, pa3, m0, vb0 + s_cur, vl0, vh0, vl1, vh1, vl2, vh2, vl3, vh3);
      decideSM(pA1, m0, m_reg, alA); ATT_SBAR();
      phaseB(o, vb0 + s_cur, pa0, pa1, pa2, pa3, pA0, pA1, m_reg, vl0, vh0, vl1, vh1, vl2, vh2, vl3, vh3);
      ATT_RESC(alA);
      ATT_WAITBAR(0);
      if (t + 4 < NT) ATT_DMA(t + 4, s_cur);
      ATT_ROT();
    }
  }
  finishOnly(pB0, pB1, alB, l_reg, pa0, pa1, pa2, pa3); ATT_SBAR();
  pv_d0(o, vb0 + s_cur, pa0, pa1, pa2, pa3);
  { auto rr = __builtin_amdgcn_permlane32_swap(__float_as_uint(l_reg), __float_as_uint(l_reg), false, false); l_reg = __uint_as_float(rr[0]) + __uint_as_float(rr[1]); }
  if (hi == 0) li_l[r32] = l_reg; asm volatile("s_waitcnt lgkmcnt(0)" ::: "memory");
  float rli[16];
#pragma unroll
  for (int r = 0; r < 16; ++r) rli[r] = __builtin_amdgcn_rcpf(li_l[crow(r, hi)]);
  __syncthreads();
  LAS float* X = (LAS float*)lds;
  if (mp == 1) {
#pragma unroll
    for (int r = 0; r < 16; ++r)
#pragma unroll
      for (int d0 = 0; d0 < 4; ++d0) X[(wq * 32 + crow(r, hi)) * 128 + d0 * 32 + r32] = o[d0][r] * rli[r] * lam;
  }
  __syncthreads();
  if (mp == 0) {
    float ss[16];
#pragma unroll
    for (int r = 0; r < 16; ++r) { float s = 0.f;
#pragma unroll
      for (int d0 = 0; d0 < 4; ++d0) { const float v = o[d0][r] * rli[r] - X[(wq * 32 + crow(r, hi)) * 128 + d0 * 32 + r32]; o[d0][r] = v; s += v * v; }
      ss[r] = s; }
#pragma unroll
    for (int r = 0; r < 16; ++r) {
      ss[r] = ::sum_x16(::sum_row16(ss[r]));
      ss[r] = post * __builtin_amdgcn_rsqf(ss[r] * (1.f / 128.f) + 1e-6f); }
    float gg[4];
#pragma unroll
    for (int d0 = 0; d0 < 4; ++d0) gg[d0] = sg[d0 * 32 + r32];
    unsigned short* Yw = Y + (size_t)(qrow0 + wq * 32) * 2048 + hh * 128 + r32;
#pragma unroll
    for (int r = 0; r < 16; ++r)
#pragma unroll
      for (int d0 = 0; d0 < 4; ++d0) Yw[(size_t)crow(r, hi) * 2048 + d0 * 32] = (unsigned short)f2bf(o[d0][r] * ss[r] * gg[d0]);
  }
  __syncthreads();
#undef ATT_DMA
#undef ATT_WAITBAR
#undef ATT_ROT
#undef ATT_RESC
}
}
namespace gla {
using bf16x8 = __attribute__((ext_vector_type(8))) short;
using f32x4 = __attribute__((ext_vector_type(4))) float;
using u32x4 = __attribute__((ext_vector_type(4))) unsigned;
typedef float f32x2 __attribute__((ext_vector_type(2)));
constexpr int LDP = 6400, NCH = 68;
constexpr int QE_BYTES = 32768, KDT_BYTES = 32768 + 1024, ATT_BYTES = 8192, VT_BYTES = 65536;
constexpr size_t QEI_OFF = 0, KDI_OFF = QEI_OFF + (size_t)2 * 16 * NCH * QE_BYTES, ATT_OFF = KDI_OFF + (size_t)2 * 16 * NCH * KDT_BYTES, VT_OFF = ATT_OFF + (size_t)2 * 16 * NCH * ATT_BYTES,
                 IMG_END = VT_OFF + (size_t)16 * NCH * VT_BYTES;
__device__ __forceinline__ int chunk_row(int b, int c) { return c < 4 ? b * 256 + 64 * c : 1024 + b * 4096 + 64 * (c - 4); }
__device__ __forceinline__ unsigned cvtpk(float lo, float hi) { unsigned r; asm volatile("v_cvt_pk_bf16_f32 %0, %1, %2" : "=v"(r) : "v"(lo), "v"(hi)); return r; }
__device__ __forceinline__ float bf2f_(unsigned short v) { return __builtin_bit_cast(float, (unsigned)v << 16); }
__device__ __forceinline__ int qe_off(int t, int k) { const int ks = k >> 5, k5 = k & 31, g = (k5 & 15) >> 2, j = (k5 & 3) + ((k5 >> 4) << 2); const int ch = (4 * ks + g) ^ (t & 15); return t * 512 + ch * 16 + j * 2; }
__device__ __forceinline__ int r128_off(int r, int cidx) { return r * 128 + ((cidx ^ ((r >> 1) & 7)) << 4); }

__device__ __forceinline__ void prep_item(const unsigned short* __restrict__ P, unsigned char* __restrict__ img, const float* __restrict__ gw2, const float* __restrict__ gb, int c, int b, int hh, LAS unsigned char* lds) {
    int tid_ = threadIdx.x; asm volatile("" : "+v"(tid_)); const int tid = tid_, lane = tid & 63, wid = __builtin_amdgcn_readfirstlane(tid >> 6), g = lane >> 4, r16 = lane & 15;
    const int rb = chunk_row(b, c); const int bh = b * 4 + hh;
    LAS unsigned char* QEI = lds; LAS unsigned char* KEI = lds + 32768; LAS unsigned char* KDI = lds + 65536; LAS unsigned char* ATI = lds + 65536 + KDT_BYTES;
    LAS float* ZT = (LAS float*)(lds + 65536 + KDT_BYTES + ATT_BYTES); LAS float* SEG = ZT + 64 * 32;
    {
        { const int tb = tid & 7, vg = tid >> 3; u32x4 xr[8];
#pragma unroll
          for (int j = 0; j < 8; ++j) xr[j] = *(const u32x4*)(P + (size_t)(rb + 8 * tb + j) * LDP + 2048 + hh * 512 + 8 * vg);
#pragma unroll
          for (int q = 0; q < 8; ++q) { const int v = 8 * vg + q; unsigned ow[4];
#pragma unroll
              for (int w = 0; w < 4; ++w) { const unsigned a = xr[2 * w][q >> 1], bq = xr[2 * w + 1][q >> 1]; ow[w] = (q & 1) ? ((a >> 16) | (bq & 0xffff0000u)) : ((a & 0xffffu) | (bq << 16)); }
              *(LAS u32x4*)(lds + r128_off(v, tb)) = (u32x4){ow[0], ow[1], ow[2], ow[3]}; } }
        __syncthreads();
        unsigned char* dst = img + VT_OFF + (size_t)(bh * NCH + c) * VT_BYTES;
#pragma unroll
        for (int i = 0; i < 8; ++i) { const int e = tid + i * 512; *(u32x4*)(dst + (size_t)e * 16) = *(const LAS u32x4*)(lds + e * 16); }
        __syncthreads();
    }
    const int k = tid & 255, th = tid >> 8;
#pragma unroll
    for (int i = 0; i < 4; ++i) { const int e = tid + i * 512, t = e >> 5, c16 = e & 31; const size_t ro = (size_t)(rb + t) * LDP + hh * 256 + c16 * 8;
        *(LAS u32x4*)(QEI + t * 512 + c16 * 16) = *(const u32x4*)(P + ro); *(LAS u32x4*)(KEI + t * 512 + c16 * 16) = *(const u32x4*)(P + ro + 1024); }
    __syncthreads();
    float qreg[32], kreg[32];
#pragma unroll
    for (int i = 0; i < 32; ++i) { qreg[i] = bf2f_(*(const LAS unsigned short*)(QEI + (32 * th + i) * 512 + k * 2)) * 0.0625f; kreg[i] = bf2f_(*(const LAS unsigned short*)(KEI + (32 * th + i) * 512 + k * 2)); }
#pragma unroll
    for (int d = 0; d < 2; ++d) {
        LAS float* XG = (LAS float*)lds;
        if (d == 0) __syncthreads();
        { bf16x8 za[4];
#pragma unroll
          for (int tt = 0; tt < 4; ++tt) { za[tt] = (bf16x8){0, 0, 0, 0, 0, 0, 0, 0}; if (g < 2) za[tt] = *(const bf16x8*)(P + (size_t)(rb + 16 * tt + r16) * LDP + 6144 + d * 16 + 8 * g); }
#pragma unroll
          for (int j = 0; j < 2; ++j) { const int kc = 32 * wid + 16 * j + r16; float wv[8];
#pragma unroll
              for (int i = 0; i < 8; ++i) { wv[i] = 0.f; if (g < 2) wv[i] = gw2[(size_t)(d * 16 + 8 * g + i) * 1024 + hh * 256 + kc]; }
              unsigned hw[4], lw[4];
#pragma unroll
              for (int p = 0; p < 4; ++p) { hw[p] = pk2(wv[2 * p], wv[2 * p + 1]);
                  lw[p] = pk2(wv[2 * p] - __builtin_bit_cast(float, hw[p] << 16), wv[2 * p + 1] - __builtin_bit_cast(float, hw[p] & 0xffff0000u)); }
              const bf16x8 bh = __builtin_bit_cast(bf16x8, (u32x4){hw[0], hw[1], hw[2], hw[3]}), bl = __builtin_bit_cast(bf16x8, (u32x4){lw[0], lw[1], lw[2], lw[3]});
#pragma unroll
              for (int tt = 0; tt < 4; ++tt) { f32x4 ag = {0.f, 0.f, 0.f, 0.f};
                  ag = __builtin_amdgcn_mfma_f32_16x16x32_bf16(za[tt], bh, ag, 0, 0, 0); ag = __builtin_amdgcn_mfma_f32_16x16x32_bf16(za[tt], bl, ag, 0, 0, 0);
#pragma unroll
                  for (int rg = 0; rg < 4; ++rg) XG[(16 * tt + 4 * g + rg) * 256 + kc] = ag[rg]; } } }
        __syncthreads();
        const float bias = gb[d * 1024 + hh * 256 + k];
        float bc[32]; float run = 0.f;
#pragma unroll
        for (int i = 0; i < 32; ++i) { const int t = d == 0 ? 32 * th + i : 32 * th + 31 - i;
            const float x = XG[t * 256 + k] + bias;
            const float l2 = __builtin_amdgcn_logf(1.0f + __builtin_amdgcn_exp2f(fabsf(x) * -1.4426950408889634f));
            run += __builtin_fmaf(fminf(x, 0.f), 0.0625f * 1.4426950408889634f, l2 * -0.0625f); bc[i] = run; }
        SEG[th * 256 + k] = run;
        __syncthreads();
        const float s0 = SEG[k], s1 = SEG[256 + k]; const float bend = s0 + s1;
        const float pre = d == 0 ? (th == 1 ? s0 : 0.f) : (th == 0 ? s1 : 0.f);
        const float ebend = __builtin_amdgcn_exp2f(bend);
        unsigned kdp[16];
#pragma unroll
        for (int i = 0; i < 16; ++i) kdp[i] = 0u;
#pragma unroll
        for (int i = 0; i < 32; ++i) { const int t = d == 0 ? 32 * th + i : 32 * th + 31 - i; const float bcum = bc[i] + pre;
            const float qv = qreg[d == 0 ? i : 31 - i], kv = kreg[d == 0 ? i : 31 - i];
            const float qe = qv * __builtin_amdgcn_exp2f(bcum), ke = kv * __builtin_amdgcn_exp2f(-bcum), kd = ke * ebend;
            *(LAS unsigned short*)(QEI + qe_off(t, k)) = (unsigned short)f2bf(qe);
            *(LAS unsigned short*)(KEI + qe_off(t, k)) = (unsigned short)f2bf(ke);
            const int tl = t & 31;
            const unsigned hv = f2bf(kd);
            if (tl & 1) kdp[tl >> 1] = (kdp[tl >> 1] & 0xffffu) | (hv << 16); else kdp[tl >> 1] = (kdp[tl >> 1] & 0xffff0000u) | hv; }
#pragma unroll
        for (int cc = 0; cc < 4; ++cc) *(LAS u32x4*)(KDI + r128_off(k, 4 * th + cc)) = (u32x4){kdp[4 * cc], kdp[4 * cc + 1], kdp[4 * cc + 2], kdp[4 * cc + 3]};
        if (th == 0) *(LAS float*)(KDI + 32768 + 4 * k) = ebend;
        __syncthreads();
        { const int tt = wid >> 1; f32x4 acc[2] = {};
#pragma unroll
          for (int ks = 0; ks < 8; ++ks) { const int trow = 16 * tt + r16; const bf16x8 af = *(const LAS bf16x8*)(QEI + trow * 512 + (((4 * ks + g) ^ (trow & 15)) << 4));
#pragma unroll
            for (int mi = 0; mi < 2; ++mi) { const int mrow = 16 * (2 * (wid & 1) + mi) + r16; const bf16x8 bfr = *(const LAS bf16x8*)(KEI + mrow * 512 + (((4 * ks + g) ^ (mrow & 15)) << 4));
                acc[mi] = __builtin_amdgcn_mfma_f32_16x16x32_bf16(af, bfr, acc[mi], 0, 0, 0); } }
#pragma unroll
          for (int mi = 0; mi < 2; ++mi) { const int m = 16 * (2 * (wid & 1) + mi) + r16;
#pragma unroll
            for (int rg = 0; rg < 4; ++rg) { const int t = 16 * tt + 4 * g + rg; const bool keep = d == 0 ? (m <= t) : (m >= t);
                *(LAS unsigned short*)(ATI + r128_off(t, m >> 3) + (m & 7) * 2) = (unsigned short)f2bf(keep ? acc[mi][rg] : 0.f); } } }
        __syncthreads();
        { const size_t ii = (size_t)((d * 16 + bh) * NCH + c);
          unsigned char* dq = img + QEI_OFF + ii * QE_BYTES; unsigned char* dk = img + KDI_OFF + ii * KDT_BYTES; unsigned char* da = img + ATT_OFF + ii * ATT_BYTES;
#pragma unroll
          for (int i = 0; i < 4; ++i) { const int e = tid + i * 512; *(u32x4*)(dq + (size_t)e * 16) = *(const LAS u32x4*)(QEI + e * 16); }
          for (int e = tid; e < KDT_BYTES / 16; e += 512) *(u32x4*)(dk + (size_t)e * 16) = *(const LAS u32x4*)(KDI + e * 16);
          *(u32x4*)(da + (size_t)tid * 16) = *(const LAS u32x4*)(ATI + tid * 16); }
        __syncthreads();
    }
}

template <int DD> __device__ __forceinline__ void prep_half(const unsigned short* __restrict__ P, unsigned char* __restrict__ img, const float* __restrict__ gw2, const float* __restrict__ gb, int c, int b, int hh, LAS unsigned char* lds) {
    int tid_ = threadIdx.x; asm volatile("" : "+v"(tid_)); const int tid = tid_, lane = tid & 63, wid = __builtin_amdgcn_readfirstlane(tid >> 6), g = lane >> 4, r16 = lane & 15;
    const int rb = chunk_row(b, c); const int bh = b * 4 + hh;
    LAS unsigned char* QEI = lds; LAS unsigned char* KEI = lds + 32768; LAS unsigned char* KDI = lds + 65536; LAS unsigned char* ATI = lds + 65536 + KDT_BYTES;
    LAS float* ZT = (LAS float*)(lds + 65536 + KDT_BYTES + ATT_BYTES); LAS float* SEG = ZT + 64 * 32;
    __syncthreads();
    if (DD == 0) {
        { const int tb = tid & 7, vg = tid >> 3; u32x4 xr[8];
#pragma unroll
          for (int j = 0; j < 8; ++j) xr[j] = *(const u32x4*)(P + (size_t)(rb + 8 * tb + j) * LDP + 2048 + hh * 512 + 8 * vg);
#pragma unroll
          for (int q = 0; q < 8; ++q) { const int v = 8 * vg + q; unsigned ow[4];
#pragma unroll
              for (int w = 0; w < 4; ++w) { const unsigned a = xr[2 * w][q >> 1], bq = xr[2 * w + 1][q >> 1]; ow[w] = (q & 1) ? ((a >> 16) | (bq & 0xffff0000u)) : ((a & 0xffffu) | (bq << 16)); }
              *(LAS u32x4*)(lds + r128_off(v, tb)) = (u32x4){ow[0], ow[1], ow[2], ow[3]}; } }
        __syncthreads();
        unsigned char* dst = img + VT_OFF + (size_t)(bh * NCH + c) * VT_BYTES;
#pragma unroll
        for (int i = 0; i < 8; ++i) { const int e = tid + i * 512; *(u32x4*)(dst + (size_t)e * 16) = *(const LAS u32x4*)(lds + e * 16); }
        __syncthreads();
    }
    for (int e = tid; e < 64 * 32; e += 512) { const int t = e >> 5, i = e & 31; ZT[e] = bf2f_(P[(size_t)(rb + t) * LDP + 6144 + i]); }
    __syncthreads();
    const int k = tid & 255, th = tid >> 8;
#pragma unroll
    for (int i = 0; i < 4; ++i) { const int e = tid + i * 512, t = e >> 5, c16 = e & 31; const size_t ro = (size_t)(rb + t) * LDP + hh * 256 + c16 * 8;
        *(LAS u32x4*)(QEI + t * 512 + c16 * 16) = *(const u32x4*)(P + ro); *(LAS u32x4*)(KEI + t * 512 + c16 * 16) = *(const u32x4*)(P + ro + 1024); }
    __syncthreads();
    float qreg[32], kreg[32];
#pragma unroll
    for (int i = 0; i < 32; ++i) { qreg[i] = bf2f_(*(const LAS unsigned short*)(QEI + (32 * th + i) * 512 + k * 2)) * 0.0625f; kreg[i] = bf2f_(*(const LAS unsigned short*)(KEI + (32 * th + i) * 512 + k * 2)); }
    { constexpr int d = DD;
        f32x2 w2p[8];
#pragma unroll
        for (int i = 0; i < 8; ++i) w2p[i] = (f32x2){gw2[(size_t)(d * 16 + 2 * i) * 1024 + hh * 256 + k], gw2[(size_t)(d * 16 + 2 * i + 1) * 1024 + hh * 256 + k]};
        const float bias = gb[d * 1024 + hh * 256 + k];
        float bc[32]; float run = 0.f;
#pragma unroll
        for (int i = 0; i < 32; ++i) { const int t = d == 0 ? 32 * th + i : 32 * th + 31 - i;
            f32x2 acc = {bias, 0.f};
#pragma unroll
            for (int q4 = 0; q4 < 4; ++q4) { const f32x4 z4 = *(const LAS f32x4*)(ZT + t * 32 + d * 16 + 4 * q4);
                acc = __builtin_elementwise_fma((f32x2){z4[0], z4[1]}, w2p[2 * q4], acc); acc = __builtin_elementwise_fma((f32x2){z4[2], z4[3]}, w2p[2 * q4 + 1], acc); }
            const float x = acc.x + acc.y;
            const float l2 = __builtin_amdgcn_logf(1.0f + __builtin_amdgcn_exp2f(fabsf(x) * -1.4426950408889634f));
            run += __builtin_fmaf(fminf(x, 0.f), 0.0625f * 1.4426950408889634f, l2 * -0.0625f); bc[i] = run; }
        SEG[th * 256 + k] = run;
        __syncthreads();
        const float s0 = SEG[k], s1 = SEG[256 + k]; const float bend = s0 + s1;
        const float pre = d == 0 ? (th == 1 ? s0 : 0.f) : (th == 0 ? s1 : 0.f);
        const float ebend = __builtin_amdgcn_exp2f(bend);
        unsigned kdp[16];
#pragma unroll
        for (int i = 0; i < 16; ++i) kdp[i] = 0u;
#pragma unroll
        for (int i = 0; i < 32; ++i) { const int t = d == 0 ? 32 * th + i : 32 * th + 31 - i; const float bcum = bc[i] + pre;
            const float qv = qreg[d == 0 ? i : 31 - i], kv = kreg[d == 0 ? i : 31 - i];
            const float qe = qv * __builtin_amdgcn_exp2f(bcum), ke = kv * __builtin_amdgcn_exp2f(-bcum), kd = ke * ebend;
            *(LAS unsigned short*)(QEI + qe_off(t, k)) = (unsigned short)f2bf(qe);
            *(LAS unsigned short*)(KEI + qe_off(t, k)) = (unsigned short)f2bf(ke);
            const int tl = t & 31;
            const unsigned hv = f2bf(kd);
            if (tl & 1) kdp[tl >> 1] = (kdp[tl >> 1] & 0xffffu) | (hv << 16); else kdp[tl >> 1] = (kdp[tl >> 1] & 0xffff0000u) | hv; }
#pragma unroll
        for (int cc = 0; cc < 4; ++cc) *(LAS u32x4*)(KDI + r128_off(k, 4 * th + cc)) = (u32x4){kdp[4 * cc], kdp[4 * cc + 1], kdp[4 * cc + 2], kdp[4 * cc + 3]};
        if (th == 0) *(LAS float*)(KDI + 32768 + 4 * k) = ebend;
        __syncthreads();
        { const int tt = wid >> 1; f32x4 acc[2] = {};
#pragma unroll
          for (int ks = 0; ks < 8; ++ks) { const int trow = 16 * tt + r16; const bf16x8 af = *(const LAS bf16x8*)(QEI + trow * 512 + (((4 * ks + g) ^ (trow & 15)) << 4));
#pragma unroll
            for (int mi = 0; mi < 2; ++mi) { const int mrow = 16 * (2 * (wid & 1) + mi) + r16; const bf16x8 bfr = *(const LAS bf16x8*)(KEI + mrow * 512 + (((4 * ks + g) ^ (mrow & 15)) << 4));
                acc[mi] = __builtin_amdgcn_mfma_f32_16x16x32_bf16(af, bfr, acc[mi], 0, 0, 0); } }
#pragma unroll
          for (int mi = 0; mi < 2; ++mi) { const int m = 16 * (2 * (wid & 1) + mi) + r16;
#pragma unroll
            for (int rg = 0; rg < 4; ++rg) { const int t = 16 * tt + 4 * g + rg; const bool keep = d == 0 ? (m <= t) : (m >= t);
                *(LAS unsigned short*)(ATI + r128_off(t, m >> 3) + (m & 7) * 2) = (unsigned short)f2bf(keep ? acc[mi][rg] : 0.f); } } }
        __syncthreads();
        { const size_t ii = (size_t)((d * 16 + bh) * NCH + c);
          unsigned char* dq = img + QEI_OFF + ii * QE_BYTES; unsigned char* dk = img + KDI_OFF + ii * KDT_BYTES; unsigned char* da = img + ATT_OFF + ii * ATT_BYTES;
#pragma unroll
          for (int i = 0; i < 4; ++i) { const int e = tid + i * 512; *(u32x4*)(dq + (size_t)e * 16) = *(const LAS u32x4*)(QEI + e * 16); }
          for (int e = tid; e < KDT_BYTES / 16; e += 512) *(u32x4*)(dk + (size_t)e * 16) = *(const LAS u32x4*)(KDI + e * 16);
          *(u32x4*)(da + (size_t)tid * 16) = *(const LAS u32x4*)(ATI + tid * 16); }
        __syncthreads();
    }
}

__device__ __forceinline__ void gl_dma(const void* gbase, unsigned voffB, unsigned lds_dst) { unsigned keep;
  asm volatile("s_mov_b32 %0, m0\n\ts_mov_b32 m0, %3\n\ts_nop 0\n\tglobal_load_lds_dwordx4 %1, %2\n\ts_mov_b32 m0, %0" : "=&s"(keep) : "v"(voffB), "s"(gbase), "s"(lds_dst) : "memory"); }
__device__ __forceinline__ void oq_store(unsigned short* __restrict__ OQ, size_t elt0, unsigned so0, const f32x4 (&oa)[4], const f32x4 (&ob)[4]) {
    unsigned char* base = (unsigned char*)(OQ + elt0);
#pragma unroll
    for (int tt = 0; tt < 4; ++tt) { const f32x4 o = oa[tt] + ob[tt]; const unsigned p01 = cvtpk(o[0], o[1]), p23 = cvtpk(o[2], o[3]);
        unsigned f0 = so0 + (tt * 16 + 0) * 4096, f1 = so0 + (tt * 16 + 1) * 4096, f2 = so0 + (tt * 16 + 2) * 4096, f3 = so0 + (tt * 16 + 3) * 4096;
        asm volatile("" : "+v"(f0), "+v"(f1), "+v"(f2), "+v"(f3));
        *(unsigned short*)(base + f0) = (unsigned short)p01; *(unsigned short*)(base + f1) = (unsigned short)(p01 >> 16);
        *(unsigned short*)(base + f2) = (unsigned short)p23; *(unsigned short*)(base + f3) = (unsigned short)(p23 >> 16); }
}
constexpr int STAGE_BYTES = QE_BYTES + KDT_BYTES, SEQ_LDS = 2 * STAGE_BYTES + 16384;
__device__ __forceinline__ void seq_unit(const unsigned char* __restrict__ img, unsigned short* __restrict__ OQ  , int b, int hh, int d, int vs, LAS unsigned char* lds) {
    int tid_ = threadIdx.x; asm volatile("" : "+v"(tid_)); const int tid = tid_, lane = tid & 63, wid = __builtin_amdgcn_readfirstlane(tid >> 6), g = lane >> 4, r16 = lane & 15, kh = wid >> 2, vq = wid & 3;
    const int bh = b * 4 + hh;
    LAS float* XCH = (LAS float*)(lds + 2 * STAGE_BYTES);
    f32x4 S[8] = {}; f32x4 oprev[4] = {}; int rb_prev = 0;
    bf16x8 vfr[2], afr[4];
    const int vrow = vs * 64 + vq * 16 + r16;
    const unsigned vo0 = (unsigned)(wid * 1024 + lane * 16);
    const unsigned so0 = (unsigned)((4 * g * 2048 + vq * 16 + r16) * 2);
#define GLA_CSEQ(i) (d == 0 ? (i) : ((i) < 4 ? 3 - (i) : 71 - (i)))
#define GLA_ISSUE(ci, bufsel) do { const int c_ = (ci); const size_t ii_ = (size_t)((d * 16 + bh) * NCH + c_); \
        const unsigned char* sq_ = img + QEI_OFF + ii_ * QE_BYTES; const unsigned char* sk_ = img + KDI_OFF + ii_ * KDT_BYTES; LAS unsigned char* db_ = lds + (bufsel) * STAGE_BYTES; \
        const unsigned dl_ = (unsigned)(uintptr_t)db_ + wid * 1024; \
        _Pragma("unroll") for (int r_ = 0; r_ < 4; ++r_) { gl_dma(sq_ + r_ * 8192, vo0, (unsigned)__builtin_amdgcn_readfirstlane(dl_ + r_ * 8192)); gl_dma(sk_ + r_ * 8192, vo0, (unsigned)__builtin_amdgcn_readfirstlane(dl_ + 32768 + r_ * 8192)); } \
        if (wid == 0) gl_dma(sk_ + 32768, vo0, (unsigned)__builtin_amdgcn_readfirstlane(dl_ + 65536)); \
        const unsigned char* sv_ = img + VT_OFF + (size_t)(bh * NCH + c_) * VT_BYTES; \
        vfr[0] = *(const bf16x8*)(sv_ + r128_off(vrow, g)); vfr[1] = *(const bf16x8*)(sv_ + r128_off(vrow, 4 + g)); \
        const unsigned char* sa_ = img + ATT_OFF + ii_ * ATT_BYTES; \
        _Pragma("unroll") for (int tt = 0; tt < 4; ++tt) afr[tt] = *(const bf16x8*)(sa_ + r128_off(16 * tt + r16, 4 * kh + g)); } while (0)
    __syncthreads();
    GLA_ISSUE(GLA_CSEQ(0), 0);
    for (int i = 0; i < NCH; ++i) {
        const int c = GLA_CSEQ(i); const int rb = chunk_row(b, c);
        LAS unsigned char* QEI = lds + (i & 1) * STAGE_BYTES; LAS unsigned char* KDI = QEI + QE_BYTES; LAS float* EB = (LAS float*)(KDI + 32768);
        if (kh == 0 && i >= 2) asm volatile("s_waitcnt vmcnt(16) lgkmcnt(0)\n\ts_barrier" ::: "memory");
        else asm volatile("s_waitcnt vmcnt(0) lgkmcnt(0)\n\ts_barrier" ::: "memory");
        const bf16x8 vf0 = vfr[0], vf1 = vfr[1]; bf16x8 af[4];
#pragma unroll
        for (int tt = 0; tt < 4; ++tt) af[tt] = afr[tt];
        if (i + 1 < NCH) GLA_ISSUE(GLA_CSEQ(i + 1), (i + 1) & 1);
        f32x4 xin[4];
        if (i > 0 && kh == 0) {
#pragma unroll
            for (int tt = 0; tt < 4; ++tt) xin[tt] = *(const LAS f32x4*)(XCH + ((vq * 4 + tt) * 64 + lane) * 4); }
        asm volatile("s_waitcnt lgkmcnt(0)\n\ts_barrier" ::: "memory");
        bf16x8 qa[4][4];
#define GLA_QRD(tt) do { const int trow_ = 16 * (tt) + r16; _Pragma("unroll") for (int ks = 0; ks < 4; ++ks) qa[tt][ks] = *(const LAS bf16x8*)(QEI + trow_ * 512 + (((16 * kh + 4 * ks + g) ^ (trow_ & 15)) << 4)); } while (0)
#define GLA_QMF(tt) do { _Pragma("unroll") for (int ks = 0; ks < 4; ++ks) o[tt] = __builtin_amdgcn_mfma_f32_16x16x32_bf16(qa[tt][ks], sb[ks], o[tt], 0, 0, 0); \
            o[tt] = __builtin_amdgcn_mfma_f32_16x16x32_bf16(af[tt], kh == 0 ? vf0 : vf1, o[tt], 0, 0, 0); } while (0)
        GLA_QRD(0);
        if (i > 0 && kh == 0) oq_store(OQ, ((size_t)d * 17408 + rb_prev) * 2048 + hh * 512 + vs * 64, so0, oprev, xin);
        bf16x8 sb[4];
#pragma unroll
        for (int ks = 0; ks < 4; ++ks) { u32x4 w; w.x = cvtpk(S[2 * ks][0], S[2 * ks][1]); w.y = cvtpk(S[2 * ks][2], S[2 * ks][3]); w.z = cvtpk(S[2 * ks + 1][0], S[2 * ks + 1][1]); w.w = cvtpk(S[2 * ks + 1][2], S[2 * ks + 1][3]);
            sb[ks] = __builtin_bit_cast(bf16x8, w); }
        f32x4 o[4] = {};
        __builtin_amdgcn_sched_barrier(0);
        GLA_QRD(1);
        __builtin_amdgcn_sched_barrier(0);
        GLA_QMF(0); GLA_QRD(2);
        __builtin_amdgcn_sched_barrier(0);
        GLA_QMF(1); GLA_QRD(3);
        __builtin_amdgcn_sched_barrier(0);
        GLA_QMF(2);
        __builtin_amdgcn_sched_barrier(0);
        GLA_QMF(3);
        __builtin_amdgcn_sched_barrier(0);
#undef GLA_QRD
#undef GLA_QMF
        if (kh == 1) {
#pragma unroll
            for (int tt = 0; tt < 4; ++tt) *(LAS f32x4*)(XCH + ((vq * 4 + tt) * 64 + lane) * 4) = o[tt];
        } else {
#pragma unroll
            for (int tt = 0; tt < 4; ++tt) oprev[tt] = o[tt];
        }
        rb_prev = rb;
        f32x4 e4[8]; bf16x8 ka0[8], ka1[8];
#define GLA_SRD(kt) do { const int krow0_ = 128 * kh + 16 * (kt), kr_ = krow0_ + r16; e4[kt] = *(const LAS f32x4*)(EB + krow0_ + 4 * g); \
            ka0[kt] = *(const LAS bf16x8*)(KDI + r128_off(kr_, g)); ka1[kt] = *(const LAS bf16x8*)(KDI + r128_off(kr_, 4 + g)); } while (0)
#define GLA_SUP(k0) do { S[k0] = S[k0] * e4[k0]; S[(k0) + 1] = S[(k0) + 1] * e4[(k0) + 1]; \
            S[k0] = __builtin_amdgcn_mfma_f32_16x16x32_bf16(ka0[k0], vf0, S[k0], 0, 0, 0); S[(k0) + 1] = __builtin_amdgcn_mfma_f32_16x16x32_bf16(ka0[(k0) + 1], vf0, S[(k0) + 1], 0, 0, 0); \
            S[k0] = __builtin_amdgcn_mfma_f32_16x16x32_bf16(ka1[k0], vf1, S[k0], 0, 0, 0); S[(k0) + 1] = __builtin_amdgcn_mfma_f32_16x16x32_bf16(ka1[(k0) + 1], vf1, S[(k0) + 1], 0, 0, 0); } while (0)
        GLA_SRD(0); GLA_SRD(1); GLA_SRD(2); GLA_SRD(3);
        __builtin_amdgcn_sched_barrier(0);
        GLA_SUP(0); GLA_SRD(4); GLA_SRD(5);
        __builtin_amdgcn_sched_barrier(0);
        GLA_SUP(2); GLA_SRD(6); GLA_SRD(7);
        __builtin_amdgcn_sched_barrier(0);
        GLA_SUP(4);
        __builtin_amdgcn_sched_barrier(0);
        GLA_SUP(6);
#undef GLA_SRD
#undef GLA_SUP
    }
    __syncthreads();
    if (kh == 0) { f32x4 xl[4];
#pragma unroll
        for (int tt = 0; tt < 4; ++tt) xl[tt] = *(const LAS f32x4*)(XCH + ((vq * 4 + tt) * 64 + lane) * 4);
        oq_store(OQ, ((size_t)d * 17408 + rb_prev) * 2048 + hh * 512 + vs * 64, so0, oprev, xl); }
    __syncthreads();
#undef GLA_ISSUE
#undef GLA_CSEQ
}
}
namespace lru {
using bf16x8 = __attribute__((ext_vector_type(8))) short;
using f32x4 = __attribute__((ext_vector_type(4))) float;
using u32x4 = __attribute__((ext_vector_type(4))) unsigned;
constexpr int LDP = 5120, NCH = 68, MROWS = 17408;
constexpr size_t HL_OFF = 0, AC_OFF = (size_t)2 * MROWS * 1024 * 2, AGGA_OFF = (size_t)4 * MROWS * 1024 * 2, AGGH_OFF = AGGA_OFF + (size_t)2 * 4 * NCH * 1024 * 4, LRU_END = AGGH_OFF + (size_t)2 * 4 * NCH * 1024 * 4;
__device__ __forceinline__ int chunk_row(int b, int c) { return c < 4 ? b * 256 + 64 * c : 1024 + b * 4096 + 64 * (c - 4); }
__device__ __forceinline__ float bf2f_(unsigned short v) { return __builtin_bit_cast(float, (unsigned)v << 16); }
__device__ __forceinline__ float sigm(float x) { return __builtin_amdgcn_rcpf(1.f + __builtin_amdgcn_exp2f(x * -1.4426950408889634f)); }
#define LRU_CSEQ(d, i) ((d) == 0 ? (i) : ((i) < 4 ? 3 - (i) : 71 - (i)))
#define LRU_POS(d, c) ((d) == 0 ? (c) : ((c) < 4 ? 3 - (c) : 71 - (c)))

struct Wreg { bf16x8 w[2][2][4]; float ba[2], bx[2], sp[2]; };

__device__ __forceinline__ void load_w(Wreg& W, const unsigned short* __restrict__ WT  , const float* __restrict__ ba, const float* __restrict__ bx, const float* __restrict__ lam  ,
                                       int n, int wid, int lane) {
    const int d = wid >> 2, g = lane >> 4, r16 = lane & 15;
#pragma unroll
    for (int mat = 0; mat < 2; ++mat)
#pragma unroll
        for (int ct = 0; ct < 2; ++ct) { const int j = 16 * (2 * (wid & 3) + ct) + r16;
#pragma unroll
            for (int ks = 0; ks < 4; ++ks) W.w[mat][ct][ks] = *(const bf16x8*)(WT + ((size_t)(((d * 2 + mat) * 8 + n) * 128 + j)) * 128 + 32 * ks + 8 * g); }
#pragma unroll
    for (int ct = 0; ct < 2; ++ct) { const int ch = n * 128 + 16 * (2 * (wid & 3) + ct) + r16;
        W.ba[ct] = ba[d * 1024 + ch]; W.bx[ct] = bx[d * 1024 + ch]; W.sp[ct] = -8.0f * 1.4426950408889634f * log1pf(expf(-lam[d * 1024 + ch])); }
}

struct ConvW { f32x4 w[4][2]; f32x4 b[2]; };
__device__ __forceinline__ void load_cw(ConvW& C, const float* __restrict__ cw, const float* __restrict__ cb, int n, int tid) { const int ch0 = n * 128 + (tid & 15) * 8;
#pragma unroll
    for (int jj = 0; jj < 4; ++jj) { C.w[jj][0] = *(const f32x4*)(cw + jj * 1024 + ch0); C.w[jj][1] = *(const f32x4*)(cw + jj * 1024 + ch0 + 4); }
    C.b[0] = *(const f32x4*)(cb + ch0); C.b[1] = *(const f32x4*)(cb + ch0 + 4); }
template <int d> __device__ __forceinline__ void lru_scan(const Wreg& W, const LAS unsigned char* XB, const LAS float* XF, LAS unsigned short* OUTB, int wid, int g, int r16, float (&cA)[2], float (&cH)[2]) {
#pragma unroll
    for (int ti = 0; ti < 4; ++ti) { const int tt = d == 0 ? ti : 3 - ti;
        f32x4 acc[2][2] = {};
#pragma unroll
        for (int ks = 0; ks < 4; ++ks) { const int trow = 16 * tt + r16; const bf16x8 af = *(const LAS bf16x8*)(XB + trow * 256 + (((4 * ks + g) ^ (trow & 15)) << 4));
#pragma unroll
            for (int mat = 0; mat < 2; ++mat)
#pragma unroll
                for (int ct = 0; ct < 2; ++ct) acc[mat][ct] = __builtin_amdgcn_mfma_f32_16x16x32_bf16(af, W.w[mat][ct][ks], acc[mat][ct], 0, 0, 0); }
#pragma unroll
        for (int ct = 0; ct < 2; ++ct) { const int chl = 16 * (2 * (wid & 3) + ct) + r16;
            float av[4], bv[4];
#pragma unroll
            for (int rg = 0; rg < 4; ++rg) { const int t = 16 * tt + 4 * g + rg; const float xc = XF[t * 128 + chl];
                const float r = sigm(acc[0][ct][rg] + W.ba[ct]), gi = sigm(acc[1][ct][rg] + W.bx[ct]);
                const float a = __builtin_amdgcn_exp2f(r * W.sp[ct]); av[rg] = a; bv[rg] = __builtin_amdgcn_sqrtf(__builtin_fmaf(-a, a, 1.0f)) * gi * xc; }
            float hl[4], al[4]; float h = 0.f, Ap = 1.f;
#pragma unroll
            for (int q = 0; q < 4; ++q) { const int rg = d == 0 ? q : 3 - q; h = av[rg] * h + bv[rg]; Ap *= av[rg]; hl[rg] = h; al[rg] = Ap; }
            float gA[4], gH[4];
            {
              unsigned pa[2] = {__builtin_bit_cast(unsigned, Ap), __builtin_bit_cast(unsigned, Ap)}, ph[2] = {__builtin_bit_cast(unsigned, h), __builtin_bit_cast(unsigned, h)}; ::xl_swap16(pa[0], pa[1]); ::xl_swap16(ph[0], ph[1]);
              unsigned a02[2] = {pa[0], pa[0]}, a13[2] = {pa[1], pa[1]}, h02[2] = {ph[0], ph[0]}, h13[2] = {ph[1], ph[1]};
              ::xl_swap32(a02[0], a02[1]); ::xl_swap32(a13[0], a13[1]); ::xl_swap32(h02[0], h02[1]); ::xl_swap32(h13[0], h13[1]);
              gA[0] = __builtin_bit_cast(float, a02[0]); gA[1] = __builtin_bit_cast(float, a13[0]); gA[2] = __builtin_bit_cast(float, a02[1]); gA[3] = __builtin_bit_cast(float, a13[1]);
              gH[0] = __builtin_bit_cast(float, h02[0]); gH[1] = __builtin_bit_cast(float, h13[0]); gH[2] = __builtin_bit_cast(float, h02[1]); gH[3] = __builtin_bit_cast(float, h13[1]); }
            float Ain = cA[ct], hin = cH[ct]; float Aall = cA[ct], hall = cH[ct];
#pragma unroll
            for (int q = 0; q < 4; ++q) { const int s = d == 0 ? q : 3 - q; const bool before = d == 0 ? (s < g) : (s > g);
                if (before) { hin = gA[s] * hin + gH[s]; Ain *= gA[s]; }
                hall = gA[s] * hall + gH[s]; Aall *= gA[s]; }
            cA[ct] = Aall; cH[ct] = hall;
#pragma unroll
            for (int rg = 0; rg < 4; ++rg) { const int ox = (d * 64 + 16 * tt + 4 * g + rg) * 128 + (chl ^ (g << 4));
                OUTB[ox] = (unsigned short)f2bf(hl[rg] + al[rg] * hin); OUTB[2 * 64 * 128 + ox] = (unsigned short)f2bf(al[rg] * Ain); }
        }
    }
}
__device__ __forceinline__ void lru1_item(const unsigned short* __restrict__ P, unsigned char* __restrict__ buf, const ConvW& CW, const Wreg& W, int c, int b, int n, LAS unsigned char* lds) {
    int tid_ = threadIdx.x; asm volatile("" : "+v"(tid_)); const int tid = tid_, lane = tid & 63, wid = __builtin_amdgcn_readfirstlane(tid >> 6), g = lane >> 4, r16 = lane & 15, d = wid >> 2;
    const int rb = chunk_row(b, c); const int lo = c < 4 ? b * 256 : 1024 + b * 4096, hi = c < 4 ? lo + 256 : lo + 4096;
    LAS unsigned char* XB = lds;
    LAS float* XF = (LAS float*)(lds + 16384);
    LAS unsigned short* OUTB = (LAS unsigned short*)(lds + 49152);
    __syncthreads();
    LAS unsigned char* XR = lds + 49152 + 65536;
    for (int e = tid; e < 68 * 16; e += 512) { const int r = e >> 4, c16 = e & 15; const int rr = rb - 2 + r; u32x4 v = {0u, 0u, 0u, 0u};
        if (rr >= lo && rr < hi) v = *(const u32x4*)(P + (size_t)rr * LDP + 4096 + n * 128 + c16 * 8);
        *(LAS u32x4*)(XR + r * 256 + c16 * 16) = v; }
    __syncthreads();
#pragma unroll
    for (int q = 0; q < 2; ++q) { const int e = tid + q * 512, t = e >> 4, c8 = (e & 15) * 8;
        float acc[8] = {CW.b[0][0], CW.b[0][1], CW.b[0][2], CW.b[0][3], CW.b[1][0], CW.b[1][1], CW.b[1][2], CW.b[1][3]};
#pragma unroll
        for (int jj = 0; jj < 4; ++jj) { const u32x4 w = *(const LAS u32x4*)(XR + (t + jj) * 256 + c8 * 2); const unsigned ww[4] = {w.x, w.y, w.z, w.w};
#pragma unroll
            for (int i = 0; i < 8; ++i) { const float xv = (i & 1) ? __builtin_bit_cast(float, ww[i >> 1] & 0xffff0000u) : __builtin_bit_cast(float, ww[i >> 1] << 16); acc[i] += xv * CW.w[jj][i >> 2][i & 3]; } }
        u32x4 pk; pk.x = pk2(acc[0], acc[1]); pk.y = pk2(acc[2], acc[3]); pk.z = pk2(acc[4], acc[5]); pk.w = pk2(acc[6], acc[7]);
        *(LAS u32x4*)(XB + t * 256 + ((((c8 >> 3)) ^ (t & 15)) << 4)) = pk;
        *(LAS f32x4*)(XF + t * 128 + c8) = (f32x4){acc[0], acc[1], acc[2], acc[3]}; *(LAS f32x4*)(XF + t * 128 + c8 + 4) = (f32x4){acc[4], acc[5], acc[6], acc[7]}; }
    __syncthreads();
    float cA[2] = {1.f, 1.f}, cH[2] = {0.f, 0.f};
    if (d == 0) lru_scan<0>(W, XB, XF, OUTB, wid, g, r16, cA, cH); else lru_scan<1>(W, XB, XF, OUTB, wid, g, r16, cA, cH);
    __syncthreads();
#pragma unroll
    for (int q = 0; q < 4; ++q) { const int e = tid + q * 512; const int dd = (e >> 10) & 1, t = (e >> 4) & 63, c8 = (e & 15) * 8;
        const u32x4 w = *(const LAS u32x4*)(OUTB + ((2 + dd) * 64 + t) * 128 + (c8 ^ (((t >> 2) & 3) << 4)));
        *(u32x4*)((unsigned short*)(buf + AC_OFF) + (size_t)dd * MROWS * 1024 + (size_t)(rb + t) * 1024 + n * 128 + c8) = w; }
#pragma unroll
    for (int q = 0; q < 2; ++q) { const int e = tid + q * 512; const int t = (e >> 4) & 63, c8 = (e & 15) * 8;
        const int cs = c8 ^ (((t >> 2) & 3) << 4);
        const u32x4 w0 = *(const LAS u32x4*)(OUTB + (0 * 64 + t) * 128 + cs), w1 = *(const LAS u32x4*)(OUTB + (1 * 64 + t) * 128 + cs);
        const unsigned a[4] = {w0.x, w0.y, w0.z, w0.w}, bq[4] = {w1.x, w1.y, w1.z, w1.w}; unsigned o[4];
#pragma unroll
        for (int i = 0; i < 4; ++i) o[i] = pk2(__builtin_bit_cast(float, a[i] << 16) + __builtin_bit_cast(float, bq[i] << 16), __builtin_bit_cast(float, a[i] & 0xffff0000u) + __builtin_bit_cast(float, bq[i] & 0xffff0000u));
        *(u32x4*)((unsigned short*)(buf + HL_OFF) + (size_t)(rb + t) * 1024 + n * 128 + c8) = (u32x4){o[0], o[1], o[2], o[3]}; }
    if (g == 0) {
#pragma unroll
        for (int ct = 0; ct < 2; ++ct) { const int ch = n * 128 + 16 * (2 * (wid & 3) + ct) + r16; const size_t ix = ((size_t)(d * 4 + b) * NCH + c) * 1024 + ch;
            ((float*)(buf + AGGA_OFF))[ix] = cA[ct]; ((float*)(buf + AGGH_OFF))[ix] = cH[ct]; }
    }
}

__device__ __forceinline__ float gelu_t(float x) { const float u = 0.7978845608028654f * (x + 0.044715f * x * x * x); const float e = __expf(2.f * u); const float th = 1.f - 2.f * __builtin_amdgcn_rcpf(e + 1.f); return 0.5f * x * (1.f + th); }

__device__ __forceinline__ void merge_range(const unsigned short* __restrict__ P, const unsigned char* __restrict__ buf, unsigned short* __restrict__ Y, int c0, int len, int b, int cq, LAS unsigned char* lds) {
    int tid_ = threadIdx.x; asm volatile("" : "+v"(tid_)); const int tid = tid_;
    LAS float* CAR = (LAS float*)lds;
    __syncthreads();
    { const int d = tid >> 8, chl = tid & 255, ch = cq * 256 + chl;
      const float* GA = (const float*)(buf + AGGA_OFF) + (size_t)(d * 4 + b) * NCH * 1024 + ch; const float* GH = (const float*)(buf + AGGH_OFF) + (size_t)(d * 4 + b) * NCH * 1024 + ch;
      float h = 0.f;
      if (d == 0) {
#pragma unroll 16
          for (int i = 0; i < c0; ++i) h = GA[(size_t)i * 1024] * h + GH[(size_t)i * 1024];
          for (int k = 0; k < len; ++k) { CAR[(0 * 5 + k) * 256 + chl] = h; h = GA[(size_t)(c0 + k) * 1024] * h + GH[(size_t)(c0 + k) * 1024]; }
      } else {
          const int pos = LRU_POS(1, c0 + len - 1);
#pragma unroll 16
          for (int i = 0; i < pos; ++i) { const int cc = LRU_CSEQ(1, i); h = GA[(size_t)cc * 1024] * h + GH[(size_t)cc * 1024]; }
          for (int k = len - 1; k >= 0; --k) { CAR[(1 * 5 + k) * 256 + chl] = h; h = GA[(size_t)(c0 + k) * 1024] * h + GH[(size_t)(c0 + k) * 1024]; }
      } }
    __syncthreads();
    const unsigned short* HL0 = (const unsigned short*)(buf + HL_OFF);
    const unsigned short* AC0 = (const unsigned short*)(buf + AC_OFF); const unsigned short* AC1 = AC0 + (size_t)MROWS * 1024;
    for (int k = 0; k < len; ++k) { const int rb = chunk_row(b, c0 + k); const LAS float* C0 = CAR + (0 * 5 + k) * 256; const LAS float* C1 = CAR + (1 * 5 + k) * 256;
#pragma unroll
      for (int q = 0; q < 4; ++q) { const int e = tid + q * 512, t = e >> 5, c8 = (e & 31) * 8; const size_t ix = (size_t)(rb + t) * 1024 + cq * 256 + c8;
        const u32x4 h0 = *(const u32x4*)(HL0 + ix), a0 = *(const u32x4*)(AC0 + ix), a1 = *(const u32x4*)(AC1 + ix);
        const u32x4 gt = *(const u32x4*)(P + (size_t)(rb + t) * LDP + 3072 + cq * 256 + c8);
        const unsigned h0w[4] = {h0.x, h0.y, h0.z, h0.w}, a0w[4] = {a0.x, a0.y, a0.z, a0.w}, a1w[4] = {a1.x, a1.y, a1.z, a1.w}, gw[4] = {gt.x, gt.y, gt.z, gt.w};
        float y[8];
#pragma unroll
        for (int i = 0; i < 8; ++i) {
#define LRU_EL(W) ((i & 1) ? __builtin_bit_cast(float, W[i >> 1] & 0xffff0000u) : __builtin_bit_cast(float, W[i >> 1] << 16))
            const float hs = LRU_EL(h0w) + LRU_EL(a0w) * C0[c8 + i] + LRU_EL(a1w) * C1[c8 + i];
            y[i] = gelu_t(LRU_EL(gw)) * hs;
#undef LRU_EL
        }
        u32x4 o; o.x = pk2(y[0], y[1]); o.y = pk2(y[2], y[3]); o.z = pk2(y[4], y[5]); o.w = pk2(y[6], y[7]);
        *(u32x4*)(Y + (size_t)(rb + t) * 2048 + 1024 + cq * 256 + c8) = o; } }
}
}
constexpr int DM = 2048, NB = 4, SEQ = 4096, CTXL = 256, NCTX = NB * CTXL, MLAT = NB * SEQ, MTOT = NCTX + MLAT, DFF = 8192, DEPTH = 4;
constexpr int EV_IN = 5120, OD_IN = 6176, OD_INP = 6400, NMODC = 6 * DM;
constexpr float EPS = 1e-6f;
constexpr int NWAVES = 8, NTHR = 512;

constexpr size_t MiB = 1u << 20;
constexpr size_t WS_CTL = 0, CTL_ZERO_BYTES = 64 * 1024;
constexpr size_t WS_MODS = 1 * MiB, WS_ROPE = 2 * MiB;
constexpr size_t WS_WEVIN = 3 * MiB, WS_WEVOUT = 43 * MiB, WS_WODIN = 59 * MiB, WS_WODOUT = 109 * MiB, WS_W1 = 125 * MiB, WS_W2 = 253 * MiB;
constexpr size_t WS_H = 381 * MiB, WS_U = 517 * MiB, WS_Y = 585 * MiB, WS_P = 653 * MiB, WS_SCR = 925 * MiB, WS_OQ = 1197 * MiB, WS_WT = 1333 * MiB, WS_BIN = 1335 * MiB, WS_BUP = 1336 * MiB, WS_RSA = 1337 * MiB, WS_RSB = 1340 * MiB, WS_SLAB = 1343 * MiB, WS_END = 1407 * MiB;
constexpr int CW_BAR = 4096;

constexpr int RING_BYTES = 131072, LDSCTL_OFF = 153600, MISC_OFF = LDSCTL_OFF + 320, RED_OFF = LDSCTL_OFF + 1024, LDS_BYTES = RED_OFF + 4096;

struct Args { const float* in[30]; float* out; unsigned char* ws; int ph_lo, ph_hi; };
enum { I_X = 0, I_C, I_CTX, I_CCTX, I_ADAW, I_ADAB, I_N1G, I_N2G, I_W1, I_W2, I_EVWIN, I_EVWOUT, I_LQ1, I_LK1, I_LQ2, I_LK2, I_SUBG, I_CONVW, I_CONVB,
       I_WA, I_BA, I_WX, I_BX, I_LAM, I_ODWIN, I_ODWOUT, I_GW2, I_GB, I_ODNG, I_FING };

__device__ __forceinline__ float bf2f(bf16 v) { return __builtin_bit_cast(float, (unsigned)v << 16); }
__device__ __forceinline__ float wave_sum(float v) { return sum_x32(sum_x16(sum_row16(v))); }
__device__ __forceinline__ float wave_max(float v) { return max_x32(max_x16(max_row16(v))); }
__device__ __forceinline__ float sigmoidf_(float x) { return __builtin_amdgcn_rcpf(1.f + __builtin_amdgcn_exp2f(x * -1.4426950408889634f)); }
__device__ __forceinline__ float siluf_(float x) { return x * __builtin_amdgcn_rcpf(1.f + __builtin_amdgcn_exp2f(x * -1.4426950408889634f)); }
__device__ __forceinline__ float gelu_tanh(float x) { const float t = tanhf(0.7978845608028654f * (x + 0.044715f * x * x * x)); return 0.5f * x * (1.f + t); }
__device__ __forceinline__ int mod_row(int r) { return r < NCTX ? 4 : (r - NCTX) / SEQ; }

struct TC { int tid, lane, wave, gtid, NT, gw, NGW; };
typedef const __attribute__((address_space(4))) Args* ArgP;
__device__ __forceinline__ TC mk_tc() { int tid = threadIdx.x, bid = blockIdx.x, G = gridDim.x; asm volatile("" : "+v"(tid), "+s"(bid), "+s"(G)); TC t; t.tid = tid; t.lane = tid & 63; t.wave = __builtin_amdgcn_readfirstlane(tid >> 6);
    t.gtid = bid * NTHR + tid; t.NT = G * NTHR; t.gw = bid * NWAVES + t.wave; t.NGW = G * NWAVES; return t; }
__device__ __forceinline__ ArgP argp() { ArgP p = (ArgP)__builtin_amdgcn_kernarg_segment_ptr(); asm volatile("" : "+s"(p)); return p; }

__device__ __forceinline__ int cvt_items_win(int L) { return (L & 1) ? (DM / 64) * (OD_IN / 32) : (DM / 64) * (EV_IN / 32); }
constexpr int CVT_I_WOUT = (DM / 64) * (DM / 32), CVT_I_W1 = (DM / 64) * (DFF / 32), CVT_I_W2 = (DFF / 64) * (DM / 32);
__device__ __forceinline__ int cvt_items_total(int L) { return cvt_items_win(L) + CVT_I_WOUT + CVT_I_W1 + CVT_I_W2; }
__device__ __forceinline__ void cvt_layer(ArgP A, int L, int it0, int it1, int gw, int ngw, int lane, LAS float* scr) {
    unsigned char* ws = A->ws; const int j = L >> 1, n_in = cvt_items_win(L);
    for (int it = it0 + gw; it < it1; it += ngw) {
        int r = it;
        if (r < n_in) { if (L & 1) p0_transpose_item<false>(A->in[I_ODWIN] + (size_t)j * DM * OD_IN, DM, OD_IN, (bf16*)(ws + WS_WODIN) + (size_t)j * OD_INP * DM, 0, scr, r, lane);
                        else p0_transpose_item<true>(A->in[I_EVWIN] + (size_t)j * DM * EV_IN, DM, EV_IN, (bf16*)(ws + WS_WEVIN) + (size_t)j * EV_IN * DM, 0, scr, r, lane); continue; }
        r -= n_in;
        if (r < CVT_I_WOUT) { p0_transpose_item<false>(A->in[(L & 1) ? I_ODWOUT : I_EVWOUT] + (size_t)j * DM * DM, DM, DM, (bf16*)(ws + ((L & 1) ? WS_WODOUT : WS_WEVOUT)) + (size_t)j * DM * DM, 0, scr, r, lane); continue; }
        r -= CVT_I_WOUT;
        if (r < CVT_I_W1) { p0_transpose_item<false>(A->in[I_W1] + (size_t)L * DM * DFF, DM, DFF, (bf16*)(ws + WS_W1) + (size_t)L * DFF * DM, 0, scr, r, lane); continue; }
        r -= CVT_I_W1;
        p0_transpose_item<false>(A->in[I_W2] + (size_t)L * DFF * DM, DFF, DM, (bf16*)(ws + WS_W2) + (size_t)L * DM * DFF, 0, scr, r, lane);
    }
}
__device__ __forceinline__ void ph_setup(ArgP A, const TC& t, LAS unsigned char* lds) {
    unsigned char* ws = A->ws;
    LAS float* sil = (LAS float*)lds;
    for (int i = t.tid; i < 5 * DM; i += NTHR) { const int r = i / DM, k = i % DM; const float v = r < 4 ? A->in[I_C][r * DM + k] : A->in[I_CCTX][k]; sil[i] = siluf_(v); }
    __syncthreads();
    float* mods = (float*)(ws + WS_MODS);
    { LAS float* part = (LAS float*)(lds + 40960);
      const int cl = t.tid & 63, kq = t.tid >> 6;
      for (int it = blockIdx.x; it < DEPTH * NMODC / 64; it += gridDim.x) { const int l = it / (NMODC / 64), col = (it % (NMODC / 64)) * 64 + cl;
        const float* w = A->in[I_ADAW] + ((size_t)l * DM + kq * 256) * NMODC + col; const LAS float* sk = sil + kq * 256;
        float acc0 = 0.f, acc1 = 0.f, acc2 = 0.f, acc3 = 0.f, acc4 = 0.f;
#pragma unroll 16
        for (int k = 0; k < 256; ++k) { const float wv = w[(size_t)k * NMODC];
            acc0 += sk[k] * wv; acc1 += sk[DM + k] * wv; acc2 += sk[2 * DM + k] * wv; acc3 += sk[3 * DM + k] * wv; acc4 += sk[4 * DM + k] * wv; }
        LAS float* pp = part + (kq * 64 + cl) * 5; pp[0] = acc0; pp[1] = acc1; pp[2] = acc2; pp[3] = acc3; pp[4] = acc4;
        __syncthreads();
        if (t.tid < 320) { const int r = t.tid / 64, c2 = t.tid & 63; float s = 0.f;
#pragma unroll
            for (int q = 0; q < 8; ++q) s += part[(q * 64 + c2) * 5 + r];
            mods[(size_t)(l * 5 + r) * NMODC + (it % (NMODC / 64)) * 64 + c2] = s + A->in[I_ADAB][l * NMODC + (it % (NMODC / 64)) * 64 + c2]; }
        __syncthreads(); } }
    LAS float* scr = (LAS float*)(lds + 40960 + t.wave * 8704);
    cvt_layer(A, 0, 0, cvt_items_total(0), t.gw, t.NGW, t.lane, scr);
    for (int j = 0; j < 2; ++j) {
        GAS v4u* z = (GAS v4u*)((bf16*)(ws + WS_WODIN) + (size_t)j * OD_INP * DM + (size_t)OD_IN * DM);
        for (int i = t.gtid; i < (OD_INP - OD_IN) * DM / 8; i += t.NT) z[i] = (v4u){0u, 0u, 0u, 0u};
    }
    if (t.gtid < 64 * 16) { const int p = t.gtid / 16, f = t.gtid % 16;
        const float inv = powf(10000.0f, -(float)f / 16.0f); const float ang = (float)p * inv;
        const double ad = (double)ang; const double kk = rint(ad * 0.15915494309189535); const float rr = (float)(ad - kk * 6.283185307179586);
        float* rope = (float*)(ws + WS_ROPE); rope[2 * t.gtid] = cosf(rr); rope[2 * t.gtid + 1] = sinf(rr); }
    { bf16* WT = (bf16*)(ws + WS_WT);
      for (int idx = t.gtid; idx < 2 * 2 * 2 * 8 * 128 * 128; idx += t.NT) { const int i = idx & 127, jo = (idx >> 7) & 127, n = (idx >> 14) & 7, mat = (idx >> 17) & 1, d = (idx >> 18) & 1, jj = idx >> 19;
          const float* src = A->in[mat ? I_WX : I_WA] + ((size_t)((jj * 2 + d) * 8 + n) * 128 + i) * 128 + jo; WT[idx] = (bf16)f2bf(*src); } }
    { GAS unsigned long long* H = (GAS unsigned long long*)(ws + WS_H); const GAS f32x4* cx = (const GAS f32x4*)A->in[I_CTX]; const GAS f32x4* xx = (const GAS f32x4*)A->in[I_X];
      for (int i0 = t.gtid; i0 < MTOT * (DM / 4); i0 += 8 * t.NT) { f32x4 v[8];
#pragma unroll
          for (int q = 0; q < 8; ++q) { const int i = i0 + q * t.NT; v[q] = (f32x4){0.f, 0.f, 0.f, 0.f}; if (i < MTOT * (DM / 4)) v[q] = i < NCTX * (DM / 4) ? cx[i] : xx[i - NCTX * (DM / 4)]; }
#pragma unroll
          for (int q = 0; q < 8; ++q) { const int i = i0 + q * t.NT; if (i < MTOT * (DM / 4)) H[i] = (unsigned long long)pk2(v[q].x, v[q].y) | ((unsigned long long)pk2(v[q].z, v[q].w) << 32); } } }
}


__device__ __forceinline__ void bias_rows(const bf16* Wt, int N, const float* shiftv  , float* out  , int nb, const TC& t, LAS float* sh  ) {
    __syncthreads();
    for (int i = t.tid; i < 5 * DM / 4; i += NTHR) { const int r = i / (DM / 4), c4 = i % (DM / 4); *(LAS f32x4*)(sh + r * DM + 4 * c4) = *(const f32x4*)(shiftv + (size_t)r * NMODC + 4 * c4); }
    __syncthreads();
    for (int n = t.gw; n < N; n += t.NGW) {
        float acc[5] = {0.f, 0.f, 0.f, 0.f, 0.f};
#pragma unroll
        for (int i = 0; i < 4; ++i) { const int k0 = (i * 64 + t.lane) * 8; const v4u w = *(const v4u*)(Wt + (size_t)n * DM + k0); const unsigned ww[4] = {w.x, w.y, w.z, w.w};
#pragma unroll
            for (int r = 0; r < 5; ++r) { const f32x4 s0 = *(const LAS f32x4*)(sh + r * DM + k0), s1 = *(const LAS f32x4*)(sh + r * DM + k0 + 4);
                acc[r] += __builtin_bit_cast(float, ww[0] << 16) * s0.x + __builtin_bit_cast(float, ww[0] & 0xffff0000u) * s0.y + __builtin_bit_cast(float, ww[1] << 16) * s0.z + __builtin_bit_cast(float, ww[1] & 0xffff0000u) * s0.w
                        + __builtin_bit_cast(float, ww[2] << 16) * s1.x + __builtin_bit_cast(float, ww[2] & 0xffff0000u) * s1.y + __builtin_bit_cast(float, ww[3] << 16) * s1.z + __builtin_bit_cast(float, ww[3] & 0xffff0000u) * s1.w; } }
#pragma unroll
        for (int r = 0; r < 5; ++r) { const float s = wave_sum(acc[r]); if (t.lane == 0) __hip_atomic_store(out + (size_t)r * nb + n, s, __ATOMIC_RELAXED, __HIP_MEMORY_SCOPE_AGENT); }
    }
}
__device__ __forceinline__ void layer_biases(ArgP A, const TC& t, int l, LAS unsigned char* lds) {
    unsigned char* ws = A->ws; const float* ml = (const float*)(ws + WS_MODS) + (size_t)l * 5 * NMODC; LAS float* sh = (LAS float*)lds; const int j = l >> 1;
    if ((l & 1) == 0) bias_rows((const bf16*)(ws + WS_WEVIN) + (size_t)j * EV_IN * DM, EV_IN, ml, (float*)(ws + WS_BIN) + (size_t)l * 5 * OD_INP, OD_INP, t, sh);
    else bias_rows((const bf16*)(ws + WS_WODIN) + (size_t)j * OD_INP * DM, OD_INP, ml, (float*)(ws + WS_BIN) + (size_t)l * 5 * OD_INP, OD_INP, t, sh);
    bias_rows((const bf16*)(ws + WS_W1) + (size_t)l * DFF * DM, DFF, ml + 3 * DM, (float*)(ws + WS_BUP) + (size_t)l * 5 * DFF, DFF, t, sh);
}
__device__ __forceinline__ void ph_setup_b(ArgP A, const TC& t, LAS unsigned char* lds) {
    unsigned char* ws = A->ws; const float* mods = (const float*)(ws + WS_MODS); LAS float* sh = (LAS float*)lds;
    { const int l = 0; const int j = l >> 1; const float* ml = mods + (size_t)l * 5 * NMODC;
        if ((l & 1) == 0) bias_rows((const bf16*)(ws + WS_WEVIN) + (size_t)j * EV_IN * DM, EV_IN, ml, (float*)(ws + WS_BIN) + (size_t)l * 5 * OD_INP, OD_INP, t, sh);
        else bias_rows((const bf16*)(ws + WS_WODIN) + (size_t)j * OD_INP * DM, OD_INP, ml, (float*)(ws + WS_BIN) + (size_t)l * 5 * OD_INP, OD_INP, t, sh);
        bias_rows((const bf16*)(ws + WS_W1) + (size_t)l * DFF * DM, DFF, ml + 3 * DM, (float*)(ws + WS_BUP) + (size_t)l * 5 * DFF, DFF, t, sh); }
    const float* g = A->in[I_N1G]; const bf16* H = (const bf16*)(ws + WS_H); bf16* U = (bf16*)(ws + WS_U); float* rsa = (float*)(ws + WS_RSA);
    for (int r = t.gw; r < MTOT; r += t.NGW) {
        const float* sc = mods + (size_t)mod_row(r) * NMODC + DM; float ss = 0.f;
        v4u hwa[4]; f32x4 ga[4][2], sa[4][2];
#pragma unroll
        for (int jj = 0; jj < 4; ++jj) { const int c = 8 * (t.lane + 64 * jj); hwa[jj] = *(const v4u*)(H + (size_t)r * DM + c);
            ga[jj][0] = *(const f32x4*)(g + c); ga[jj][1] = *(const f32x4*)(g + c + 4); sa[jj][0] = *(const f32x4*)(sc + c); sa[jj][1] = *(const f32x4*)(sc + c + 4); }
#pragma unroll
        for (int jj = 0; jj < 4; ++jj) { const int c = 8 * (t.lane + 64 * jj); const v4u hw = hwa[jj]; const unsigned ww[4] = {hw.x, hw.y, hw.z, hw.w};
            float y[8];
#pragma unroll
            for (int i = 0; i < 8; ++i) { const float v = (i & 1) ? __builtin_bit_cast(float, ww[i >> 1] & 0xffff0000u) : __builtin_bit_cast(float, ww[i >> 1] << 16); ss += v * v; y[i] = v * (ga[jj][i >> 2][i & 3] * (sa[jj][i >> 2][i & 3] + 1.0f)); }
            v4u o; o.x = pk2(y[0], y[1]); o.y = pk2(y[2], y[3]); o.z = pk2(y[4], y[5]); o.w = pk2(y[6], y[7]); *(v4u*)(U + (size_t)r * DM + c) = o; }
        ss = wave_sum(ss); if (t.lane < 8) __hip_atomic_store(rsa + (size_t)t.lane * MTOT + r, t.lane == 0 ? ss : 0.f, __ATOMIC_RELAXED, __HIP_MEMORY_SCOPE_AGENT);
    }
}
__device__ __forceinline__ void ph_attn_fast(ArgP A, int l, int j, LAS unsigned char* lds) {
    const int lane = threadIdx.x & 63;
    const float lam_init = 0.8f - 0.6f * expf(-0.3f * (float)l);
    const float dq1 = wave_sum(A->in[I_LQ1][j * 64 + lane] * A->in[I_LK1][j * 64 + lane]);
    const float dq2 = wave_sum(A->in[I_LQ2][j * 64 + lane] * A->in[I_LK2][j * 64 + lane]);
    const float lam = expf(dq1) - expf(dq2) + lam_init;
    const bf16* P = (const bf16*)(A->ws + WS_P); bf16* Y = (bf16*)(A->ws + WS_Y); const float* sg = A->in[I_SUBG] + j * 128;
    const int G = gridDim.x, bid = blockIdx.x; const int vcu = (G % 8 == 0) ? (bid & 7) * (G >> 3) + (bid >> 3) : bid;
    constexpr int NBIG = NB * 8 * 32, NSMALL = NB * 8 * 2;
    for (int u0 = vcu; u0 < NBIG + G; u0 += G) {
        int u = u0; if (u0 >= NBIG) { const int v = u0 - NBIG - G / 2; if (v < 0 || v >= NSMALL) continue; u = NBIG + v; }
        int b, hh, qrow0, NT;
        if (u < NBIG) { b = u >> 8; hh = (u >> 5) & 7; qrow0 = NCTX + b * SEQ + (u & 31) * 128; NT = 68; }
        else { const int v = u - NBIG; b = v >> 4; hh = (v >> 1) & 7; qrow0 = b * CTXL + (v & 1) * 128; NT = 4; }
        att::attn_unit(P, Y, b, hh, qrow0, NT, lam, 1.f - lam_init, sg, lds);
    }
}

__device__ __forceinline__ void ph_lru1(ArgP A, int j, LAS unsigned char* lds) {
    const bf16* P = (const bf16*)(A->ws + WS_P); unsigned char* buf = A->ws + WS_SCR;
    const bf16* WT = (const bf16*)(A->ws + WS_WT) + (size_t)j * 2 * 2 * 8 * 128 * 128;
    const float* cw = A->in[I_CONVW] + (size_t)j * 4 * 1024; const float* cb = A->in[I_CONVB] + (size_t)j * 1024;
    const float* ba = A->in[I_BA] + (size_t)j * 2 * 1024; const float* bx = A->in[I_BX] + (size_t)j * 2 * 1024; const float* lam = A->in[I_LAM] + (size_t)j * 2 * 1024;
    const int G = gridDim.x, bid = blockIdx.x; const int vcu = (G % 8 == 0) ? (bid & 7) * (G >> 3) + (bid >> 3) : bid;
    int tid_ = threadIdx.x; asm volatile("" : "+v"(tid_)); const int wid = __builtin_amdgcn_readfirstlane(tid_ >> 6), lane = tid_ & 63;
    lru::Wreg W; lru::ConvW CW; int ncur = -1;
    for (int it = vcu; it < lru::NCH * 4 * 8; it += G) { const int n = it & 7, cb_ = it >> 3; const int c = cb_ % lru::NCH, b = cb_ / lru::NCH;
        if (n != ncur) { lru::load_w(W, WT, ba, bx, lam, n, wid, lane); lru::load_cw(CW, cw, cb, n, tid_); ncur = n; }
        lru::lru1_item(P, buf, CW, W, c, b, n, lds); }
}
__device__ __forceinline__ void ph_lru_merge(ArgP A, LAS unsigned char* lds) {
    const bf16* P = (const bf16*)(A->ws + WS_P); const unsigned char* buf = A->ws + WS_SCR; bf16* Y = (bf16*)(A->ws + WS_Y);
    for (int u = blockIdx.x; u < 256; u += gridDim.x) { const int ri = u & 15, bq = u >> 4;
        int c0, len; if (ri == 0) { c0 = 0; len = 4; } else { const int i = ri - 1; c0 = 4 + (i < 4 ? 5 * i : 20 + 4 * (i - 4)); len = i < 4 ? 5 : 4; }
        lru::merge_range(P, buf, Y, c0, len, bq >> 2, bq & 3, lds); }
}
__device__ __forceinline__ void ph_gla_prep(ArgP A, int j, LAS unsigned char* lds) {
    const bf16* P = (const bf16*)(A->ws + WS_P); unsigned char* img = A->ws + WS_SCR;
    const float* gw2 = A->in[I_GW2] + (size_t)j * 2 * 16 * 1024; const float* gb = A->in[I_GB] + (size_t)j * 2 * 1024;
    const int G = gridDim.x, NIT = gla::NCH * 16, NFULL = (NIT / G) * G;
    for (int it = blockIdx.x; it < NFULL; it += G) { const int c = it % gla::NCH, bh = it / gla::NCH; gla::prep_item(P, img, gw2, gb, c, bh >> 2, bh & 3, lds); }
    { const int hb = blockIdx.x; if (hb < 2 * (NIT - NFULL)) { const int it = NFULL + (hb >> 1), c = it % gla::NCH, bh = it / gla::NCH;
        if (hb & 1) gla::prep_half<1>(P, img, gw2, gb, c, bh >> 2, bh & 3, lds); else gla::prep_half<0>(P, img, gw2, gb, c, bh >> 2, bh & 3, lds); } }
}
__device__ __forceinline__ void ph_gla_seq(ArgP A, LAS unsigned char* lds) {
    const unsigned char* img = A->ws + WS_SCR; bf16* OQ = (bf16*)(A->ws + WS_OQ);
    const int G = gridDim.x, bid = blockIdx.x; const int vcu = (G % 8 == 0) ? (bid & 7) * (G >> 3) + (bid >> 3) : bid;
    for (int u = vcu; u < 256; u += G) { const int vs = u & 7, d = (u >> 3) & 1, bh = u >> 4; gla::seq_unit(img, OQ, bh >> 2, bh & 3, d, vs, lds); }
}
__device__ __forceinline__ void ph_od_c4(ArgP A, const TC& t, int j) {
    const bf16* P = (const bf16*)(A->ws + WS_P); const bf16* OQ = (const bf16*)(A->ws + WS_OQ); bf16* Y = (bf16*)(A->ws + WS_Y);
    const float* ng = A->in[I_ODNG] + j * 512;
    f32x4 g0 = *(const f32x4*)(ng + 8 * t.lane), g1 = *(const f32x4*)(ng + 8 * t.lane + 4);
    const float gg[8] = {g0.x, g0.y, g0.z, g0.w, g1.x, g1.y, g1.z, g1.w};
    for (int r = t.gw; r < MTOT; r += t.NGW) {
        v4u oa[4], ob[4], rg[4];
#pragma unroll
        for (int hh = 0; hh < 4; ++hh) { const size_t ix = (size_t)r * DM + hh * 512 + 8 * t.lane;
            oa[hh] = *(const v4u*)(OQ + ix); ob[hh] = *(const v4u*)(OQ + (size_t)MTOT * DM + ix); rg[hh] = *(const v4u*)(P + (size_t)r * OD_INP + 4096 + hh * 512 + 8 * t.lane); }
#pragma unroll
        for (int hh = 0; hh < 4; ++hh) {
            const unsigned aw[4] = {oa[hh].x, oa[hh].y, oa[hh].z, oa[hh].w}, bw[4] = {ob[hh].x, ob[hh].y, ob[hh].z, ob[hh].w}, rw[4] = {rg[hh].x, rg[hh].y, rg[hh].z, rg[hh].w};
            float o[8]; float ss = 0.f;
#pragma unroll
            for (int i = 0; i < 8; ++i) {
#define EL_(W) ((i & 1) ? __builtin_bit_cast(float, W[i >> 1] & 0xffff0000u) : __builtin_bit_cast(float, W[i >> 1] << 16))
                o[i] = EL_(aw) + EL_(bw); ss += o[i] * o[i]; }
            const float rstd = __builtin_amdgcn_rsqf(wave_sum(ss) * (1.f / 512.f) + EPS);
            float y[8];
#pragma unroll
            for (int i = 0; i < 8; ++i) y[i] = o[i] * rstd * gg[i] * siluf_(EL_(rw));
#undef EL_
            v4u w; w.x = pk2(y[0], y[1]); w.y = pk2(y[2], y[3]); w.z = pk2(y[4], y[5]); w.w = pk2(y[6], y[7]);
            *(v4u*)(Y + (size_t)r * DM + hh * 512 + 8 * t.lane) = w; }
    }
}
__device__ __forceinline__ void ph_final(ArgP A, const TC& t) {
    const bf16* H = (const bf16*)(A->ws + WS_H); const float* g = A->in[I_FING];
    f32x4 gv[4][2];
#pragma unroll
    for (int jj = 0; jj < 4; ++jj) { const int c = 8 * (t.lane + 64 * jj); gv[jj][0] = *(const f32x4*)(g + c); gv[jj][1] = *(const f32x4*)(g + c + 4); }
    for (int r = t.gw; r < MLAT; r += t.NGW) {
        v4u hw[4]; float ss = 0.f;
#pragma unroll
        for (int jj = 0; jj < 4; ++jj) hw[jj] = *(const v4u*)(H + (size_t)(NCTX + r) * DM + 8 * (t.lane + 64 * jj));
        float v[4][8];
#pragma unroll
        for (int jj = 0; jj < 4; ++jj) { const unsigned ww[4] = {hw[jj].x, hw[jj].y, hw[jj].z, hw[jj].w};
#pragma unroll
            for (int i = 0; i < 8; ++i) { v[jj][i] = (i & 1) ? __builtin_bit_cast(float, ww[i >> 1] & 0xffff0000u) : __builtin_bit_cast(float, ww[i >> 1] << 16); ss += v[jj][i] * v[jj][i]; } }
        const float rstd = __builtin_amdgcn_rsqf(wave_sum(ss) * (1.f / DM) + EPS);
#pragma unroll
        for (int jj = 0; jj < 4; ++jj) { const int c = 8 * (t.lane + 64 * jj); const f32x4 g0 = gv[jj][0], g1 = gv[jj][1];
            *(f32x4*)(A->out + (size_t)r * DM + c) = (f32x4){v[jj][0] * rstd * g0.x, v[jj][1] * rstd * g0.y, v[jj][2] * rstd * g0.z, v[jj][3] * rstd * g0.w};
            *(f32x4*)(A->out + (size_t)r * DM + c + 4) = (f32x4){v[jj][4] * rstd * g1.x, v[jj][5] * rstd * g1.y, v[jj][6] * rstd * g1.z, v[jj][7] * rstd * g1.w}; }
    }
}

constexpr int PH_PER_LAYER = 7, N_PHASES = 3 + DEPTH * PH_PER_LAYER;
template <int N, int K, class Epi> __device__ __forceinline__ void run_gemm(LAS unsigned char* lds, const bf16* Aop, const bf16* Wt, int MR, const Epi& E) {
    pg8::Gemm g{Aop, Wt, MR, N, K, K}; pg8::StaticOrder S; S.init(MR, N, gridDim.x, (int)blockIdx.x, N == 2048 ? 4 : 8);
    pg8::gemm_phase<Epi, pg8::StaticOrder, true, true>(lds, g, S, E);
}

template <int K> __device__ __forceinline__ void ctx_splitk(LAS unsigned char* lds, const bf16* Aop, const bf16* Wt, float* slab) {
    const int G = gridDim.x, bid = blockIdx.x; const int vcu = (G % 8 == 0) ? (bid & 7) * (G >> 3) + (bid >> 3) : bid;
    const int ks = vcu & 7, un = vcu >> 3; constexpr int KC = K / 8;
    pg8::Gemm g{Aop + (size_t)ks * KC, Wt + (size_t)ks * KC, NCTX, DM, KC, K}; pg8::OneUnit S{un >> 3, un & 7, vcu < 256};
    pg8::EpiPartial E{slab + (size_t)ks * NCTX * DM};
    pg8::gemm_phase<pg8::EpiPartial, pg8::OneUnit, true, true>(lds, g, S, E);
}
__device__ __forceinline__ void ph_ctx_reduce(ArgP A, const TC& t, const float* gatev  , const float* ng, const float* scv  , float* rowss) {
    const float* slab = (const float*)(A->ws + WS_SLAB); bf16* H = (bf16*)(A->ws + WS_H); bf16* U = (bf16*)(A->ws + WS_U);
    for (int it = t.gw; it < NCTX * 4; it += t.NGW) { const int r = it >> 2, q = it & 3;
        float ss = 0.f;
#pragma unroll
        for (int jj = 0; jj < 2; ++jj) { const int c = q * 512 + 4 * (t.lane + 64 * jj);
            f32x4 sv[8];
#pragma unroll
            for (int ks = 0; ks < 8; ++ks) sv[ks] = *(const f32x4*)(slab + ((size_t)ks * NCTX + r) * DM + c);
            const f32x4 s = ((sv[0] + sv[1]) + (sv[2] + sv[3])) + ((sv[4] + sv[5]) + (sv[6] + sv[7]));
            const unsigned long long hw = *(const unsigned long long*)(H + (size_t)r * DM + c); const unsigned lo = (unsigned)hw, hi = (unsigned)(hw >> 32);
            const f32x4 h0 = {__builtin_bit_cast(float, lo << 16), __builtin_bit_cast(float, lo & 0xffff0000u), __builtin_bit_cast(float, hi << 16), __builtin_bit_cast(float, hi & 0xffff0000u)};
            const f32x4 gt4 = *(const f32x4*)(gatev + c), ng4 = *(const f32x4*)(ng + c), sc4 = *(const f32x4*)(scv + c);
            const f32x4 hn = h0 + gt4 * s;
            *(unsigned long long*)(H + (size_t)r * DM + c) = (unsigned long long)pk2(hn.x, hn.y) | ((unsigned long long)pk2(hn.z, hn.w) << 32); ss += (hn.x * hn.x + hn.y * hn.y) + (hn.z * hn.z + hn.w * hn.w);
            const f32x4 y = hn * (ng4 * (sc4 + 1.0f));
            *(unsigned long long*)(U + (size_t)r * DM + c) = (unsigned long long)pk2(y.x, y.y) | ((unsigned long long)pk2(y.z, y.w) << 32); }
        ss = wave_sum(ss);
        if (t.lane < 2) __hip_atomic_store(rowss + (size_t)(q + 4 * t.lane) * MTOT + r, t.lane == 0 ? ss : 0.f, __ATOMIC_RELAXED, __HIP_MEMORY_SCOPE_AGENT);
    }
}
__device__ __forceinline__ int slack_idle(int nwg) { const int G = gridDim.x, rounds = (nwg + G - 1) / G; return rounds * G - nwg; }
__device__ __forceinline__ void cvt_in_slack(ArgP A, int Lnext, int nwg, int it0, int it1, LAS unsigned char* lds) {
    int tid_ = threadIdx.x; asm volatile("" : "+v"(tid_)); const int wave = __builtin_amdgcn_readfirstlane(tid_ >> 6), lane = tid_ & 63;
    const int G = gridDim.x, idle = slack_idle(nwg), c0 = G - idle; LAS float* scr = (LAS float*)(lds + wave * 8704);
    if (idle == 0) cvt_layer(A, Lnext, it0, it1, (int)blockIdx.x * NWAVES + wave, G * NWAVES, lane, scr);
    else if ((int)blockIdx.x >= c0) cvt_layer(A, Lnext, it0, it1, ((int)blockIdx.x - c0) * NWAVES + wave, idle * NWAVES, lane, scr);
}
__global__ void __launch_bounds__(NTHR, 2) mega(Args args) {
    extern __shared__ __attribute__((aligned(16))) unsigned char lds_raw[];
    LAS unsigned char* lds = (LAS unsigned char*)lds_raw;
    volatile LAS unsigned* MISC = (volatile LAS unsigned*)(lds + MISC_OFF);
    for (int u = threadIdx.x; u < (LDS_BYTES - LDSCTL_OFF) / 4; u += NTHR) ((LAS unsigned*)(lds + LDSCTL_OFF))[u] = 0u;
    __syncthreads();
    const int lo = argp()->ph_lo, hi = argp()->ph_hi;
    const bool use_bar = (hi - lo) > 1;
    XcdBarrier bar; bar.bar = (unsigned*)(argp()->ws + WS_CTL) + CW_BAR; bar.x = 0; bar.st = nullptr;
    if (use_bar) bar = xcd_barrier_post((unsigned*)(argp()->ws + WS_CTL) + CW_BAR, MISC + 8);
#define IN(k) (lo <= (k) && (k) < hi)
#define SEAM(k) do { if (IN(k) && (k) + 1 < hi) xcd_barrier(bar); } while (0)
    if (IN(0)) { ph_setup(argp(), mk_tc(), lds); SEAM(0); }
    if (IN(1)) { ph_setup_b(argp(), mk_tc(), lds); SEAM(1); }
    for (int l = 0; l < DEPTH; ++l) {
        const int pb = 2 + l * PH_PER_LAYER, j = l >> 1; const bool even = (l & 1) == 0;
        if (IN(pb + 0)) {
            unsigned char* ws = argp()->ws; const float* bin = (const float*)(ws + WS_BIN) + (size_t)l * 5 * OD_INP;
            if (even) { pg8::EpiIn<0, true> E{(bf16*)(ws + WS_P), EV_IN, (const float*)(ws + WS_RSA), bin, OD_INP, (const float*)(ws + WS_ROPE), 0};
                        run_gemm<EV_IN, DM>(lds, (const bf16*)(ws + WS_U), (const bf16*)(ws + WS_WEVIN) + (size_t)j * EV_IN * DM, MTOT, E); }
            else      { pg8::EpiIn<0, false> E{(bf16*)(ws + WS_P), OD_INP, (const float*)(ws + WS_RSA), bin, OD_INP, nullptr, 0};
                        run_gemm<OD_INP, DM>(lds, (const bf16*)(ws + WS_U), (const bf16*)(ws + WS_WODIN) + (size_t)j * OD_INP * DM, MTOT, E); }
            if (l + 1 < DEPTH) {
                const int nwg_in = (MTOT / 256) * ((even ? EV_IN : OD_INP) / 256), nwg_up = (MTOT / 256) * (DFF / 256); const int ia = slack_idle(nwg_in), ib = slack_idle(nwg_up);
                const int tot = cvt_items_total(l + 1); const int n1 = (ia + ib) > 0 ? (int)((long)tot * ia / (ia + ib)) : tot / 2;
                cvt_in_slack(argp(), l + 1, nwg_in, 0, n1, lds); }
            SEAM(pb + 0);
        }
        if (even) {
            if (IN(pb + 1)) { ph_attn_fast(argp(), l, j, lds); ph_lru1(argp(), j, lds); SEAM(pb + 1); }
            if (IN(pb + 3)) { ph_lru_merge(argp(), lds); SEAM(pb + 3); }
        } else {
            if (IN(pb + 1)) { ph_gla_prep(argp(), j, lds); SEAM(pb + 1); }
            if (IN(pb + 2)) { ph_gla_seq(argp(), lds); SEAM(pb + 2); }
            if (IN(pb + 3)) { ph_od_c4(argp(), mk_tc(), j); SEAM(pb + 3); }
        }
        if (IN(pb + 4)) {
            unsigned char* ws = argp()->ws; const float* ml = (const float*)(ws + WS_MODS) + (size_t)l * 5 * NMODC;
            const bf16* Wt = (const bf16*)(ws + (even ? WS_WEVOUT : WS_WODOUT)) + (size_t)j * DM * DM;
            pg8::EpiResid E{(bf16*)(ws + WS_H), ml + 2 * DM, NCTX, (bf16*)(ws + WS_U), argp()->in[I_N2G] + l * DM, ml + 4 * DM, (float*)(ws + WS_RSB), (LAS float*)(lds + RED_OFF)};
            run_gemm<DM, DM>(lds, (const bf16*)(ws + WS_Y) + (size_t)NCTX * DM, Wt, MLAT, E);
            if (l < DEPTH - 1) { ctx_splitk<DM>(lds, (const bf16*)(ws + WS_Y), Wt, (float*)(ws + WS_SLAB)); xcd_barrier(bar);
                ph_ctx_reduce(argp(), mk_tc(), ml + 4 * NMODC + 2 * DM, argp()->in[I_N2G] + l * DM, ml + 4 * NMODC + 4 * DM, (float*)(ws + WS_RSB)); }
            SEAM(pb + 4);
        }
        if (IN(pb + 5)) {
            unsigned char* ws = argp()->ws;
            const int rb0 = (l == DEPTH - 1) ? NCTX : 0;
            pg8::EpiIn<1, false> E{(bf16*)(ws + WS_P), DFF, (const float*)(ws + WS_RSB), (const float*)(ws + WS_BUP) + (size_t)l * 5 * DFF, DFF, nullptr, rb0};
            run_gemm<DFF, DM>(lds, (const bf16*)(ws + WS_U) + (size_t)rb0 * DM, (const bf16*)(ws + WS_W1) + (size_t)l * DFF * DM, MTOT - rb0, E);
            if (l + 1 < DEPTH) {
                const int nwg_in = (MTOT / 256) * ((even ? EV_IN : OD_INP) / 256), nwg_up = (MTOT / 256) * (DFF / 256); const int ia = slack_idle(nwg_in), ib = slack_idle(nwg_up);
                const int tot = cvt_items_total(l + 1); const int n1 = (ia + ib) > 0 ? (int)((long)tot * ia / (ia + ib)) : tot / 2;
                cvt_in_slack(argp(), l + 1, nwg_up, n1, tot, lds); }
            SEAM(pb + 5);
        }
        if (IN(pb + 6)) {
            unsigned char* ws = argp()->ws; const float* ml = (const float*)(ws + WS_MODS) + (size_t)l * 5 * NMODC;
            const bool last = l == DEPTH - 1; const int ln = last ? l : l + 1;
            pg8::EpiResid E{(bf16*)(ws + WS_H), ml + 5 * DM, NCTX, last ? (bf16*)nullptr : (bf16*)(ws + WS_U), argp()->in[I_N1G] + ln * DM, (const float*)(ws + WS_MODS) + (size_t)ln * 5 * NMODC + 1 * DM, (float*)(ws + WS_RSA), (LAS float*)(lds + RED_OFF)};
            run_gemm<DM, DFF>(lds, (const bf16*)(ws + WS_P) + (size_t)NCTX * DFF, (const bf16*)(ws + WS_W2) + (size_t)l * DM * DFF, MLAT, E);
            if (!last) { ctx_splitk<DFF>(lds, (const bf16*)(ws + WS_P), (const bf16*)(ws + WS_W2) + (size_t)l * DM * DFF, (float*)(ws + WS_SLAB)); xcd_barrier(bar);
                ph_ctx_reduce(argp(), mk_tc(), ml + 4 * NMODC + 5 * DM, argp()->in[I_N1G] + ln * DM, (const float*)(ws + WS_MODS) + (size_t)ln * 5 * NMODC + 4 * NMODC + 1 * DM, (float*)(ws + WS_RSA));
                layer_biases(argp(), mk_tc(), l + 1, lds); }
            SEAM(pb + 6);
        }
    }
    if (IN(N_PHASES - 1)) ph_final(argp(), mk_tc());
#undef IN
#undef SEAM
}

extern "C" void kernel_launch(void* const* d_in, const int* in_sizes, int n_in, void* d_out, int out_size, void* d_ws, size_t ws_size, hipStream_t stream) {
    static int grid = 0;
    if (grid == 0) {
        if (n_in != 30 || ws_size < WS_END) { fprintf(stderr, "kernel_launch: bad n_in %d or ws %zu\n", n_in, ws_size); grid = -1; return; }
        int dev = 0, cus = 0;
        if (hipGetDevice(&dev) != hipSuccess || hipDeviceGetAttribute(&cus, hipDeviceAttributeMultiprocessorCount, dev) != hipSuccess) { grid = -1; return; }
        if (hipFuncSetAttribute((const void*)mega, hipFuncAttributeMaxDynamicSharedMemorySize, LDS_BYTES) != hipSuccess) { grid = -1; return; }
        (void)hipGetLastError();
        grid = cus;
    }
    if (grid < 0) return;
    (void)hipMemsetAsync((char*)d_ws + WS_CTL, 0, CTL_ZERO_BYTES, stream);
    Args a{};
    for (int i = 0; i < 30; ++i) a.in[i] = (const float*)d_in[i];
    a.out = (float*)d_out; a.ws = (unsigned char*)d_ws;
    a.ph_lo = 0; a.ph_hi = N_PHASES; hipLaunchKernelGGL(mega, dim3(grid), dim3(NTHR), LDS_BYTES, stream, a);
}
```
